# Optimizing an MI355X kernel written in HIP

```python
import math
import jax, jax.numpy as jnp
from jax import lax
import numpy as np

D_MODEL = 4096
BATCH = 1
SEQ = 8192
DEPTH = 1

MEM_LEN = 256
DA_HEADS = 8
DA_HEAD_DIM = 128
DA_V_DIM = 2 * DA_HEAD_DIM
DA_WIDTH = DA_HEADS * DA_V_DIM
HG_HEADS = 16
HG_EXPAND = 128
HG_HEAD_DIM = 128
HG_WIDTH = HG_HEADS * HG_HEAD_DIM
HG_CHUNK = 64
XA_HEADS = 4
XA_HEAD_DIM = 128
XA_WIDTH = XA_HEADS * XA_HEAD_DIM
D_FF = 11008
ROPE_THETA = 10000.0
Q_BLOCK = 128
LN_EPS = 1e-5
DEEPNORM_ALPHA = (2 * DEPTH) ** 0.25
DEEPNORM_BETA = (8 * DEPTH) ** -0.25
MIX_SPLITS = (DA_HEADS * 2 * DA_HEAD_DIM,
              DA_HEADS * 2 * DA_HEAD_DIM,
              DA_WIDTH,
              HG_HEADS * HG_EXPAND,
              HG_HEADS * HG_EXPAND,
              HG_WIDTH,
              HG_WIDTH,
              D_MODEL,
              D_MODEL)
MIX_IN_WIDTH = sum(MIX_SPLITS)

kernel_name = "diffattn_hgrn2_gated_hybrid_layer"


def layer_norm(x, g, b):
    xf = x.astype(jnp.float32)
    mu = jnp.mean(xf, axis=-1, keepdims=True)
    var = jnp.mean(jnp.square(xf - mu), axis=-1, keepdims=True)
    y = (xf - mu) * lax.rsqrt(var + LN_EPS) * g.astype(jnp.float32) + b.astype(jnp.float32)
    return y.astype(x.dtype)


def rms_norm(x, g):
    xf = x.astype(jnp.float32)
    y = xf * lax.rsqrt(jnp.mean(xf * xf, axis=-1, keepdims=True) + LN_EPS) * g.astype(jnp.float32)
    return y.astype(x.dtype)


def swiglu(x, w_gate, w_up, w_down):
    return (jax.nn.silu(x @ w_gate) * (x @ w_up)) @ w_down


def rope_tables(seq, dim):
    inv = 1.0 / (ROPE_THETA ** (jnp.arange(0, dim, 2, dtype=jnp.float32) / dim))
    ang = jnp.arange(seq, dtype=jnp.float32)[:, None] * inv[None, :]
    return jnp.cos(ang), jnp.sin(ang)


def apply_rope(x, cos, sin):
    x1, x2 = jnp.split(x.astype(jnp.float32), 2, axis=-1)
    c = cos[None, :, None, :]
    s = sin[None, :, None, :]
    return jnp.concatenate([x1 * c - x2 * s, x2 * c + x1 * s], axis=-1).astype(x.dtype)


def causal_diff_attention(q, k, v, lam):
    B, S, H, _, Dh = q.shape
    nb = S // Q_BLOCK
    scale = Dh ** -0.5
    qb = q.reshape(B, nb, Q_BLOCK, H, 2, Dh).transpose(1, 0, 2, 3, 4, 5)
    kpos = jnp.arange(S)

    def block(args):
        qblk, start = args
        s = jnp.einsum('bqhmd,bkhmd->bmhqk', qblk, k).astype(jnp.float32) * scale
        qpos = start + jnp.arange(Q_BLOCK)
        mask = kpos[None, :] <= qpos[:, None]
        p = jax.nn.softmax(jnp.where(mask, s, -jnp.inf), axis=-1)
        a = p[:, 0] - lam * p[:, 1]
        return jnp.einsum('bhqk,bkhe->bqhe', a.astype(v.dtype), v)

    out = lax.map(block, (qb, jnp.arange(nb) * Q_BLOCK))
    return out.transpose(1, 0, 2, 3, 4).reshape(B, S, H, v.shape[-1])


def diff_attention_branch(q_flat, k_flat, v_flat, lq1, lk1, lq2, lk2, subln_g, w_up, cos, sin, layer_idx):
    B, S, _ = q_flat.shape
    lambda_init = 0.8 - 0.6 * math.exp(-0.3 * layer_idx)
    q = apply_rope(q_flat.reshape(B, S, DA_HEADS * 2, DA_HEAD_DIM), cos, sin).reshape(B, S, DA_HEADS, 2, DA_HEAD_DIM)
    k = apply_rope(k_flat.reshape(B, S, DA_HEADS * 2, DA_HEAD_DIM), cos, sin).reshape(B, S, DA_HEADS, 2, DA_HEAD_DIM)
    v = v_flat.reshape(B, S, DA_HEADS, DA_V_DIM)
    f32 = jnp.float32
    lam = (jnp.exp(jnp.sum(lq1.astype(f32) * lk1.astype(f32)))
           - jnp.exp(jnp.sum(lq2.astype(f32) * lk2.astype(f32))) + lambda_init)
    o = causal_diff_attention(q, k, v, lam)
    o = rms_norm(o, subln_g) * (1.0 - lambda_init)
    return o.reshape(B, S, DA_WIDTH) @ w_up


def hgrn2_chunk_scan(q, k, v, logf):
    B, S, H, N = q.shape
    Dv = v.shape[-1]
    C = HG_CHUNK
    nc = S // C

    def to_chunks(t):
        return t.reshape(B, nc, C, H, t.shape[-1]).transpose(1, 0, 3, 2, 4)

    qc, kc, vc, gc = to_chunks(q), to_chunks(k), to_chunks(v), to_chunks(logf)
    bc = jnp.cumsum(gc, axis=3)
    causal = jnp.tril(jnp.ones((C, C), dtype=bool))

    def step(state, inp):
        qt, kt, vt, bt = inp
        o_inter = jnp.einsum('bhcn,bhnv->bhcv', qt * jnp.exp(bt), state)
        diff = bt[:, :, :, None, :] - bt[:, :, None, :, :]
        decay = jnp.exp(jnp.where(causal[None, None, :, :, None], diff, -jnp.inf))
        A = jnp.einsum('bhtn,bhsn,bhtsn->bhts', qt, kt, decay)
        o_intra = jnp.einsum('bhts,bhsv->bhtv', A, vt)
        bl = bt[:, :, -1:, :]
        new_state = (jnp.exp(bl[:, :, 0, :])[..., None] * state
                     + jnp.einsum('bhsn,bhsv->bhnv', kt * jnp.exp(bl - bt), vt))
        return new_state, o_inter + o_intra

    s0 = jnp.zeros((B, H, N, Dv), jnp.float32)
    _, o = lax.scan(step, s0, (qc, kc, vc, bc))
    return o.transpose(1, 0, 3, 2, 4).reshape(B, S, H, Dv)


def hgrn2_branch(q_flat, f_flat, i_flat, g_flat, lb, norm_g, w_up):
    B, S, _ = q_flat.shape
    f32 = jnp.float32
    shp_k = (B, S, HG_HEADS, HG_EXPAND)
    shp_v = (B, S, HG_HEADS, HG_HEAD_DIM)
    lbh = lb.reshape(HG_HEADS, HG_EXPAND)
    f = lbh + (1.0 - lbh) * jax.nn.sigmoid(f_flat.astype(f32).reshape(shp_k))
    o = hgrn2_chunk_scan(q_flat.astype(f32).reshape(shp_k), 1.0 - f,
                         i_flat.astype(f32).reshape(shp_v), jnp.log(f))
    o = rms_norm(o, norm_g) * jax.nn.silu(g_flat.astype(f32).reshape(shp_v))
    return o.astype(q_flat.dtype).reshape(B, S, HG_WIDTH) @ w_up


def memory_cross_attention(x, mem, w_q, w_k, w_v, w_o):
    B, S, _ = x.shape
    M = mem.shape[1]
    q = (x @ w_q).reshape(B, S, XA_HEADS, XA_HEAD_DIM)
    k = (mem @ w_k).reshape(B, M, XA_HEADS, XA_HEAD_DIM)
    v = (mem @ w_v).reshape(B, M, XA_HEADS, XA_HEAD_DIM)
    s = jnp.einsum('bshd,bmhd->bhsm', q, k).astype(jnp.float32) * (XA_HEAD_DIM ** -0.5)
    p = jax.nn.softmax(s, axis=-1).astype(v.dtype)
    o = jnp.einsum('bhsm,bmhd->bshd', p, v).reshape(B, S, XA_WIDTH)
    return o @ w_o


def setup_inputs(seed: int = 0) -> dict:
    key = jax.random.key(seed)
    ks = iter(jax.random.split(key, 40))
    L = DEPTH
    f32 = jnp.float32

    def w(shape, fan_in, scale=1.0):
        return jax.random.normal(next(ks), shape, f32) * (scale * fan_in ** -0.5)

    def gain(shape):
        return 1.0 + 0.02 * jax.random.normal(next(ks), shape, f32)

    def bias(shape):
        return 0.02 * jax.random.normal(next(ks), shape, f32)

    return {
        "x": jax.random.normal(next(ks), (BATCH, SEQ, D_MODEL), f32),
        "mem": jax.random.normal(next(ks), (BATCH, MEM_LEN, D_MODEL), f32),
        "ffn1_w_gate": w((L, D_MODEL, D_FF), D_MODEL),
        "ffn1_w_up": w((L, D_MODEL, D_FF), D_MODEL),
        "ffn1_w_down": w((L, D_FF, D_MODEL), D_FF, DEEPNORM_BETA),
        "ln1_g": gain((L, D_MODEL)),
        "ln1_b": bias((L, D_MODEL)),
        "mix_w_in": w((L, D_MODEL, MIX_IN_WIDTH), D_MODEL),
        "da_lambda_q1": 0.1 * jax.random.normal(next(ks), (L, DA_HEAD_DIM), f32),
        "da_lambda_k1": 0.1 * jax.random.normal(next(ks), (L, DA_HEAD_DIM), f32),
        "da_lambda_q2": 0.1 * jax.random.normal(next(ks), (L, DA_HEAD_DIM), f32),
        "da_lambda_k2": 0.1 * jax.random.normal(next(ks), (L, DA_HEAD_DIM), f32),
        "da_subln_g": gain((L, DA_V_DIM)),
        "da_w_up": w((L, DA_WIDTH, D_MODEL), DA_WIDTH),
        "hg_lb_logits": 0.5 * jax.random.normal(next(ks), (DEPTH + 1, HG_HEADS * HG_EXPAND), f32),
        "hg_norm_g": gain((L, HG_HEAD_DIM)),
        "hg_w_up": w((L, HG_WIDTH, D_MODEL), HG_WIDTH),
        "mix_w_out": w((L, D_MODEL, D_MODEL), D_MODEL, DEEPNORM_BETA),
        "ln2_g": gain((L, D_MODEL)),
        "ln2_b": bias((L, D_MODEL)),
        "xa_w_q": w((L, D_MODEL, XA_WIDTH), D_MODEL),
        "xa_w_k": w((L, D_MODEL, XA_WIDTH), D_MODEL),
        "xa_w_v": w((L, D_MODEL, XA_WIDTH), D_MODEL),
        "xa_w_o": w((L, XA_WIDTH, D_MODEL), XA_WIDTH, DEEPNORM_BETA),
        "ln3_g": gain((L, D_MODEL)),
        "ln3_b": bias((L, D_MODEL)),
        "ffn2_w_gate": w((L, D_MODEL, D_FF), D_MODEL),
        "ffn2_w_up": w((L, D_MODEL, D_FF), D_MODEL),
        "ffn2_w_down": w((L, D_FF, D_MODEL), D_FF, DEEPNORM_BETA),
        "ln4_g": gain((L, D_MODEL)),
        "ln4_b": bias((L, D_MODEL)),
    }


def reference(x, mem, ffn1_w_gate, ffn1_w_up, ffn1_w_down, ln1_g, ln1_b,
              mix_w_in, da_lambda_q1, da_lambda_k1, da_lambda_q2, da_lambda_k2,
              da_subln_g, da_w_up, hg_lb_logits, hg_norm_g, hg_w_up, mix_w_out,
              ln2_g, ln2_b, xa_w_q, xa_w_k, xa_w_v, xa_w_o, ln3_g, ln3_b,
              ffn2_w_gate, ffn2_w_up, ffn2_w_down, ln4_g, ln4_b):
    S = x.shape[1]
    cos, sin = rope_tables(S, DA_HEAD_DIM)
    lb_all = jnp.cumsum(jax.nn.softmax(hg_lb_logits.astype(jnp.float32), axis=0), axis=0)
    split_points = [int(p) for p in np.cumsum(np.array(MIX_SPLITS[:-1]))]
    for l in range(DEPTH):
        x = layer_norm(DEEPNORM_ALPHA * x + 0.5 * swiglu(x, ffn1_w_gate[l], ffn1_w_up[l], ffn1_w_down[l]),
                       ln1_g[l], ln1_b[l])
        proj = x @ mix_w_in[l]
        da_q, da_k, da_v, hg_q, hg_f, hg_i, hg_g, gate_a, gate_b = jnp.split(proj, split_points, axis=-1)
        y_a = diff_attention_branch(da_q, da_k, da_v, da_lambda_q1[l], da_lambda_k1[l],
                                    da_lambda_q2[l], da_lambda_k2[l], da_subln_g[l], da_w_up[l],
                                    cos, sin, l)
        y_b = hgrn2_branch(hg_q, hg_f, hg_i, hg_g, lb_all[l], hg_norm_g[l], hg_w_up[l])
        merged = jax.nn.sigmoid(gate_a) * y_a + jax.nn.sigmoid(gate_b) * y_b
        x = layer_norm(DEEPNORM_ALPHA * x + merged @ mix_w_out[l], ln2_g[l], ln2_b[l])
        x = layer_norm(DEEPNORM_ALPHA * x + memory_cross_attention(x, mem, xa_w_q[l], xa_w_k[l], xa_w_v[l], xa_w_o[l]),
                       ln3_g[l], ln3_b[l])
        x = layer_norm(DEEPNORM_ALPHA * x + 0.5 * swiglu(x, ffn2_w_gate[l], ffn2_w_up[l], ffn2_w_down[l]),
                       ln4_g[l], ln4_b[l])
    return x
```

```cpp
#include <hip/hip_runtime.h>
#include <cstdio>
#include <cstdint>
__device__ __forceinline__ int mk_lane() { int l; asm volatile("v_mbcnt_lo_u32_b32 %0, -1, 0\n\tv_mbcnt_hi_u32_b32 %0, -1, %0" : "=v"(l)); return l; }
namespace pg8 {
#define PG8_LAS __attribute__((address_space(3)))
typedef unsigned short bf16_t;
typedef short bf16x8 __attribute__((ext_vector_type(8)));
typedef float f32x4 __attribute__((ext_vector_type(4)));
typedef unsigned u32x4 __attribute__((ext_vector_type(4)));
constexpr int BM = 256, BK = 64, HALF = 128, HTB = HALF * BK * 2  , STAGE_BYTES = 8 * HTB, NXCD = 8, WGM = 8;

__host__ __device__ __forceinline__ int lds_byte(int r, int c) { const int st = (r >> 4) * 2 + (c >> 5), rr = r & 15, cc = c & 31, ob = rr * 64 + cc * 2; return st * 1024 + (ob ^ (((ob >> 9) & 1) << 5)); }
__host__ __device__ __forceinline__ void stage_rc(int b, int& R, int& C) { const int st = b / 1024, sb = b % 1024, swz = sb ^ (((sb >> 9) & 1) << 5); R = (st >> 1) * 16 + swz / 64; C = (st & 1) * 32 + (swz % 64) / 2; }
__host__ __device__ __forceinline__ int perm32(int rho) { const int n = rho >> 4, i = rho & 15; return 8 * (i >> 2) + 4 * n + (i & 3); }

struct Unit { int pm, pn, seg, ko; };
struct Gemm { const bf16_t* A; const bf16_t* Bt; int M, N, K, ld; const bf16_t* A2; const bf16_t* Bt2; };

struct StaticOrder {
    int nM, nN, nwg, G, c;
    __host__ __device__ void init(int M, int N, int G_, int c_) { nM = M / BM; nN = N / BM; nwg = nM * nN; G = G_; c = c_; }
    __host__ __device__ bool next(int i, Unit& u) const {
        const long L = (long)i * G + c; if (L >= nwg) return false;
        int wgid = (int)L; { const int q = nwg / NXCD, r = nwg % NXCD, xcd = wgid % NXCD, off = wgid / NXCD; wgid = (xcd < r ? xcd * (q + 1) : r * (q + 1) + (xcd - r) * q) + off; }
        const int nig = WGM * nN, gid = wgid / nig, fm = gid * WGM, gsz = (nM - fm) < WGM ? (nM - fm) : WGM;
        u.pm = fm + ((wgid % nig) % gsz); u.pn = (wgid % nig) / gsz; u.seg = 0; u.ko = 0; return true;
    }
    __device__ __forceinline__ void a_ready(const Unit&) const {}
    __device__ __forceinline__ void done(const Unit&) const {}
};
struct DualOrder : StaticOrder { __device__ __forceinline__ bool next(int i, Unit& u) const { if (!StaticOrder::next(i >> 1, u)) return false; u.seg = i & 1; return true; } };
struct SplitKOrder { int M, N, ntiles, nks, K, G, c;
    __device__ __forceinline__ void init(int M_, int N_, int K_, int nks_, int G_, int c_) { M = M_; N = N_; ntiles = (M_ / BM) * (N_ / BM); nks = nks_; K = K_; G = G_; c = c_; }
    __device__ __forceinline__ bool next(int i, Unit& u) const { const long L = (long)i * G + c; if (L >= (long)ntiles * nks) return false;
        StaticOrder b; b.init(M, N, ntiles, (int)(L % ntiles)); b.next(0, u); u.seg = 0; u.ko = (int)(L / ntiles) * K; return true; }
    __device__ __forceinline__ void a_ready(const Unit&) const {}
    __device__ __forceinline__ void done(const Unit&) const {}
};

typedef __bf16 bf16x2_cv __attribute__((ext_vector_type(2)));
typedef float f32x2_cv __attribute__((ext_vector_type(2)));
__device__ __forceinline__ unsigned cvt_pk_bf16_pinned(float lo, float hi) { unsigned r; asm volatile("s_nop 1\n\tv_cvt_pk_bf16_f32 %0, %1, %2" : "=v"(r) : "v"(lo), "v"(hi)); return r; }
__device__ __forceinline__ unsigned cvt_pk_bf16(float lo, float hi) { const bf16x2_cv v = __builtin_convertvector((f32x2_cv){lo, hi}, bf16x2_cv); return __builtin_bit_cast(unsigned, v); }
__device__ __forceinline__ u32x4 pack8(const f32x4 a, const f32x4 b) { u32x4 w; w.x = cvt_pk_bf16(a[0], a[1]); w.y = cvt_pk_bf16(a[2], a[3]); w.z = cvt_pk_bf16(b[0], b[1]); w.w = cvt_pk_bf16(b[2], b[3]); return w; }
__device__ __forceinline__ float sigm(float x) { return __builtin_amdgcn_rcpf(1.0f + __builtin_amdgcn_exp2f(-1.4426950408889634f * x)); }
__device__ __forceinline__ f32x4 sigm4(const f32x4 x) { return (f32x4){sigm(x[0]), sigm(x[1]), sigm(x[2]), sigm(x[3])}; }
__device__ __forceinline__ f32x4 bf_lo4(const u32x4 w) { return (f32x4){__uint_as_float(w.x << 16), __uint_as_float(w.x & 0xffff0000u), __uint_as_float(w.y << 16), __uint_as_float(w.y & 0xffff0000u)}; }
__device__ __forceinline__ f32x4 bf_hi4(const u32x4 w) { return (f32x4){__uint_as_float(w.z << 16), __uint_as_float(w.z & 0xffff0000u), __uint_as_float(w.w << 16), __uint_as_float(w.w & 0xffff0000u)}; }

struct EpiBf16 {
    static constexpr bool PERM = true, AFTER_DRAIN = false, CHAIN = false;
    bf16_t* O; int ldc;
    __device__ __forceinline__ void operator()(const f32x4 (&acc)[2][2][4][2], const Unit& u, int wr, int wc, int fr, int fq) const {
        const int row0 = u.pm * BM + wr * 64 + fr, col0 = u.pn * BM + wc * 32 + 8 * fq;
#pragma unroll
        for (int ai = 0; ai < 2; ++ai)
#pragma unroll
            for (int m = 0; m < 4; ++m) { bf16_t* rowp = O + (size_t)(row0 + ai * HALF + m * 16) * ldc + col0;
#pragma unroll
                for (int bj = 0; bj < 2; ++bj) *(u32x4*)(rowp + bj * HALF) = pack8(acc[ai][bj][m][0], acc[ai][bj][m][1]); }
    }
};
struct EpiSwiGLU {
    static constexpr bool PERM = true, AFTER_DRAIN = false, CHAIN = false;
    bf16_t* H; int ldh;
    __device__ __forceinline__ void operator()(const f32x4 (&acc)[2][2][4][2], const Unit& u, int wr, int wc, int fr, int fq) const {
        const int row0 = u.pm * BM + wr * 64 + fr, col0 = u.pn * HALF + wc * 32 + 8 * fq;
#pragma unroll
        for (int ai = 0; ai < 2; ++ai)
#pragma unroll
            for (int m = 0; m < 4; ++m) { bf16_t* rowp = H + (size_t)(row0 + ai * HALF + m * 16) * ldh + col0;
                const f32x4 g0 = acc[ai][0][m][0], g1 = acc[ai][0][m][1];
                const f32x4 v0 = g0 * sigm4(g0) * acc[ai][1][m][0], v1 = g1 * sigm4(g1) * acc[ai][1][m][1];
                *(u32x4*)rowp = pack8(v0, v1); }
    }
};
struct EpiResF32 {
    static constexpr bool PERM = false, AFTER_DRAIN = false, CHAIN = false;
    const float* R; float* Y; int ldc; float alpha, beta;
    __device__ __forceinline__ void operator()(const f32x4 (&acc)[2][2][4][2], const Unit& u, int wr, int wc, int fr, int fq) const {
        const int row0 = u.pm * BM + wr * 64 + fr, col0 = u.pn * BM + wc * 32 + 4 * fq;
#pragma unroll
        for (int ai = 0; ai < 2; ++ai)
#pragma unroll
            for (int m = 0; m < 4; ++m) { const size_t off = (size_t)(row0 + ai * HALF + m * 16) * ldc + col0;
#pragma unroll
                for (int bj = 0; bj < 2; ++bj)
#pragma unroll
                    for (int n = 0; n < 2; ++n) { const f32x4 r = *(const f32x4*)(R + off + bj * HALF + n * 16); *(f32x4*)(Y + off + bj * HALF + n * 16) = r * alpha + acc[ai][bj][m][n] * beta; }
                asm volatile("" ::: "memory"); }
    }
};
struct EpiGateA {
    static constexpr bool PERM = true, AFTER_DRAIN = false, CHAIN = false;
    const bf16_t* G; float* T; int ldc;
    __device__ __forceinline__ void operator()(const f32x4 (&acc)[2][2][4][2], const Unit& u, int wr, int wc, int fr, int fq) const {
        const int row0 = u.pm * BM + wr * 64 + fr, col0 = u.pn * BM + wc * 32 + 8 * fq;
#pragma unroll
        for (int ai = 0; ai < 2; ++ai)
#pragma unroll
            for (int m = 0; m < 4; ++m) { const size_t off = (size_t)(row0 + ai * HALF + m * 16) * ldc + col0;
#pragma unroll
                for (int bj = 0; bj < 2; ++bj) { const u32x4 gw = *(const u32x4*)(G + off + bj * HALF);
                    *(f32x4*)(T + off + bj * HALF) = bf_lo4(gw) * acc[ai][bj][m][0]; *(f32x4*)(T + off + bj * HALF + 4) = bf_hi4(gw) * acc[ai][bj][m][1]; } }
    }
};
struct EpiGateB {
    static constexpr bool PERM = true, AFTER_DRAIN = false, CHAIN = false;
    const bf16_t* G; const float* T; bf16_t* O; int ldc;
    __device__ __forceinline__ void operator()(const f32x4 (&acc)[2][2][4][2], const Unit& u, int wr, int wc, int fr, int fq) const {
        const int row0 = u.pm * BM + wr * 64 + fr, col0 = u.pn * BM + wc * 32 + 8 * fq;
#pragma unroll
        for (int ai = 0; ai < 2; ++ai)
#pragma unroll
            for (int m = 0; m < 4; ++m) { const size_t off = (size_t)(row0 + ai * HALF + m * 16) * ldc + col0;
#pragma unroll
                for (int bj = 0; bj < 2; ++bj) { const u32x4 gw = *(const u32x4*)(G + off + bj * HALF);
                    const f32x4 t0 = *(const f32x4*)(T + off + bj * HALF), t1 = *(const f32x4*)(T + off + bj * HALF + 4);
                    *(u32x4*)(O + off + bj * HALF) = pack8(t0 + bf_lo4(gw) * acc[ai][bj][m][0], t1 + bf_hi4(gw) * acc[ai][bj][m][1]); }
                asm volatile("" ::: "memory"); }
    }
};
struct EpiMixIn {
    static constexpr bool PERM = true, AFTER_DRAIN = false, CHAIN = false;
    bf16_t* PB; size_t segstride;
    float* HF;
    bf16_t* GA; bf16_t* GB;
    const float* COS; const float* SIN;
    __device__ __forceinline__ void operator()(const f32x4 (&acc)[2][2][4][2], const Unit& u, int wr, int wc, int fr, int fq) const {
        const int seg = u.pn >> 3, row0 = u.pm * BM + wr * 64 + fr;
        if (seg < 2) {
            bf16_t* base = PB + (size_t)seg * segstride + (u.pn & 7) * 256 + (wc >> 1) * 128 + 32 * (wc & 1) + 8 * fq;
            const int d0 = 32 * (wc & 1) + 8 * fq;
#pragma unroll
            for (int ai = 0; ai < 2; ++ai) { f32x4 cs[4][4];
#pragma unroll
                for (int m = 0; m < 4; ++m) { const size_t ro = (size_t)(row0 + ai * HALF + m * 16) * 64 + d0;
                    cs[m][0] = *(const f32x4*)(COS + ro); cs[m][1] = *(const f32x4*)(COS + ro + 4); cs[m][2] = *(const f32x4*)(SIN + ro); cs[m][3] = *(const f32x4*)(SIN + ro + 4); }
#pragma unroll
                for (int m = 0; m < 4; ++m) { const int row = row0 + ai * HALF + m * 16;
                    const f32x4 c0 = cs[m][0], c1 = cs[m][1], s0 = cs[m][2], s1 = cs[m][3];
                    const f32x4 x1a = acc[ai][0][m][0], x1b = acc[ai][0][m][1], x2a = acc[ai][1][m][0], x2b = acc[ai][1][m][1];
                    bf16_t* dst = base + (size_t)row * 2048;
                    *(u32x4*)dst = pack8(x1a * c0 - x2a * s0, x1b * c1 - x2b * s1);
                    *(u32x4*)(dst + 64) = pack8(x2a * c0 + x1a * s0, x2b * c1 + x1b * s1); }
                asm volatile("" ::: "memory"); }
        } else if (seg == 4) {
            float* base = HF + (u.pn & 7) * 256 + wc * 32 + 8 * fq;
#pragma unroll
            for (int ai = 0; ai < 2; ++ai)
#pragma unroll
                for (int m = 0; m < 4; ++m) { float* dst = base + (size_t)(row0 + ai * HALF + m * 16) * 2048;
#pragma unroll
                    for (int bj = 0; bj < 2; ++bj) { *(f32x4*)(dst + bj * HALF) = acc[ai][bj][m][0]; *(f32x4*)(dst + bj * HALF + 4) = acc[ai][bj][m][1]; } }
        } else if (seg >= 7) {
            bf16_t* base = (seg >= 9 ? GB + (u.pn - 72) * 256 : GA + (u.pn - 56) * 256) + wc * 32 + 8 * fq;
#pragma unroll
            for (int ai = 0; ai < 2; ++ai)
#pragma unroll
                for (int m = 0; m < 4; ++m) { bf16_t* dst = base + (size_t)(row0 + ai * HALF + m * 16) * 4096;
#pragma unroll
                    for (int bj = 0; bj < 2; ++bj) *(u32x4*)(dst + bj * HALF) = pack8(sigm4(acc[ai][bj][m][0]), sigm4(acc[ai][bj][m][1])); }
        } else {
            const int slot = seg <= 3 ? seg : seg - 1;
            bf16_t* base = PB + (size_t)slot * segstride + (u.pn & 7) * 256 + wc * 32 + 8 * fq;
#pragma unroll
            for (int ai = 0; ai < 2; ++ai)
#pragma unroll
                for (int m = 0; m < 4; ++m) { bf16_t* dst = base + (size_t)(row0 + ai * HALF + m * 16) * 2048;
#pragma unroll
                    for (int bj = 0; bj < 2; ++bj) *(u32x4*)(dst + bj * HALF) = pack8(acc[ai][bj][m][0], acc[ai][bj][m][1]); }
        }
    }
};

struct EpiMerge {
    static constexpr bool PERM = true, AFTER_DRAIN = false, CHAIN = true;
    const bf16_t* GA; const bf16_t* GB; bf16_t* O; int ldc;
    __device__ __forceinline__ void mid(f32x4 (&acc)[2][2][4][2], const Unit& u, int wr, int wc, int fr, int fq) const {
        const int row0 = u.pm * BM + wr * 64 + fr, col0 = u.pn * BM + wc * 32 + 8 * fq;
#pragma unroll
        for (int ai = 0; ai < 2; ++ai)
#pragma unroll
            for (int m = 0; m < 4; ++m) { const size_t off = (size_t)(row0 + ai * HALF + m * 16) * ldc + col0;
#pragma unroll
                for (int bj = 0; bj < 2; ++bj) { const u32x4 ga = *(const u32x4*)(GA + off + bj * HALF), gb = *(const u32x4*)(GB + off + bj * HALF);
                    const f32x4 b0 = bf_lo4(gb), b1 = bf_hi4(gb);
                    const f32x4 r0 = bf_lo4(ga) * (f32x4){__builtin_amdgcn_rcpf(fmaxf(b0[0], 1e-30f)), __builtin_amdgcn_rcpf(fmaxf(b0[1], 1e-30f)), __builtin_amdgcn_rcpf(fmaxf(b0[2], 1e-30f)), __builtin_amdgcn_rcpf(fmaxf(b0[3], 1e-30f))};
                    const f32x4 r1 = bf_hi4(ga) * (f32x4){__builtin_amdgcn_rcpf(fmaxf(b1[0], 1e-30f)), __builtin_amdgcn_rcpf(fmaxf(b1[1], 1e-30f)), __builtin_amdgcn_rcpf(fmaxf(b1[2], 1e-30f)), __builtin_amdgcn_rcpf(fmaxf(b1[3], 1e-30f))};
                    acc[ai][bj][m][0] = acc[ai][bj][m][0] * r0; acc[ai][bj][m][1] = acc[ai][bj][m][1] * r1; } }
    }
    __device__ __forceinline__ void operator()(const f32x4 (&acc)[2][2][4][2], const Unit& u, int wr, int wc, int fr, int fq) const {
        const int row0 = u.pm * BM + wr * 64 + fr, col0 = u.pn * BM + wc * 32 + 8 * fq;
#pragma unroll
        for (int ai = 0; ai < 2; ++ai)
#pragma unroll
            for (int m = 0; m < 4; ++m) { const size_t off = (size_t)(row0 + ai * HALF + m * 16) * ldc + col0;
#pragma unroll
                for (int bj = 0; bj < 2; ++bj) { const u32x4 gb = *(const u32x4*)(GB + off + bj * HALF);
                    *(u32x4*)(O + off + bj * HALF) = pack8(bf_lo4(gb) * acc[ai][bj][m][0], bf_hi4(gb) * acc[ai][bj][m][1]); } }
    }
};
struct EpiF32Part {
    static constexpr bool PERM = false, AFTER_DRAIN = false, CHAIN = false;
    float* P; int ldc; int kslice; size_t slice_stride;
    __device__ __forceinline__ void operator()(const f32x4 (&acc)[2][2][4][2], const Unit& u, int wr, int wc, int fr, int fq) const {
        const int row0 = u.pm * BM + wr * 64 + fr, col0 = u.pn * BM + wc * 32 + 4 * fq; float* base = P + (size_t)(u.ko / kslice) * slice_stride;
#pragma unroll
        for (int ai = 0; ai < 2; ++ai)
#pragma unroll
            for (int m = 0; m < 4; ++m) { float* rowp = base + (size_t)(row0 + ai * HALF + m * 16) * ldc + col0;
#pragma unroll
                for (int bj = 0; bj < 2; ++bj)
#pragma unroll
                    for (int n = 0; n < 2; ++n) *(f32x4*)(rowp + bj * HALF + n * 16) = acc[ai][bj][m][n]; }
    }
};
struct EpiResLN {
    static constexpr bool PERM = false, AFTER_DRAIN = false, CHAIN = false;
    const float* Yp; const float* ST; const float* G; const float* B; float* Y; int ldc; float alpha, beta;
    __device__ __forceinline__ void operator()(const f32x4 (&acc)[2][2][4][2], const Unit& u, int wr, int wc, int fr, int fq) const {
        const int row0 = u.pm * BM + wr * 64 + fr, col0 = u.pn * BM + wc * 32 + 4 * fq;
        f32x4 g4[2][2], b4[2][2];
#pragma unroll
        for (int bj = 0; bj < 2; ++bj)
#pragma unroll
            for (int n = 0; n < 2; ++n) { g4[bj][n] = *(const f32x4*)(G + col0 + bj * HALF + n * 16); b4[bj][n] = *(const f32x4*)(B + col0 + bj * HALF + n * 16); }
#pragma unroll
        for (int ai = 0; ai < 2; ++ai)
#pragma unroll
            for (int m = 0; m < 4; ++m) { const int row = row0 + ai * HALF + m * 16; const size_t off = (size_t)row * ldc + col0;
                const float mean = ST[2 * row], rstd = ST[2 * row + 1];
#pragma unroll
                for (int bj = 0; bj < 2; ++bj)
#pragma unroll
                    for (int n = 0; n < 2; ++n) { const f32x4 yp = *(const f32x4*)(Yp + off + bj * HALF + n * 16);
                        const f32x4 x = (yp - mean) * rstd * g4[bj][n] + b4[bj][n];
                        *(f32x4*)(Y + off + bj * HALF + n * 16) = x * alpha + acc[ai][bj][m][n] * beta; }
                asm volatile("" ::: "memory"); }
    }
};
template <class Epi, class Sched, bool ALIGN_EPI = false, bool SP2 = false>
__device__ __forceinline__ void gemm_phase(PG8_LAS unsigned char* lds, const Gemm g, const Sched& S, const Epi& E, const int wid) {
    const int lane = mk_lane(), tid = wid * 64 + lane, wr = wid >> 2, wc = wid & 3, fr = lane & 15, fq = lane >> 4;
    const int K = g.K, LD = g.ld, nt = K / BK;
    unsigned voffA[2], voffB[2];
#pragma unroll
    for (int i = 0; i < 2; ++i) { int R, C; stage_rc(tid * 16 + i * 8192, R, C); const int Rb = Epi::PERM ? ((R & ~31) + perm32(R & 31)) : R;
        voffA[i] = (unsigned)(R * LD + C) * 2u; voffB[i] = (unsigned)(Rb * LD + C) * 2u; }
    const size_t kstep = (size_t)(BK * 2);
    const size_t hstep = (size_t)HALF * LD * 2;
    const size_t tstep = 2 * hstep;
    const unsigned ldsw = (unsigned)wid * 1024u;
    const int aoff = lds_byte(wr * 64 + fr, fq * 8), boff = lds_byte(wc * 32 + fr, fq * 8);
#define PG8_SA(b, h) (((b) * 2 + (h)) * HTB)
#define PG8_SB(b, h) ((4 + (b) * 2 + (h)) * HTB)
#define PG8_STAGE(bufoff, gbase, voff) do { _Pragma("unroll") for (int _i = 0; _i < 2; ++_i) \
        __builtin_amdgcn_global_load_lds((const unsigned*)((const char*)(gbase) + (voff)[_i]), (PG8_LAS unsigned*)(lds + (bufoff) + ldsw + _i * 8192), 16, 0, 0); } while (0)
#define PG8_LDA(dst, b, h) do { _Pragma("unroll") for (int m = 0; m < 4; ++m) _Pragma("unroll") for (int k = 0; k < 2; ++k) dst[m][k] = *(const PG8_LAS bf16x8*)(lds + PG8_SA(b, h) + aoff + m * 2048 + k * 1024); } while (0)
#define PG8_LDB(dst, b, h) do { _Pragma("unroll") for (int n = 0; n < 2; ++n) _Pragma("unroll") for (int k = 0; k < 2; ++k) dst[n][k] = *(const PG8_LAS bf16x8*)(lds + PG8_SB(b, h) + boff + n * 2048 + k * 1024); } while (0)
#define PG8_MMA(ai, bj, At, Bt) do { __builtin_amdgcn_s_setprio(1); _Pragma("unroll") for (int m = 0; m < 4; ++m) _Pragma("unroll") for (int n = 0; n < 2; ++n) _Pragma("unroll") for (int k = 0; k < 2; ++k) \
        acc[ai][bj][m][n] = __builtin_amdgcn_mfma_f32_16x16x32_bf16(Bt[n][k], At[m][k], acc[ai][bj][m][n], 0, 0, 0); __builtin_amdgcn_s_setprio(0); } while (0)
#define PG8_WAIT_V(n) asm volatile("s_waitcnt vmcnt(" #n ")" ::: "memory")
#define PG8_WAIT_L(n) asm volatile("s_waitcnt lgkmcnt(" #n ")" ::: "memory")
#define PG8_BAR __builtin_amdgcn_s_barrier()
#define PG8_SCHED __builtin_amdgcn_sched_barrier(0)
    Unit cur, nxt; int ui = 0;
    if (!S.next(0, cur)) return;
    f32x4 acc[2][2][4][2];
#pragma unroll
    for (int a = 0; a < 2; ++a)
#pragma unroll
        for (int b = 0; b < 2; ++b)
#pragma unroll
            for (int m = 0; m < 4; ++m)
#pragma unroll
                for (int n = 0; n < 2; ++n) acc[a][b][m][n] = (f32x4){0.f, 0.f, 0.f, 0.f};
    bf16x8 At[4][2], B0[2][2], B1[2][2];
#define PG8_UA(u) ((const char*)((u).seg ? g.A2 : g.A) + (size_t)(u).pm * tstep + (size_t)(u).ko * 2)
#define PG8_UB(u) ((const char*)((u).seg ? g.Bt2 : g.Bt) + (size_t)(u).pn * tstep + (size_t)(u).ko * 2)
    const char* cA = PG8_UA(cur); const char* cB = PG8_UB(cur);
    S.a_ready(cur);
    if constexpr (SP2) {
        PG8_STAGE(PG8_SB(0, 0), cB, voffB); PG8_STAGE(PG8_SB(0, 1), cB + hstep, voffB); PG8_STAGE(PG8_SA(0, 0), cA, voffA); PG8_STAGE(PG8_SA(0, 1), cA + hstep, voffA);
        if (wr == 1) PG8_BAR;
        PG8_WAIT_V(2); PG8_BAR;
        PG8_STAGE(PG8_SB(1, 0), cB + kstep, voffB); PG8_STAGE(PG8_SA(1, 0), cA + kstep, voffA); PG8_STAGE(PG8_SB(1, 1), cB + hstep + kstep, voffB);
        PG8_WAIT_V(6); PG8_BAR;
    } else {
        PG8_STAGE(PG8_SB(0, 0), cB, voffB); PG8_STAGE(PG8_SA(0, 0), cA, voffA); PG8_STAGE(PG8_SB(0, 1), cB + hstep, voffB); PG8_STAGE(PG8_SA(0, 1), cA + hstep, voffA);
        if (wr == 1) PG8_BAR;
        PG8_WAIT_V(4); PG8_BAR;
        PG8_STAGE(PG8_SB(1, 0), cB + kstep, voffB); PG8_STAGE(PG8_SA(1, 0), cA + kstep, voffA); PG8_STAGE(PG8_SB(1, 1), cB + hstep + kstep, voffB);
        PG8_WAIT_V(6); PG8_BAR;
    }
    for (;;) {
        const bool has_next = S.next(ui + 1, nxt);
        const char* nA = has_next ? PG8_UA(nxt) : cA; const char* nB = has_next ? PG8_UB(nxt) : cB;
        for (int t = 0; t < nt; t += 2) {
            const bool last = (t == nt - 2);
            const char* a1 = cA + (size_t)(t + 1) * kstep;
            const char* a2 = last ? nA : cA + (size_t)(t + 2) * kstep; const char* b2 = last ? nB : cB + (size_t)(t + 2) * kstep;
            const char* a3 = a2 + kstep; const char* b3 = b2 + kstep;
            if (last && has_next) S.a_ready(nxt);
            if constexpr (SP2) {
            PG8_LDB(B0, 0, 0); PG8_LDB(B1, 0, 1); PG8_SCHED; PG8_LDA(At, 0, 0); PG8_STAGE(PG8_SA(1, 1), a1 + hstep, voffA);
            PG8_WAIT_V(8); PG8_WAIT_L(0); PG8_BAR; PG8_MMA(0, 0, At, B0); PG8_MMA(0, 1, At, B1); PG8_BAR; PG8_SCHED;
            PG8_LDA(At, 0, 1); PG8_STAGE(PG8_SB(0, 0), b2, voffB); PG8_STAGE(PG8_SB(0, 1), b2 + hstep, voffB); PG8_STAGE(PG8_SA(0, 0), a2, voffA);
            PG8_WAIT_V(8); PG8_WAIT_L(0); PG8_BAR; PG8_MMA(1, 0, At, B0); PG8_MMA(1, 1, At, B1); PG8_BAR; PG8_SCHED;
            PG8_LDB(B0, 1, 0); PG8_LDB(B1, 1, 1); PG8_SCHED; PG8_LDA(At, 1, 0); PG8_STAGE(PG8_SA(0, 1), a2 + hstep, voffA);
            PG8_WAIT_V(8); PG8_WAIT_L(0); PG8_BAR; PG8_MMA(0, 0, At, B0); PG8_MMA(0, 1, At, B1); PG8_BAR; PG8_SCHED;
            PG8_LDA(At, 1, 1); PG8_STAGE(PG8_SB(1, 0), b3, voffB); PG8_STAGE(PG8_SB(1, 1), b3 + hstep, voffB); PG8_STAGE(PG8_SA(1, 0), a3, voffA);
            PG8_WAIT_V(8); PG8_WAIT_L(0); PG8_BAR; PG8_MMA(1, 0, At, B0); PG8_MMA(1, 1, At, B1); PG8_BAR; PG8_SCHED;
            } else {
            PG8_LDB(B0, 0, 0); PG8_SCHED; PG8_LDA(At, 0, 0); PG8_STAGE(PG8_SA(1, 1), a1 + hstep, voffA);
            PG8_WAIT_L(8); PG8_BAR; PG8_WAIT_L(0); PG8_MMA(0, 0, At, B0); PG8_BAR; PG8_SCHED;
            PG8_LDB(B1, 0, 1); PG8_STAGE(PG8_SB(0, 0), b2, voffB);
            PG8_BAR; PG8_WAIT_L(0); PG8_MMA(0, 1, At, B1); PG8_BAR;
            PG8_LDA(At, 0, 1); PG8_STAGE(PG8_SA(0, 0), a2, voffA);
            PG8_BAR; PG8_WAIT_L(0); PG8_MMA(1, 0, At, B0); PG8_BAR; PG8_SCHED;
            PG8_STAGE(PG8_SB(0, 1), b2 + hstep, voffB);
            PG8_WAIT_V(6); PG8_BAR; PG8_MMA(1, 1, At, B1); PG8_BAR;
            PG8_LDB(B0, 1, 0); PG8_SCHED; PG8_LDA(At, 1, 0); PG8_STAGE(PG8_SA(0, 1), a2 + hstep, voffA);
            PG8_WAIT_L(8); PG8_BAR; PG8_WAIT_L(0); PG8_MMA(0, 0, At, B0); PG8_BAR; PG8_SCHED;
            PG8_LDB(B1, 1, 1); PG8_STAGE(PG8_SB(1, 0), b3, voffB);
            PG8_BAR; PG8_WAIT_L(0); PG8_MMA(0, 1, At, B1); PG8_BAR;
            PG8_LDA(At, 1, 1); PG8_STAGE(PG8_SA(1, 0), a3, voffA);
            PG8_BAR; PG8_WAIT_L(0); PG8_MMA(1, 0, At, B0); PG8_BAR; PG8_SCHED;
            PG8_STAGE(PG8_SB(1, 1), b3 + hstep, voffB);
            PG8_WAIT_V(6); PG8_BAR; PG8_MMA(1, 1, At, B1); PG8_BAR;
            }
        }
        if constexpr (ALIGN_EPI) { if (wr == 0) PG8_BAR; }
        bool keep_acc = false;
        if constexpr (Epi::CHAIN) { if (cur.seg == 0) { E.mid(acc, cur, wr, wc, fr, fq); keep_acc = true; } else E(acc, cur, wr, wc, fr, fq); }
        else if constexpr (!Epi::AFTER_DRAIN) { E(acc, cur, wr, wc, fr, fq); S.done(cur); }
        if (!has_next) break;
        if (!keep_acc) {
#pragma unroll
        for (int a = 0; a < 2; ++a)
#pragma unroll
            for (int b = 0; b < 2; ++b)
#pragma unroll
                for (int m = 0; m < 4; ++m)
#pragma unroll
                    for (int n = 0; n < 2; ++n) acc[a][b][m][n] = (f32x4){0.f, 0.f, 0.f, 0.f};
        }
        cur = nxt; cA = nA; cB = nB; ++ui;
        if constexpr (ALIGN_EPI) { if (wr == 1) PG8_BAR; }
    }
    PG8_WAIT_V(0);
    if constexpr (!ALIGN_EPI) { if (wr == 0) PG8_BAR; }
    PG8_BAR;
    if constexpr (Epi::AFTER_DRAIN) { E.fused(acc, cur, wr, wc, fr, fq, lds, wid, lane); S.done(cur); }
#undef PG8_UA
#undef PG8_UB
#undef PG8_SA
#undef PG8_SB
#undef PG8_STAGE
#undef PG8_LDA
#undef PG8_LDB
#undef PG8_MMA
#undef PG8_WAIT_V
#undef PG8_WAIT_L
#undef PG8_BAR
#undef PG8_SCHED
}
}
namespace attn {
constexpr int D = 128;
constexpr float THR = 8.f;
constexpr bool WSKIP = false;
constexpr float SCALE = 0.08838834764831845f;
constexpr int NW = 8, QBLK = 32, KVBLK = 64, QB = NW * QBLK;
constexpr int SHM_V = KVBLK * D * 2, SHM_K = KVBLK * D * 2;
constexpr int LDS_BYTES = 2 * SHM_V + 2 * SHM_K + NW * 64 * 4;

typedef unsigned short bf16;
typedef short bf16x8 __attribute__((ext_vector_type(8)));
typedef short s16x4 __attribute__((ext_vector_type(4)));
typedef float f32x16 __attribute__((ext_vector_type(16)));
typedef float f32x4 __attribute__((ext_vector_type(4)));
typedef unsigned u32x4 __attribute__((ext_vector_type(4)));
template <class A, class Bt> struct same_t { static constexpr bool v = false; };
template <class A> struct same_t<A, A> { static constexpr bool v = true; };

#define KSWZ(row, colB) ((row) * 256 + ((colB) ^ (((row) & 7) << 4)))
#define SBAR() __builtin_amdgcn_sched_barrier(0)
__device__ __forceinline__ int v_st(int k, int c) { const int kk = (k & ~0xC) | ((k & 4) << 1) | ((k & 8) >> 1); return ((kk >> 3) * 4 + (c >> 5)) * 512 + ((kk & 7) * 32 + (c & 31)) * 2; }
__device__ __forceinline__ int v_rd_base(int lane) { return ((lane & 3) << 3) | (((lane >> 2) & 3) << 6) | (((lane >> 4) & 1) << 5) | (((lane >> 5) & 1) << 8); }
constexpr int v_rd_off(int d0, int ks, int half) { return d0 * 512 + ks * 4096 + half * 2048; }
__device__ __forceinline__ int crow(int r, int hi) { return (r & 3) + 8 * (r >> 2) + 4 * hi; }
__device__ __forceinline__ unsigned cvtpk(float lo, float hi) {
    unsigned r; asm volatile("v_cvt_pk_bf16_f32 %0, %1, %2" : "=v"(r) : "v"(lo), "v"(hi)); return r;
}
__device__ __forceinline__ bf16x8 pack8(f32x4 a, f32x4 b) {
    u32x4 w = {cvtpk(a[0], a[1]), cvtpk(a[2], a[3]), cvtpk(b[0], b[1]), cvtpk(b[2], b[3])};
    return *reinterpret_cast<bf16x8*>(&w);
}
template <class T> __device__ __forceinline__ bf16x8 load8(const T* p) {
    if constexpr (same_t<T, float>::v) { return pack8(*(const f32x4*)p, *(const f32x4*)(p + 4)); }
    else { return *reinterpret_cast<const bf16x8*>(p); }
}
__device__ __forceinline__ void mask_tile(f32x16& p0, f32x16& p1, int dq, unsigned W) {
    const float NEG = -__builtin_inff();
#pragma unroll
    for (int r = 0; r < 16; ++r) {
        const int c = (r & 3) + 8 * (r >> 2);
        if ((unsigned)(dq - c) >= W) p0[r] = NEG;
        if ((unsigned)(dq - c - 32) >= W) p1[r] = NEG;
    }
}
__device__ __forceinline__ void partialSM(f32x16& p0, f32x16& p1, float& m_reg, float& mn, float& alpha) {
    float pmax = p0[0]; for (int r = 1; r < 16; ++r) pmax = fmaxf(pmax, p0[r]); for (int r = 0; r < 16; ++r) pmax = fmaxf(pmax, p1[r]);
    { auto rr = __builtin_amdgcn_permlane32_swap(__float_as_uint(pmax), __float_as_uint(pmax), false, false);
      pmax = fmaxf(__uint_as_float(rr[0]), __uint_as_float(rr[1])); }
    constexpr float C2 = 1.4426950408889634f * SCALE;
    if (__builtin_expect(__all((pmax - m_reg) * SCALE <= THR), 1)) { mn = m_reg; alpha = 1.f; }
    else { mn = fmaxf(m_reg, pmax); alpha = __builtin_amdgcn_exp2f((m_reg - mn) * C2); m_reg = mn; }
    const float mnL = -mn * C2;
    for (int r = 0; r < 16; ++r) p0[r] = fmaf(p0[r], C2, mnL); for (int r = 0; r < 16; ++r) p1[r] = fmaf(p1[r], C2, mnL);
    for (int r = 0; r < 16; ++r) p0[r] = __builtin_amdgcn_exp2f(p0[r]);
}
__device__ __forceinline__ void finishSM(f32x16& p0, f32x16& p1, float alpha, float& l_reg, bf16x8& pa0, bf16x8& pa1, bf16x8& pa2, bf16x8& pa3) {
    for (int r = 0; r < 16; ++r) p1[r] = __builtin_amdgcn_exp2f(p1[r]);
    float ps = 0; for (int r = 0; r < 16; ++r) ps += p0[r]; for (int r = 0; r < 16; ++r) ps += p1[r];
    { auto rr = __builtin_amdgcn_permlane32_swap(__float_as_uint(ps), __float_as_uint(ps), false, false);
      ps = __uint_as_float(rr[0]) + __uint_as_float(rr[1]); }
    l_reg = l_reg * alpha + ps;
#define PK4(P, B_, OUT) do { unsigned a0 = cvtpk(P[B_+0], P[B_+1]), a1 = cvtpk(P[B_+2], P[B_+3]);                          \
        unsigned b0 = cvtpk(P[B_+4], P[B_+5]), b1 = cvtpk(P[B_+6], P[B_+7]);                                             \
        auto r0 = __builtin_amdgcn_permlane32_swap(a0, b0, false, false); auto r1 = __builtin_amdgcn_permlane32_swap(a1, b1, false, false); \
        u32x4 w = {r0[0], r1[0], r0[1], r1[1]}; OUT = *reinterpret_cast<bf16x8*>(&w); } while (0)
    PK4(p0, 0, pa0); PK4(p0, 8, pa1); PK4(p1, 0, pa2); PK4(p1, 8, pa3);
#undef PK4
}
template <int KB, bool SK>
__device__ __forceinline__ void qkt(f32x16& p0, f32x16& p1, const char* K_lds, int r32, int hi, const bf16x8* qr, bool act) {
    if (SK && !act) { const float NEG = -__builtin_inff();
#pragma unroll
        for (int r = 0; r < 16; ++r) { p0[r] = NEG; p1[r] = NEG; } return; }
    p0 = f32x16{}; p1 = f32x16{};
    const char* kb[4];
#pragma unroll
    for (int dd = 0; dd < 4; ++dd) kb[dd] = K_lds + KB * SHM_K + KSWZ(r32, (dd * 16 + hi * 8) * 2);
#pragma unroll
    for (int d0 = 0; d0 < 8; ++d0) { const char* a = kb[d0 & 3] + (d0 >> 2) * 128;
        bf16x8 b0 = *reinterpret_cast<const bf16x8*>(a);
        bf16x8 b1 = *reinterpret_cast<const bf16x8*>(a + 32 * 256);
        p0 = __builtin_amdgcn_mfma_f32_32x32x16_bf16(b0, qr[d0], p0, 0, 0, 0);
        p1 = __builtin_amdgcn_mfma_f32_32x32x16_bf16(b1, qr[d0], p1, 0, 0, 0); }
}
template <int VB, bool SK>
__device__ __forceinline__ void pv_tile(f32x16* o, int vb0, bf16x8 pa0, bf16x8 pa1, bf16x8 pa2, bf16x8 pa3, bool act) {
    if (SK && !act) return;
#define TRRD(dst, off) asm volatile("ds_read_b64_tr_b16 %0, %1 offset:%2" : "=&v"(dst) : "v"(vb0), "i"(off) : "memory")
#define PV_D0(d0) do { s16x4 l0, l1, l2, l3, h0, h1, h2, h3; constexpr int b_ = VB * SHM_V + v_rd_off(d0, 0, 0);     \
        TRRD(l0, b_); TRRD(h0, b_ + 2048); TRRD(l1, b_ + 4096); TRRD(h1, b_ + 6144); TRRD(l2, b_ + 8192); TRRD(h2, b_ + 10240); TRRD(l3, b_ + 12288); TRRD(h3, b_ + 14336); \
        asm volatile("s_waitcnt lgkmcnt(0)" ::: "memory"); SBAR();                 \
        o[d0] = __builtin_amdgcn_mfma_f32_32x32x16_bf16(pa0, (bf16x8){l0[0], l0[1], l0[2], l0[3], h0[0], h0[1], h0[2], h0[3]}, o[d0], 0, 0, 0);   \
        o[d0] = __builtin_amdgcn_mfma_f32_32x32x16_bf16(pa1, (bf16x8){l1[0], l1[1], l1[2], l1[3], h1[0], h1[1], h1[2], h1[3]}, o[d0], 0, 0, 0);   \
        o[d0] = __builtin_amdgcn_mfma_f32_32x32x16_bf16(pa2, (bf16x8){l2[0], l2[1], l2[2], l2[3], h2[0], h2[1], h2[2], h2[3]}, o[d0], 0, 0, 0);   \
        o[d0] = __builtin_amdgcn_mfma_f32_32x32x16_bf16(pa3, (bf16x8){l3[0], l3[1], l3[2], l3[3], h3[0], h3[1], h3[2], h3[3]}, o[d0], 0, 0, 0); } while (0)
    PV_D0(0); PV_D0(1); PV_D0(2); PV_D0(3);
#undef PV_D0
#undef TRRD
}

template <class TIn, class TOut> struct BlockRef { const TIn* Q; const TIn* K; const TIn* V; TOut* O; int P0; };
template <class TIn> struct Seam {
    bf16x8 qr[8];
    bf16x8 st_v0, st_v1, st_k0, st_k1; f32x4 sf0, sf1, sf2, sf3;
    f32x4 tq[16];
};
__device__ __forceinline__ int swa_jlo(int P0, int W) { const int lowk = P0 - W + 1; return lowk > 0 ? lowk / KVBLK : 0; }
#define ROW(p, k0, rr) ((p) + (size_t)((k0) + (rr)) * KS + sc)
#define VMW() asm volatile("s_waitcnt vmcnt(0)" ::: "memory")
#define VMWN(n) asm volatile("s_waitcnt vmcnt(%0)" :: "i"(n) : "memory")
#define SLOAD_H(Kp, Vp, k0) do { S.st_v0 = load8<TIn>(ROW(Vp, k0, sr)); S.st_v1 = load8<TIn>(ROW(Vp, k0, 32 + sr));              \
                         S.st_k0 = load8<TIn>(ROW(Kp, k0, sr)); S.st_k1 = load8<TIn>(ROW(Kp, k0, 32 + sr)); } while (0)
#define SWRITE_HK(bf) do { *(bf16x8*)(K_lds + (bf) * SHM_K + kws) = S.st_k0; *(bf16x8*)(K_lds + (bf) * SHM_K + kws + 32 * 256) = S.st_k1; } while (0)
#define SWRITE_HV(bf) do { *(bf16x8*)(V_lds + (bf) * SHM_V + vst0) = S.st_v0; *(bf16x8*)(V_lds + (bf) * SHM_V + vst1) = S.st_v1; } while (0)
#define SWRITE_H(bf) do { SWRITE_HV(bf); SWRITE_HK(bf); } while (0)
#define SLOAD_F(p, k0) do { S.sf0 = *(const f32x4*)ROW(p, k0, sr); S.sf1 = *(const f32x4*)(ROW(p, k0, sr) + 4);                \
                            S.sf2 = *(const f32x4*)ROW(p, k0, 32 + sr); S.sf3 = *(const f32x4*)(ROW(p, k0, 32 + sr) + 4); } while (0)
#define SWRITE_KF(bf) do { *(bf16x8*)(K_lds + (bf) * SHM_K + kws) = pack8(S.sf0, S.sf1); *(bf16x8*)(K_lds + (bf) * SHM_K + kws + 32 * 256) = pack8(S.sf2, S.sf3); } while (0)
#define SWRITE_VF(bf) do { *(bf16x8*)(V_lds + (bf) * SHM_V + vst0) = pack8(S.sf0, S.sf1); *(bf16x8*)(V_lds + (bf) * SHM_V + vst1) = pack8(S.sf2, S.sf3); } while (0)
template <class TIn, class TOut, int QS, int KS, int OS>
__device__ __forceinline__ void causal_swa_prime(const BlockRef<TIn, TOut>& cur, int W, char* lds, Seam<TIn>& S, const int wid) {
    constexpr bool F32 = same_t<TIn, float>::v;
    const int lane = mk_lane(), tid = wid * 64 + lane, r32 = lane & 31, hi = lane >> 5;
    const int sr = tid >> 4, sc = (tid & 15) * 8, kws = KSWZ(sr, sc * 2); char* K_lds = lds + 2 * SHM_V;
    const int kb0 = swa_jlo(cur.P0, W) * KVBLK;
    for (int d0 = 0; d0 < 8; ++d0) S.qr[d0] = load8<TIn>(cur.Q + (size_t)(wid * QBLK + r32) * QS + d0 * 16 + hi * 8);
    if constexpr (F32) { SLOAD_F((const float*)cur.K, kb0); VMW(); SWRITE_KF(0); SBAR(); SLOAD_F((const float*)cur.V, kb0); }
    else { SLOAD_H(cur.K, cur.V, kb0); VMW(); SWRITE_HK(0); }
    __syncthreads();
}
template <class TIn, class TOut, int QS, int KS, int OS>
__device__ __forceinline__ void causal_swa_block(const BlockRef<TIn, TOut>& cur, const BlockRef<TIn, TOut>& nxt, int skv, int W, char* lds, Seam<TIn>& S, const int wid) {
    constexpr bool F32 = same_t<TIn, float>::v;
    const int lane = mk_lane(), tid = wid * 64 + lane, r32 = lane & 31, hi = lane >> 5;
    const int j_lo = swa_jlo(cur.P0, W);
    int j_hi = (cur.P0 + QB - 1) / KVBLK + 1; if (j_hi > skv / KVBLK) j_hi = skv / KVBLK;
    const int NT = j_hi - j_lo;
    const int kbn = swa_jlo(nxt.P0, W) * KVBLK;
    const int qlo = cur.P0 + wid * QBLK, qm = qlo + r32 - 4 * hi;
    char* V_lds = lds; char* K_lds = lds + 2 * SHM_V;
    float* ws = (float*)(lds + 2 * SHM_V + 2 * SHM_K) + wid * 64; float* li_l = ws, * al_l = ws + 32;
    float m_reg = -1e30f, l_reg = 0; f32x16 o[4] = {};
    const int sr = tid >> 4, sc = (tid & 15) * 8, vst0 = v_st(sr, sc), vst1 = v_st(32 + sr, sc), kws = KSWZ(sr, sc * 2);
    const int vb0 = (int)(uintptr_t)V_lds + v_rd_base(lane);
    const TIn* Kh = cur.K; const TIn* Vh = cur.V;
#define RESC(a) do { if (__any((a) < 1.f)) { if (hi == 0) al_l[r32] = (a); asm volatile("s_waitcnt lgkmcnt(0)" ::: "memory");              \
                     for (int d_ = 0; d_ < 4; ++d_) for (int r = 0; r < 16; ++r) o[d_][r] *= al_l[crow(r, hi)]; } } while (0)
#define KBASE(t) ((j_lo + (t)) * KVBLK)
#define ACT(t) (KBASE(t) <= qlo + QBLK - 1 && KBASE(t) + KVBLK - 1 >= qlo - W + 1)
#define MASKT(P0_, P1_, t) do { const int kb_ = KBASE(t); if ((!SK || ACT(t)) && (kb_ + KVBLK - 1 > qlo || kb_ <= qlo + QBLK - 1 - W)) mask_tile(P0_, P1_, qm - kb_, (unsigned)W); } while (0)
    constexpr int NQL = F32 ? 16 : 8;
    constexpr bool SK = WSKIP && !F32;
#define SEAM_K0() do { VMWN(NQL); if constexpr (F32) { SWRITE_KF(0); SBAR(); SLOAD_F((const float*)nxt.V, kbn); } else { SWRITE_HK(0); } SBAR(); } while (0)
    f32x16 pA0, pA1, pB0, pB1; float mnA, mnB, alA, alB; bf16x8 pa0, pa1, pa2, pa3;
    if constexpr (F32) { VMW(); SWRITE_VF(0); SBAR(); } else { SWRITE_HV(0); SBAR(); }
    if (NT > 1) { if constexpr (F32) SLOAD_F((const float*)Kh, KBASE(1)); else SLOAD_H(Kh, Vh, KBASE(1)); }
    SBAR(); qkt<0, SK>(pA0, pA1, K_lds, r32, hi, S.qr, ACT(0));
    if constexpr (F32) { if (NT > 1) { VMW(); SWRITE_KF(1); SBAR(); SLOAD_F((const float*)Vh, KBASE(1)); } }
    MASKT(pA0, pA1, 0); partialSM(pA0, pA1, m_reg, mnA, alA);
    if (NT > 1) { VMW(); if constexpr (F32) { SWRITE_VF(1); SBAR(); if (NT > 2) SLOAD_F((const float*)Kh, KBASE(2)); } else SWRITE_H(1); }
    __syncthreads();
#define HALF_STEP(PX0, PX1, mnX, alX, PY0, PY1, alY, t, KB, VB, SB) do {                                                      \
        SBAR(); qkt<KB, SK>(PX0, PX1, K_lds, r32, hi, S.qr, ACT(t));                                             \
        finishSM(PY0, PY1, alY, l_reg, pa0, pa1, pa2, pa3); SBAR();                                                           \
        if ((t) + 1 < NT) { if constexpr (F32) { VMW(); SWRITE_KF(SB); SBAR(); SLOAD_F((const float*)Vh, KBASE((t) + 1)); }  \
                            else { SLOAD_H(Kh, Vh, KBASE((t) + 1)); } SBAR(); }                                               \
        pv_tile<VB, SK>(o, vb0, pa0, pa1, pa2, pa3, ACT((t) - 1)); MASKT(PX0, PX1, (t)); partialSM(PX0, PX1, m_reg, mnX, alX);                                        \
        __syncthreads();                                                                                                      \
        if ((t) + 1 < NT) { VMW(); if constexpr (F32) { SWRITE_VF(SB); SBAR(); if ((t) + 2 < NT) SLOAD_F((const float*)Kh, KBASE((t) + 2)); } \
                            else { SWRITE_H(SB); } }                                                                          \
        RESC(alX); __syncthreads(); } while (0)
    for (int t = 1; t + 1 < NT; t += 2) {
        HALF_STEP(pB0, pB1, mnB, alB, pA0, pA1, alA, t, 1, 0, 0);
        HALF_STEP(pA0, pA1, mnA, alA, pB0, pB1, alB, t + 1, 0, 1, 1);
    }
    const bool even = (NT & 1) == 0;
    if (even) { SBAR(); qkt<1, SK>(pB0, pB1, K_lds, r32, hi, S.qr, ACT(NT - 1)); SBAR(); }
#define QROW(e) (nxt.Q + (size_t)(wid * QBLK + r32) * QS + ((e) >> 1) * 16 + hi * 8 + ((e) & 1) * 4)
    if constexpr (F32) { SLOAD_F((const float*)nxt.K, kbn); SBAR();
#pragma unroll
        for (int e = 0; e < 8; ++e) S.tq[e] = *(const f32x4*)QROW(e); }
    else { SLOAD_H(nxt.K, nxt.V, kbn); SBAR();
#pragma unroll
        for (int d0 = 0; d0 < 8; ++d0) S.qr[d0] = load8<TIn>(nxt.Q + (size_t)(wid * QBLK + r32) * QS + d0 * 16 + hi * 8); }
    SBAR();
    finishSM(pA0, pA1, alA, l_reg, pa0, pa1, pa2, pa3); SBAR();
    if constexpr (F32) {
#pragma unroll
        for (int e = 8; e < 16; ++e) S.tq[e] = *(const f32x4*)QROW(e); SBAR(); }
#undef QROW
    pv_tile<0, SK>(o, vb0, pa0, pa1, pa2, pa3, ACT(even ? NT - 2 : NT - 1));
    if (even) { MASKT(pB0, pB1, NT - 1); partialSM(pB0, pB1, m_reg, mnB, alB); __syncthreads(); RESC(alB);
        finishSM(pB0, pB1, alB, l_reg, pa0, pa1, pa2, pa3); SBAR(); pv_tile<1, SK>(o, vb0, pa0, pa1, pa2, pa3, ACT(NT - 1)); }
    SBAR(); SEAM_K0();
    if (hi == 0) li_l[r32] = l_reg; asm volatile("s_waitcnt lgkmcnt(0)" ::: "memory");
    float rli[16];
#pragma unroll
    for (int r = 0; r < 16; ++r) rli[r] = __builtin_amdgcn_rcpf(li_l[crow(r, hi)]);
    TOut* Ow = cur.O + (size_t)(wid * QBLK) * OS;
#pragma unroll
    for (int r = 0; r < 16; ++r) { const int orow = crow(r, hi);
#pragma unroll
        for (int d0 = 0; d0 < 4; ++d0) { const float v = o[d0][r] * rli[r];
            if constexpr (same_t<TOut, float>::v) { Ow[(size_t)orow * OS + d0 * 32 + r32] = v; }
            else { const float vn = __shfl_xor(v, 1);
                   if ((r32 & 1) == 0) *(unsigned*)(Ow + (size_t)orow * OS + d0 * 32 + r32) = cvtpk(v, vn); } } }
    if constexpr (F32) {
#pragma unroll
        for (int d0 = 0; d0 < 8; ++d0) S.qr[d0] = pack8(S.tq[2 * d0], S.tq[2 * d0 + 1]); }
    __syncthreads();
#undef RESC
#undef KBASE
#undef ACT
#undef MASKT
#undef SEAM_K0
#undef HALF_STEP
}
#undef ROW
#undef VMW
#undef VMWN
#undef SLOAD_H
#undef SWRITE_HK
#undef SWRITE_HV
#undef SWRITE_H
#undef SLOAD_F
#undef SWRITE_KF
#undef SWRITE_VF
}
constexpr int NWAVES = 8;
#ifndef MK_N_LAUNCHES
#define MK_N_LAUNCHES 1
#endif
constexpr int NPHASES = 18;
constexpr int N_LAUNCHES = MK_N_LAUNCHES;
static_assert(N_LAUNCHES == 1 || N_LAUNCHES == NPHASES, "MK_N_LAUNCHES: 1 or NPHASES");

constexpr int SEQ = 8192, DM = 4096, DFF = 11008, NMIX = 22528, MEM = 256;
constexpr int DAW = 2048, HGW = 2048, XAW = 512;
constexpr float LN_EPS = 1e-5f;
constexpr int DOWN_TAIL_ITEMS = 22016;
constexpr float DN_ALPHA = 1.189207115002721f;
constexpr float LAMBDA_INIT = 0.2f;
constexpr size_t MiB = 1u << 20;
constexpr size_t WS_CTL = 0, CTL_ZERO_BYTES = 1 * MiB;
constexpr size_t WS_LB = 1 * MiB;
constexpr size_t WS_LAM = WS_LB + 8192;
constexpr size_t WS_ST = WS_LB + 65536;
constexpr size_t WS_COS = 2 * MiB, WS_SIN = 4 * MiB;
constexpr size_t WS_DEC = 6 * MiB;
constexpr size_t WS_XKV = 7 * MiB;
constexpr size_t WS_MEMB = 8 * MiB;
constexpr size_t WS_XQ = 10 * MiB, WS_XO = 18 * MiB;
constexpr size_t WS_WXQ = 26 * MiB, WS_WXKV = 30 * MiB, WS_WXO = 38 * MiB, WS_WDA = 42 * MiB, WS_WHG = 58 * MiB, WS_WMO = 74 * MiB, WS_WMI = 106 * MiB, WS_W2A = 282 * MiB, WS_W2D = 454 * MiB;
constexpr size_t WS_R1 = 540 * MiB;
constexpr size_t WS_W1A = WS_R1, WS_W1D = WS_R1 + 172 * MiB;
constexpr size_t WS_PB = WS_R1, PB_SEG = 32 * MiB;
constexpr size_t WS_HF = WS_R1 + 192 * MiB;
constexpr size_t WS_XB = 798 * MiB;
constexpr size_t WS_Y = 862 * MiB;
constexpr size_t WS_XF = 990 * MiB;
constexpr size_t WS_H = 1118 * MiB;
constexpr size_t WS_SLT = WS_H;
constexpr size_t WS_GA = 1290 * MiB, WS_GB = 1354 * MiB;
constexpr size_t WS_O1 = 1418 * MiB, WS_O2 = 1482 * MiB;
constexpr size_t WS_XQP = WS_O2;
constexpr size_t WS_OA = 1546 * MiB, WS_OB = 1578 * MiB;
constexpr size_t WS_END = 1610 * MiB;
static_assert(WS_W1D + (size_t)DM * DFF * 2 <= WS_XB && WS_HF + (size_t)SEQ * 2048 * 4 <= WS_XB && WS_H + (size_t)SEQ * DFF * 2 <= WS_GA && WS_W2D + (size_t)DM * DFF * 2 <= WS_R1 && WS_WMI + (size_t)NMIX * DM * 2 <= WS_W2A && WS_W2A + (size_t)2 * DFF * DM * 2 <= WS_W2D, "d_ws map");
constexpr int CW_TMO = 0, CW_CODE = 1;
constexpr int CW_BAR = 4096;
constexpr int RING_OFF = 0, RING_BYTES = 131072;
constexpr int LDSCTL_OFF = RING_BYTES, MISC_OFF = LDSCTL_OFF + 320;
constexpr int LDS_BYTES = 147456;
constexpr int HG_KT = 0, HG_VT = 18432, HG_QD = 36864, HG_KD = 54272, HG_ST = 71680, HG_TOT = 106496, HG_ER = 108544, HG_SS = 109056;

#define GAS __attribute__((address_space(1)))
#define LAS __attribute__((address_space(3)))
typedef unsigned short bf16;
typedef unsigned v4u __attribute__((ext_vector_type(4)));
typedef unsigned v2u __attribute__((ext_vector_type(2)));
typedef float f32x4 __attribute__((ext_vector_type(4)));
typedef float f32x2 __attribute__((ext_vector_type(2)));
typedef short bf16x8 __attribute__((ext_vector_type(8)));
typedef short s16x4 __attribute__((ext_vector_type(4)));
typedef GAS unsigned gu32;
#define RLX_AGENT __ATOMIC_RELAXED, __HIP_MEMORY_SCOPE_AGENT
#define LDS_WAIT() asm volatile("s_waitcnt lgkmcnt(0)" ::: "memory")
#define VM_WAIT() asm volatile("s_waitcnt vmcnt(0)" ::: "memory")
__device__ __forceinline__ unsigned f2bf(float f) { unsigned u = __builtin_bit_cast(unsigned, f); return (u + 0x7fffu + ((u >> 16) & 1u)) >> 16; }
__device__ __forceinline__ unsigned pk2(float lo, float hi) { return f2bf(lo) | (f2bf(hi) << 16); }
__device__ __forceinline__ float bf2f(unsigned short b) { return __uint_as_float(((unsigned)b) << 16); }

#define XB_TMO      128
#define XB_XCNT(j)  (256  + 64 * (j))
#define XB_XSUB(j)  (1280 + 64 * (j))
#define XB_XGEN(j)  (2304 + 64 * (j))
#define XB_TOP      3328
#define XB_TOPGEN   3392
#define XCD_BAR_WORDS 3456
#define XB_SPIN_CAP (1u << 18)

__device__ __forceinline__ unsigned xb_ld(unsigned* p)              { return __hip_atomic_load(p, __ATOMIC_RELAXED, __HIP_MEMORY_SCOPE_AGENT); }
__device__ __forceinline__ unsigned xb_add(unsigned* p, unsigned v) { return __hip_atomic_fetch_add(p, v, __ATOMIC_RELAXED, __HIP_MEMORY_SCOPE_AGENT); }
__device__ __forceinline__ unsigned xb_xcc_id() { return (unsigned)__builtin_amdgcn_s_getreg((3 << 11) | 20) & 0xFu; }
#define XB_SPIN(cond, bar) do { unsigned _sp = 0; while (cond) { __builtin_amdgcn_s_sleep(1); \
    if ((++_sp & 255u) == 0u) { if (xb_ld(&(bar)[XB_TMO])) break; if (_sp > XB_SPIN_CAP) { atomicAdd(&(bar)[XB_TMO], 1u); break; } } } } while (0)

struct XcdBarrier {
    unsigned* bar; unsigned x;
    volatile LAS unsigned* st;
};

__device__ __forceinline__ XcdBarrier xcd_barrier_post(unsigned* bar, volatile LAS unsigned* st, const bool t0  ) {
    XcdBarrier b; b.bar = bar; b.x = xb_xcc_id(); b.st = st;
    if (t0) (void)xb_add(&bar[XB_XCNT(b.x)], 1u);
    return b;
}
__device__ __forceinline__ void xcd_barrier_complete(unsigned* bar, unsigned x, unsigned& nloc, unsigned& nx) {
    const unsigned G = gridDim.x * gridDim.y * gridDim.z;
    unsigned sum, cnt, mine, sp = 0u;
    for (;;) {
        sum = 0u; cnt = 0u; mine = 0u;
#pragma unroll
        for (unsigned j = 0; j < 16; ++j) { const unsigned c = xb_ld(&bar[XB_XCNT(j)]); sum += c; cnt += (c > 0u) ? 1u : 0u; mine = (j == x) ? c : mine; }
        if (sum == G) break;
        __builtin_amdgcn_s_sleep(1);
        if ((++sp & 255u) == 0u) { if (xb_ld(&bar[XB_TMO])) break; if (sp > XB_SPIN_CAP) { atomicAdd(&bar[XB_TMO], 1u); break; } }
    }
    nloc = mine > 0u ? mine : 1u; nx = cnt > 0u ? cnt : 1u;
}

__device__ __forceinline__ void xcd_barrier(const XcdBarrier& b, const bool t0) {
    asm volatile("s_waitcnt vmcnt(0)" ::: "memory");
    __syncthreads();
    if (t0) {
        unsigned* bar = b.bar;
        __builtin_amdgcn_s_waitcnt(0);
        unsigned nloc = b.st[0], nx = b.st[1];
        if (nloc == 0u) { xcd_barrier_complete(bar, b.x, nloc, nx); b.st[0] = nloc; b.st[1] = nx; }
        const unsigned old = xb_add(&bar[XB_XSUB(b.x)], 1u);
        const unsigned gen = old / nloc;
        if (old + 1u == (gen + 1u) * nloc) {
            __builtin_amdgcn_fence(__ATOMIC_RELEASE, "agent");
            asm volatile("s_waitcnt vmcnt(0)" ::: "memory");
            const unsigned og = xb_add(&bar[XB_TOP], 1u);
            const unsigned tg = og / nx;
            if (og + 1u == (tg + 1u) * nx) xb_add(&bar[XB_TOPGEN], 1u);
            else XB_SPIN(xb_ld(&bar[XB_TOPGEN]) == tg, bar);
            __builtin_amdgcn_fence(__ATOMIC_ACQUIRE, "agent");
            xb_add(&bar[XB_XGEN(b.x)], 1u);
            asm volatile("s_waitcnt vmcnt(0)" ::: "memory");
        } else {
            XB_SPIN(xb_ld(&bar[XB_XGEN(b.x)]) == gen, bar);
            __builtin_amdgcn_fence(__ATOMIC_ACQUIRE, "agent");
            asm volatile("s_waitcnt vmcnt(0)" ::: "memory");
        }
    }
    __syncthreads();
}

struct Args { const float* in[31]; float* out; unsigned char* ws; int ph_lo, ph_hi; };
enum InIdx { I_X = 0, I_MEM, I_F1G, I_F1U, I_F1D, I_LN1G, I_LN1B, I_MIXIN, I_LQ1, I_LK1, I_LQ2, I_LK2, I_SUBLN, I_DAUP, I_LBLOG, I_HGNORM, I_HGUP, I_MIXOUT, I_LN2G, I_LN2B,
             I_XAQ, I_XAK, I_XAV, I_XAO, I_LN3G, I_LN3B, I_F2G, I_F2U, I_F2D, I_LN4G, I_LN4B };
typedef const char __attribute__((address_space(4))) karg_c;
__device__ __forceinline__ const float* arg_in(int i) { karg_c* kp = (karg_c*)__builtin_amdgcn_kernarg_segment_ptr(); asm volatile("" : "+s"(kp)); return *(const float* const __attribute__((address_space(4)))*)(kp + 8 * i); }
__device__ __forceinline__ float* arg_out() { karg_c* kp = (karg_c*)__builtin_amdgcn_kernarg_segment_ptr(); asm volatile("" : "+s"(kp)); return *(float* const __attribute__((address_space(4)))*)(kp + 8 * 31); }
struct Frame {
    LAS unsigned char* lds;
    volatile LAS unsigned* MISC;
    gu32* ctl;
    int wave;
    int vcu, G;
};
__device__ __forceinline__ float wave_sum(float v) {
#pragma unroll
    for (int o = 1; o < 64; o <<= 1) v += __shfl_xor(v, o);
    return v;
}

__device__ __forceinline__ void p0_transpose_item(const float* W, int K, int N, bf16* WT, int k0, int n0, int drow0, LAS float* scr, int lane) {
    { float wv[32];
      const float* wp = W + (size_t)(k0 + (lane >> 5)) * N + n0 + (lane & 31);
#pragma unroll
      for (int i = 0; i < 32; ++i) wv[i] = wp[(size_t)(2 * i) * N];
#pragma unroll
      for (int i = 0; i < 32; ++i) scr[(2 * i + (lane >> 5)) * 33 + (lane & 31)] = wv[i]; }
    LDS_WAIT(); asm volatile("" ::: "memory");
    const int c = lane & 7;
#pragma unroll
    for (int j = 0; j < 4; ++j) { const int n = (lane >> 3) + 8 * j; const LAS float* s = scr + (8 * c) * 33 + n;
        v4u o; o.x = pk2(s[0 * 33], s[1 * 33]); o.y = pk2(s[2 * 33], s[3 * 33]); o.z = pk2(s[4 * 33], s[5 * 33]); o.w = pk2(s[6 * 33], s[7 * 33]);
        *(GAS v4u*)(WT + (size_t)(drow0 + n) * K + k0 + 8 * c) = o; }
    LDS_WAIT(); asm volatile("" ::: "memory");
}
__device__ __forceinline__ int map_gu(int n0, int up) { return (n0 >> 7) * 256 + up * 128 + (n0 & 127); }
__device__ __forceinline__ int map_mix(int n0) { if (n0 >= 4096) return n0; const int cc = n0 & 255; return (n0 & ~255) + ((cc >> 6) & 1) * 128 + (cc >> 7) * 64 + (cc & 63); }
__device__ __forceinline__ void sincos_d(double ang, float& sn_o, float& cs_o) {
    const double kd = __builtin_rint(ang * 0.63661977236758134308);
    double y = __builtin_fma(-kd, 1.57079632679489655800e+00, ang); y = __builtin_fma(-kd, 6.12323399573676603587e-17, y);
    const int q = ((int)kd) & 3; const double y2 = y * y;
    const double sp = y * (1.0 + y2 * (-1.0 / 6.0 + y2 * (1.0 / 120.0 + y2 * (-1.0 / 5040.0 + y2 * (1.0 / 362880.0 + y2 * (-1.0 / 39916800.0 + y2 * (1.0 / 6227020800.0 + y2 * (-1.0 / 1307674368000.0))))))));
    const double cp = 1.0 + y2 * (-0.5 + y2 * (1.0 / 24.0 + y2 * (-1.0 / 720.0 + y2 * (1.0 / 40320.0 + y2 * (-1.0 / 3628800.0 + y2 * (1.0 / 479001600.0 + y2 * (-1.0 / 87178291200.0 + y2 * (1.0 / 20922789888000.0))))))));
    const double sn = (q == 0) ? sp : (q == 1) ? cp : (q == 2) ? -sp : -cp;
    const double cs = (q == 0) ? cp : (q == 1) ? -sp : (q == 2) ? -cp : sp;
    sn_o = (float)sn; cs_o = (float)cs;
}
__device__ __forceinline__ void p0_prologue(Frame& F, unsigned char* ws) {
    LAS float* scr = (LAS float*)(F.lds + RING_OFF + F.wave * 16384); const int lane = mk_lane();
    const int gw = F.vcu * NWAVES + F.wave, NGW = F.G * NWAVES;
    bf16* ws16 = (bf16*)ws;
    constexpr int I_FF = (DM / 64) * (DFF / 32), I_DN = (DFF / 64) * (DM / 32), I_MI = (DM / 64) * (NMIX / 32), I_UP = (2048 / 64) * (DM / 32), I_MO = (DM / 64) * (DM / 32), I_XP = (DM / 64) * (XAW / 32), I_XO = (XAW / 64) * (DM / 32);
    constexpr int I_DR = I_DN - DOWN_TAIL_ITEMS;
    constexpr int NITEMS = 4 * I_FF + 2 * I_DR + I_MI + 2 * I_UP + I_MO + 3 * I_XP + I_XO;
    for (int it = gw; it < NITEMS; it += NGW) {
        int r = it; const float* W; int K, N, kind; bf16* WT;
        int off = 0;
        if (r < I_FF) { W = arg_in(I_F1G); K = DM; N = DFF; WT = (bf16*)(ws + WS_W1A); kind = 1; }
        else if ((r -= I_FF) < I_FF) { W = arg_in(I_F1U); K = DM; N = DFF; WT = (bf16*)(ws + WS_W1A); kind = 2; }
        else if ((r -= I_FF) < I_DR) { r += DOWN_TAIL_ITEMS; W = arg_in(I_F1D); K = DFF; N = DM; WT = (bf16*)(ws + WS_W1D); kind = 0; }
        else if ((r -= I_DR) < I_MI) { W = arg_in(I_MIXIN); K = DM; N = NMIX; WT = (bf16*)(ws + WS_WMI); kind = 3; }
        else if ((r -= I_MI) < I_UP) { W = arg_in(I_DAUP); K = 2048; N = DM; WT = (bf16*)(ws + WS_WDA); kind = 0; }
        else if ((r -= I_UP) < I_UP) { W = arg_in(I_HGUP); K = 2048; N = DM; WT = (bf16*)(ws + WS_WHG); kind = 0; }
        else if ((r -= I_UP) < I_MO) { W = arg_in(I_MIXOUT); K = DM; N = DM; WT = (bf16*)(ws + WS_WMO); kind = 0; }
        else if ((r -= I_MO) < I_XP) { W = arg_in(I_XAQ); K = DM; N = XAW; WT = (bf16*)(ws + WS_WXQ); kind = 0; }
        else if ((r -= I_XP) < I_XP) { W = arg_in(I_XAK); K = DM; N = XAW; WT = (bf16*)(ws + WS_WXKV); kind = 0; }
        else if ((r -= I_XP) < I_XP) { W = arg_in(I_XAV); K = DM; N = XAW; WT = (bf16*)(ws + WS_WXKV); kind = 0; off = XAW; }
        else if ((r -= I_XP) < I_XO) { W = arg_in(I_XAO); K = XAW; N = DM; WT = (bf16*)(ws + WS_WXO); kind = 0; }
        else if ((r -= I_XO) < I_FF) { W = arg_in(I_F2G); K = DM; N = DFF; WT = (bf16*)(ws + WS_W2A); kind = 1; }
        else if ((r -= I_FF) < I_FF) { W = arg_in(I_F2U); K = DM; N = DFF; WT = (bf16*)(ws + WS_W2A); kind = 2; }
        else { r -= I_FF; r += DOWN_TAIL_ITEMS; W = arg_in(I_F2D); K = DFF; N = DM; WT = (bf16*)(ws + WS_W2D); kind = 0; }
        const int nblk = N / 32, kb = r / nblk, nb = r - kb * nblk, n0 = 32 * nb;
        const int drow0 = kind == 0 ? n0 + off : kind == 3 ? map_mix(n0) : map_gu(n0, kind - 1);
        p0_transpose_item(W, K, N, WT, 64 * kb, n0, drow0, scr, lane);
    }
    (void)ws16;
    { const size_t gt = (size_t)gw * 64 + lane, NT = (size_t)NGW * 64;
      const GAS f32x4* x4 = (const GAS f32x4*)arg_in(I_X); GAS v4u* xb = (GAS v4u*)(ws + WS_XB);
      for (size_t i = gt; i < (size_t)SEQ * DM / 8; i += NT) { const f32x4 p = x4[2 * i], q = x4[2 * i + 1]; v4u o; o.x = pk2(p.x, p.y); o.y = pk2(p.z, p.w); o.z = pk2(q.x, q.y); o.w = pk2(q.z, q.w); xb[i] = o; }
      const GAS f32x4* m4 = (const GAS f32x4*)arg_in(I_MEM); GAS v4u* mb = (GAS v4u*)(ws + WS_MEMB);
      for (size_t i = gt; i < (size_t)MEM * DM / 8; i += NT) { const f32x4 p = m4[2 * i], q = m4[2 * i + 1]; v4u o; o.x = pk2(p.x, p.y); o.y = pk2(p.z, p.w); o.z = pk2(q.x, q.y); o.w = pk2(q.z, q.w); mb[i] = o; }
      float* COS = (float*)(ws + WS_COS); float* SIN = (float*)(ws + WS_SIN);
      for (size_t i = gt; i < (size_t)SEQ * 64; i += NT) { const int pos = (int)(i >> 6), fi = (int)(i & 63);
          double inv = 1.0, base = 0.86596432336006535;
#pragma unroll
          for (int bit = 0; bit < 6; ++bit) { if ((fi >> bit) & 1) inv *= base; base *= base; }
          const float invf = (float)inv; const float angf = (float)pos * invf;
          float sn, cs; sincos_d((double)angf, sn, cs); COS[i] = cs; SIN[i] = sn; }
      const float* lbl = arg_in(I_LBLOG); float* LB = (float*)(ws + WS_LB);
      for (size_t i = gt; i < 2048; i += NT) { const float l0 = lbl[i], l1 = lbl[2048 + i]; LB[i] = 1.0f / (1.0f + expf(l1 - l0)); }
    }
    if (blockIdx.x == 0 && F.wave == 0) {
        const int l = lane; const float* q1 = arg_in(I_LQ1); const float* k1 = arg_in(I_LK1); const float* q2 = arg_in(I_LQ2); const float* k2 = arg_in(I_LK2);
        const float s1 = wave_sum(q1[l] * k1[l] + q1[l + 64] * k1[l + 64]), s2 = wave_sum(q2[l] * k2[l] + q2[l + 64] * k2[l + 64]);
        if (l == 0) *(float*)(ws + WS_LAM) = expf(s1) - expf(s2) + LAMBDA_INIT;
    }
}

__device__ __forceinline__ void p0_convert_down(Frame& F, const float* W, bf16* WT, int t0) {
    const int nb = F.G - t0, b = (int)blockIdx.x - t0; if (b < 0) return;
    LAS float* scr = (LAS float*)(F.lds + RING_OFF + F.wave * 16384); const int lane = mk_lane();
    constexpr int nblk = DM / 32;
    for (int r = b * NWAVES + F.wave; r < DOWN_TAIL_ITEMS; r += nb * NWAVES) { const int kb = r / nblk, n0 = 32 * (r - kb * nblk);
        p0_transpose_item(W, DFF, DM, WT, 64 * kb, n0, n0, scr, lane); }
}
__device__ __forceinline__ void ln_phase(Frame& F, const float* Y, const float* g, const float* b, float* Xf, bf16* Xb, float* ST = nullptr) {
    const int gw = F.vcu * NWAVES + F.wave, NGW = F.G * NWAVES, lane = mk_lane();
    for (int m = gw; m < SEQ; m += NGW) {
        const GAS f32x4* yr = (const GAS f32x4*)(Y + (size_t)m * DM) + lane;
        f32x4 v[16]; float s = 0.f;
#pragma unroll
        for (int j = 0; j < 16; ++j) { v[j] = yr[64 * j]; s += (v[j].x + v[j].y) + (v[j].z + v[j].w); }
        const float mean = wave_sum(s) * (1.f / DM); float s2 = 0.f;
#pragma unroll
        for (int j = 0; j < 16; ++j) { v[j] = v[j] - mean; s2 += (v[j].x * v[j].x + v[j].y * v[j].y) + (v[j].z * v[j].z + v[j].w * v[j].w); }
        const float rstd = 1.f / sqrtf(wave_sum(s2) * (1.f / DM) + LN_EPS);
        if (ST && lane == 0) { ST[2 * m] = mean; ST[2 * m + 1] = rstd; }
        const GAS f32x4* g4 = (const GAS f32x4*)g + lane; const GAS f32x4* b4 = (const GAS f32x4*)b + lane;
#pragma unroll
        for (int j = 0; j < 16; ++j) { const f32x4 o = v[j] * rstd * g4[64 * j] + b4[64 * j];
            if (Xf) ((GAS f32x4*)(Xf + (size_t)m * DM) + lane)[64 * j] = o;
            if (Xb) { v2u w; w.x = pk2(o.x, o.y); w.y = pk2(o.z, o.w); ((GAS v2u*)(Xb + (size_t)m * DM) + lane)[64 * j] = w; } }
    }
}
__device__ __forceinline__ void da_combine(Frame& F, unsigned char* ws) {
    const int gw = F.vcu * NWAVES + F.wave, NGW = F.G * NWAVES, lane = mk_lane();
    const float lam = *(const float*)(ws + WS_LAM);
    const f32x4 g4 = ((const GAS f32x4*)arg_in(I_SUBLN))[lane];
    const float* O1 = (const float*)(ws + WS_O1); const float* O2 = (const float*)(ws + WS_O2); bf16* OA = (bf16*)(ws + WS_OA);
    for (int r = gw; r < SEQ * 8; r += NGW) {
        const size_t off = (size_t)r * 256 + 4 * lane;
        const f32x4 o1 = *(const GAS f32x4*)(O1 + off), o2 = *(const GAS f32x4*)(O2 + off);
        const f32x4 o = o1 - o2 * lam;
        const float ss = wave_sum((o.x * o.x + o.y * o.y) + (o.z * o.z + o.w * o.w));
        const float rs = (1.0f - LAMBDA_INIT) / sqrtf(ss * (1.f / 256.f) + LN_EPS);
        const f32x4 y = o * rs * g4;
        v2u w; w.x = pk2(y.x, y.y); w.y = pk2(y.z, y.w); *(GAS v2u*)(OA + off) = w;
    }
}
#define HG_GATES(ROWBASE)                                                                                           \
    float g[16], kk[16];                                                                                            \
    _Pragma("unroll") for (int i = 0; i < 16; ++i) { const float p = HF[(ROWBASE) + (size_t)i * 2048 + n];        \
        const float sg_ = __builtin_amdgcn_rcpf(1.0f + __expf(-p)); const float f = lb + (1.0f - lb) * sg_; kk[i] = 1.0f - f; g[i] = __logf(f); } \
    _Pragma("unroll") for (int i = 1; i < 16; ++i) g[i] += g[i - 1];
__device__ __forceinline__ void hgrn_passA(Frame& F, unsigned char* ws) {
    LAS unsigned char* L = F.lds + RING_OFF;
    const int lane = mk_lane(), w = F.wave, tid = w * 64 + lane, n = tid & 127, sg = tid >> 7, fr = lane & 15, fq = lane >> 4;
    const float* HF = (const float*)(ws + WS_HF); const bf16* HI = (const bf16*)(ws + WS_PB + 4 * PB_SEG); const float* LB = (const float*)(ws + WS_LB);
    float* SLT = (float*)(ws + WS_SLT); float* DEC = (float*)(ws + WS_DEC);
    LAS float* TOT = (LAS float*)(L + HG_TOT);
    for (int item = blockIdx.x; item < 2048; item += F.G) {
        const int h = item >> 7, c = item & 127;
        const float lb = LB[h * 128 + n];
        const size_t rowbase = (size_t)(c * 64 + sg * 16) * 2048 + h * 128;
        HG_GATES(rowbase)
        TOT[sg * 128 + n] = g[15];
        { unsigned vv[8];
#pragma unroll
          for (int i = 0; i < 8; ++i) vv[i] = (unsigned)HI[rowbase + (size_t)(2 * i) * 2048 + n] | ((unsigned)HI[rowbase + (size_t)(2 * i + 1) * 2048 + n] << 16);
          *(LAS v4u*)(L + HG_VT + n * 144 + sg * 32) = (v4u){vv[0], vv[1], vv[2], vv[3]}; *(LAS v4u*)(L + HG_VT + n * 144 + sg * 32 + 16) = (v4u){vv[4], vv[5], vv[6], vv[7]}; }
        __syncthreads();
        { const float t0 = TOT[n], t1 = TOT[128 + n], t2 = TOT[256 + n], t3 = TOT[384 + n];
          const float off = (sg > 0 ? t0 : 0.f) + (sg > 1 ? t1 : 0.f) + (sg > 2 ? t2 : 0.f), bl = (t0 + t1) + (t2 + t3);
          unsigned kw[8];
#pragma unroll
          for (int i = 0; i < 8; ++i) kw[i] = pg8::cvt_pk_bf16(kk[2 * i] * __expf(bl - (off + g[2 * i])), kk[2 * i + 1] * __expf(bl - (off + g[2 * i + 1])));
          *(LAS v4u*)(L + HG_KT + n * 144 + sg * 32) = (v4u){kw[0], kw[1], kw[2], kw[3]}; *(LAS v4u*)(L + HG_KT + n * 144 + sg * 32 + 16) = (v4u){kw[4], kw[5], kw[6], kw[7]};
          if (sg == 0) DEC[(size_t)(h * 128 + c) * 128 + n] = __expf(bl); }
        __syncthreads();
        f32x4 acc[8];
#pragma unroll
        for (int et = 0; et < 8; ++et) acc[et] = (f32x4){0.f, 0.f, 0.f, 0.f};
#pragma unroll
        for (int ks = 0; ks < 2; ++ks) { const bf16x8 af = *(const LAS bf16x8*)(L + HG_KT + (16 * w + fr) * 144 + (32 * ks + 8 * fq) * 2);
#pragma unroll
            for (int et = 0; et < 8; ++et) { const bf16x8 bfr = *(const LAS bf16x8*)(L + HG_VT + (16 * et + fr) * 144 + (32 * ks + 8 * fq) * 2);
                acc[et] = __builtin_amdgcn_mfma_f32_16x16x32_bf16(af, bfr, acc[et], 0, 0, 0); } }
        float* dst = SLT + (size_t)(h * 128 + c) * 16384 + 16 * w + 4 * fq;
#pragma unroll
        for (int et = 0; et < 8; ++et) *(GAS f32x4*)(dst + (size_t)(16 * et + fr) * 128) = acc[et];
        __syncthreads();
    }
}
__device__ __forceinline__ void hgrn_passB(Frame& F, unsigned char* ws) {
    const float* SLT = (const float*)(ws + WS_SLT); float* SP = (float*)(ws + WS_XF); const float* DEC = (const float*)(ws + WS_DEC);
    for (int idx = blockIdx.x * (NWAVES * 64) + F.wave * 64 + mk_lane(); idx < 16 * 128 * 64; idx += F.G * NWAVES * 64) {
        const int h = idx >> 13, e = (idx >> 6) & 127, np = idx & 63;
        const GAS f32x2* p = (const GAS f32x2*)(SLT + (size_t)h * 128 * 16384 + (size_t)e * 128 + 2 * np);
        GAS f32x2* q = (GAS f32x2*)(SP + (size_t)h * 128 * 16384 + (size_t)e * 128 + 2 * np);
        const GAS f32x2* d = (const GAS f32x2*)(DEC + (size_t)h * 128 * 128 + 2 * np);
        f32x2 st = (f32x2){0.f, 0.f};
        for (int c0 = 0; c0 < 128; c0 += 16) {
            f32x2 lv[16], dv[16];
#pragma unroll
            for (int k = 0; k < 16; ++k) { lv[k] = p[(size_t)(c0 + k) * 8192]; dv[k] = d[(size_t)(c0 + k) * 64]; }
#pragma unroll
            for (int k = 0; k < 16; ++k) { q[(size_t)(c0 + k) * 8192] = st; st = dv[k] * st + lv[k]; }
        }
    }
}
__device__ __forceinline__ void hgrn_passC(Frame& F, unsigned char* ws) {
    LAS unsigned char* L = F.lds + RING_OFF;
    const int lane = mk_lane(), w = F.wave, tid = w * 64 + lane, n = tid & 127, sg = tid >> 7, fr = lane & 15, fq = lane >> 4;
    const float* HF = (const float*)(ws + WS_HF); const bf16* HQ = (const bf16*)(ws + WS_PB + 3 * PB_SEG); const bf16* HI = (const bf16*)(ws + WS_PB + 4 * PB_SEG); const bf16* HGt = (const bf16*)(ws + WS_PB + 5 * PB_SEG);
    const float* LB = (const float*)(ws + WS_LB); const float* SLT = (const float*)(ws + WS_XF); const float* NG = arg_in(I_HGNORM); bf16* OB = (bf16*)(ws + WS_OB);
    LAS float* TOT = (LAS float*)(L + HG_TOT); LAS float* ER = (LAS float*)(L + HG_ER); LAS float* SS = (LAS float*)(L + HG_SS);
    const int ti = w & 3, eh = w >> 2;
    float ng[4];
#pragma unroll
    for (int q4 = 0; q4 < 4; ++q4) ng[q4] = NG[16 * (4 * eh + q4) + fr];
    for (int item = blockIdx.x; item < 2048; item += F.G) {
        const int h = item >> 7, c = item & 127;
        const float lb = LB[h * 128 + n];
        const size_t rowbase = (size_t)(c * 64 + sg * 16) * 2048 + h * 128;
        f32x4 sp[8];
        { const float* src = SLT + (size_t)(h * 128 + c) * 16384; const int n4 = (tid & 31) * 4;
#pragma unroll
          for (int k = 0; k < 8; ++k) sp[k] = *(const GAS f32x4*)(src + (size_t)((tid >> 5) + 16 * k) * 128 + n4); }
        unsigned short gtv[16];
#pragma unroll
        for (int i = 0; i < 4; ++i)
#pragma unroll
            for (int q4 = 0; q4 < 4; ++q4) gtv[4 * i + q4] = HGt[(size_t)(c * 64 + 16 * ti + 4 * fq + i) * 2048 + h * 128 + 16 * (4 * eh + q4) + fr];
        HG_GATES(rowbase)
        TOT[sg * 128 + n] = g[15];
        unsigned short qv[16];
#pragma unroll
        for (int i = 0; i < 16; ++i) qv[i] = HQ[rowbase + (size_t)i * 2048 + n];
        { unsigned vv[8];
#pragma unroll
          for (int i = 0; i < 8; ++i) vv[i] = (unsigned)HI[rowbase + (size_t)(2 * i) * 2048 + n] | ((unsigned)HI[rowbase + (size_t)(2 * i + 1) * 2048 + n] << 16);
          *(LAS v4u*)(L + HG_VT + n * 144 + sg * 32) = (v4u){vv[0], vv[1], vv[2], vv[3]}; *(LAS v4u*)(L + HG_VT + n * 144 + sg * 32 + 16) = (v4u){vv[4], vv[5], vv[6], vv[7]}; }
        __syncthreads();
        { const float t0 = TOT[n], t1 = TOT[128 + n], t2 = TOT[256 + n];
          const float off = (sg > 0 ? t0 : 0.f) + (sg > 1 ? t1 : 0.f) + (sg > 2 ? t2 : 0.f), r = t0 + t1;
#pragma unroll
          for (int i = 0; i < 16; ++i) { const float b = off + g[i];
              *(LAS unsigned short*)(L + HG_QD + (16 * sg + i) * 272 + n * 2) = (unsigned short)pg8::cvt_pk_bf16(bf2f(qv[i]) * __expf(b - r), 0.f);
              *(LAS unsigned short*)(L + HG_KD + (16 * sg + i) * 272 + n * 2) = (unsigned short)pg8::cvt_pk_bf16(kk[i] * __expf(r - b), 0.f); }
          if (sg == 0) ER[n] = __expf(r); }
        __syncthreads();
        { const int n4 = (tid & 31) * 4; const f32x4 er4 = *(const LAS f32x4*)(ER + n4);
#pragma unroll
          for (int k = 0; k < 8; ++k) { const int e = (tid >> 5) + 16 * k; const f32x4 s = sp[k] * er4;
              v2u o; o.x = pg8::cvt_pk_bf16(s.x, s.y); o.y = pg8::cvt_pk_bf16(s.z, s.w); *(LAS v2u*)(L + HG_ST + e * 272 + n4 * 2) = o; } }
        __syncthreads();
        bf16x8 qf[4];
#pragma unroll
        for (int ks = 0; ks < 4; ++ks) qf[ks] = *(const LAS bf16x8*)(L + HG_QD + (16 * ti + fr) * 272 + (32 * ks + 8 * fq) * 2);
        s16x4 pa[4];
#pragma unroll
        for (int j = 0; j < 4; ++j) { pa[j] = (s16x4){0, 0, 0, 0};
            if (j <= ti) { f32x4 at = (f32x4){0.f, 0.f, 0.f, 0.f};
#pragma unroll
                for (int ks = 0; ks < 4; ++ks) { const bf16x8 kf = *(const LAS bf16x8*)(L + HG_KD + (16 * j + fr) * 272 + (32 * ks + 8 * fq) * 2);
                    at = __builtin_amdgcn_mfma_f32_16x16x32_bf16(kf, qf[ks], at, 0, 0, 0); }
                if (j == ti) {
#pragma unroll
                    for (int i = 0; i < 4; ++i) at[i] = (4 * fq + i <= fr) ? at[i] : 0.f; }
                const unsigned w0 = pg8::cvt_pk_bf16(at[0], at[1]), w1 = pg8::cvt_pk_bf16(at[2], at[3]);
                pa[j] = (s16x4){(short)(w0 & 0xffffu), (short)(w0 >> 16), (short)(w1 & 0xffffu), (short)(w1 >> 16)}; } }
        f32x4 acc[4];
#pragma unroll
        for (int q4 = 0; q4 < 4; ++q4) { const int et = 4 * eh + q4; acc[q4] = (f32x4){0.f, 0.f, 0.f, 0.f};
#pragma unroll
            for (int ks = 0; ks < 4; ++ks) { const bf16x8 sf = *(const LAS bf16x8*)(L + HG_ST + (16 * et + fr) * 272 + (32 * ks + 8 * fq) * 2);
                acc[q4] = __builtin_amdgcn_mfma_f32_16x16x32_bf16(qf[ks], sf, acc[q4], 0, 0, 0); }
#pragma unroll
            for (int jp = 0; jp < 2; ++jp) if (2 * jp <= ti) {
                const s16x4 v0 = *(const LAS s16x4*)(L + HG_VT + (16 * et + fr) * 144 + (32 * jp + 4 * fq) * 2), v1 = *(const LAS s16x4*)(L + HG_VT + (16 * et + fr) * 144 + (32 * jp + 16 + 4 * fq) * 2);
                const bf16x8 af = (bf16x8){pa[2 * jp][0], pa[2 * jp][1], pa[2 * jp][2], pa[2 * jp][3], pa[2 * jp + 1][0], pa[2 * jp + 1][1], pa[2 * jp + 1][2], pa[2 * jp + 1][3]};
                const bf16x8 bfv = (bf16x8){v0[0], v0[1], v0[2], v0[3], v1[0], v1[1], v1[2], v1[3]};
                acc[q4] = __builtin_amdgcn_mfma_f32_16x16x32_bf16(af, bfv, acc[q4], 0, 0, 0); } }
        float ssq[4];
#pragma unroll
        for (int i = 0; i < 4; ++i) { float s = (acc[0][i] * acc[0][i] + acc[1][i] * acc[1][i]) + (acc[2][i] * acc[2][i] + acc[3][i] * acc[3][i]);
            s += __shfl_xor(s, 1); s += __shfl_xor(s, 2); s += __shfl_xor(s, 4); s += __shfl_xor(s, 8); ssq[i] = s; }
        if (fr == 0) { *(LAS f32x4*)(SS + w * 16 + 4 * fq) = (f32x4){ssq[0], ssq[1], ssq[2], ssq[3]}; }
        __syncthreads();
        { const f32x4 other = *(const LAS f32x4*)(SS + (w ^ 4) * 16 + 4 * fq);
#pragma unroll
          for (int i = 0; i < 4; ++i) { const float rs = __builtin_amdgcn_rsqf((ssq[i] + other[i]) * (1.f / 128.f) + LN_EPS);
              const size_t orow = (size_t)(c * 64 + 16 * ti + 4 * fq + i) * 2048 + h * 128;
#pragma unroll
              for (int q4 = 0; q4 < 4; ++q4) { const int e = 16 * (4 * eh + q4) + fr; const float gt = bf2f(gtv[4 * i + q4]);
                  const float v = acc[q4][i] * rs * ng[q4] * (gt * __builtin_amdgcn_rcpf(1.0f + __expf(-gt))), vn = __shfl_xor(v, 1);
                  if ((fr & 1) == 0) *(GAS unsigned*)(OB + orow + e) = pg8::cvt_pk_bf16(v, vn); } } }
        __syncthreads();
    }
}
struct AItem { int vh, qb0, qb1; };
__device__ __forceinline__ AItem a_decode(int L) { const int xcd = L & 7, k = L >> 3; AItem it; it.vh = (((k >> 5) * 8 + xcd) * 2 + ((k & 31) >> 4)) & 31; const int x = k & 15; it.qb0 = x; it.qb1 = 31 - x; return it; }
__device__ __forceinline__ attn::BlockRef<bf16, float> a_ref(const AItem& it, int pass, unsigned char* ws) {
    const int qb = pass ? it.qb1 : it.qb0, kvp = it.vh >> 1, vhalf = it.vh & 1, h = kvp >> 1, map = kvp & 1;
    attn::BlockRef<bf16, float> r;
    r.Q = (const bf16*)(ws + WS_PB) + (size_t)qb * 256 * 2048 + h * 256 + map * 128;
    r.K = (const bf16*)(ws + WS_PB + PB_SEG) + h * 256 + map * 128;
    r.V = (const bf16*)(ws + WS_PB + 2 * PB_SEG) + h * 256 + vhalf * 128;
    r.O = (float*)(ws + (map ? WS_O2 : WS_O1)) + (size_t)qb * 256 * 2048 + h * 256 + vhalf * 128;
    r.P0 = qb * 256;
    return r;
}
__device__ __forceinline__ void da_attention(Frame& F, unsigned char* ws) {
    constexpr int total = 512; const int stride = F.G;
    int L = blockIdx.x; if (L >= total) return;
    char* lds = (char*)F.lds;
    AItem it = a_decode(L); int pass = 0;
    attn::BlockRef<bf16, float> cur = a_ref(it, 0, ws);
    attn::Seam<bf16> S;
    attn::causal_swa_prime<bf16, float, 2048, 2048, 2048>(cur, SEQ, lds, S, F.wave);
    for (;;) {
        const bool more_pass = pass == 0 && it.qb1 != it.qb0, more_item = L + stride < total, last = !more_pass && !more_item;
        AItem itn = it; int passn = pass + 1, Ln = L;
        if (!more_pass) { passn = 0; Ln = more_item ? L + stride : L; itn = a_decode(Ln); }
        const attn::BlockRef<bf16, float> nxt = last ? cur : a_ref(itn, passn, ws);
        attn::causal_swa_block<bf16, float, 2048, 2048, 2048>(cur, nxt, SEQ, SEQ, lds, S, F.wave);
        if (last) break;
        cur = nxt; it = itn; pass = passn; L = Ln;
    }
}
__device__ __forceinline__ void xa_attention(Frame& F, unsigned char* ws) {
    LAS unsigned char* L = F.lds + RING_OFF;
    const int lane = mk_lane(), w = F.wave, tid = w * 64 + lane, fr = lane & 15, fq = lane >> 4;
    const float* XQP = (const float*)(ws + WS_XQP); const bf16* XKV = (const bf16*)(ws + WS_XKV); bf16* XO = (bf16*)(ws + WS_XO);
    constexpr float C2 = 0.08838834764831845f * 1.4426950408889634f;
    for (int item = blockIdx.x; item < 128; item += F.G) {
        const int h = item >> 5, qb = item & 31;
#pragma unroll
        for (int i = 0; i < 8; ++i) { const int idx = tid + 512 * i, key = idx >> 4, c = idx & 15;
            const v4u kv = *(const GAS v4u*)(XKV + (size_t)key * 1024 + h * 128 + 8 * c);
            *(LAS v4u*)(L + key * 256 + ((c ^ (key & 15)) << 4)) = kv; }
#pragma unroll 4
        for (int i = 0; i < 16; ++i) { const int idx = tid + 512 * i, e = idx & 127, kq = idx >> 7;
            const bf16* vp = XKV + (size_t)(4 * kq) * 1024 + 512 + h * 128 + e;
            v2u o; o.x = (unsigned)vp[0] | ((unsigned)vp[1024] << 16); o.y = (unsigned)vp[2048] | ((unsigned)vp[3072] << 16);
            *(LAS v2u*)(L + 65536 + e * 512 + ((kq ^ ((e & 15) << 1)) << 3)) = o; }
        __syncthreads();
#pragma unroll 1
        for (int qt = 0; qt < 2; ++qt) {
            const size_t qrow = (size_t)qb * 256 + 32 * w + 16 * qt;
            bf16x8 qf[4];
#pragma unroll
            for (int ks = 0; ks < 4; ++ks) { const float* qp = XQP + (qrow + fr) * XAW + h * 128 + 32 * ks + 8 * fq;
                f32x4 a = *(const GAS f32x4*)qp, b = *(const GAS f32x4*)(qp + 4);
#pragma unroll
                for (int p = 1; p < 4; ++p) { a = a + *(const GAS f32x4*)(qp + (size_t)p * SEQ * XAW); b = b + *(const GAS f32x4*)(qp + (size_t)p * SEQ * XAW + 4); }
                const v4u w4 = (v4u){pg8::cvt_pk_bf16(a[0], a[1]), pg8::cvt_pk_bf16(a[2], a[3]), pg8::cvt_pk_bf16(b[0], b[1]), pg8::cvt_pk_bf16(b[2], b[3])};
                qf[ks] = __builtin_bit_cast(bf16x8, w4); }
            f32x4 sacc[16];
#pragma unroll
            for (int kt = 0; kt < 16; ++kt) sacc[kt] = (f32x4){0.f, 0.f, 0.f, 0.f};
#pragma unroll
            for (int ks = 0; ks < 4; ++ks)
#pragma unroll
                for (int kt = 0; kt < 16; ++kt) { const bf16x8 kf = *(const LAS bf16x8*)(L + (16 * kt + fr) * 256 + (((4 * ks + fq) ^ fr) << 4));
                    sacc[kt] = __builtin_amdgcn_mfma_f32_16x16x32_bf16(kf, qf[ks], sacc[kt], 0, 0, 0); }
            float mx = sacc[0][0];
#pragma unroll
            for (int kt = 0; kt < 16; ++kt)
#pragma unroll
                for (int r = 0; r < 4; ++r) mx = fmaxf(mx, sacc[kt][r]);
            mx = fmaxf(mx, __shfl_xor(mx, 16)); mx = fmaxf(mx, __shfl_xor(mx, 32));
            const float mc = mx * C2; float l = 0.f; s16x4 pa[16];
#pragma unroll
            for (int kt = 0; kt < 16; ++kt) { f32x4 p;
#pragma unroll
                for (int r = 0; r < 4; ++r) { p[r] = __builtin_amdgcn_exp2f(sacc[kt][r] * C2 - mc); l += p[r]; }
                const unsigned w0 = pg8::cvt_pk_bf16_pinned(p[0], p[1]), w1 = pg8::cvt_pk_bf16_pinned(p[2], p[3]);
                pa[kt] = (s16x4){(short)(w0 & 0xffffu), (short)(w0 >> 16), (short)(w1 & 0xffffu), (short)(w1 >> 16)}; }
            l += __shfl_xor(l, 16); l += __shfl_xor(l, 32);
            f32x4 oacc[8];
#pragma unroll
            for (int et = 0; et < 8; ++et) oacc[et] = (f32x4){0.f, 0.f, 0.f, 0.f};
#pragma unroll
            for (int kp = 0; kp < 8; ++kp) {
                const bf16x8 af = (bf16x8){pa[2 * kp][0], pa[2 * kp][1], pa[2 * kp][2], pa[2 * kp][3], pa[2 * kp + 1][0], pa[2 * kp + 1][1], pa[2 * kp + 1][2], pa[2 * kp + 1][3]};
#pragma unroll
                for (int et = 0; et < 8; ++et) { const s16x4 v0 = *(const LAS s16x4*)(L + 65536 + (16 * et + fr) * 512 + (((8 * kp + fq) ^ (fr << 1)) << 3)), v1 = *(const LAS s16x4*)(L + 65536 + (16 * et + fr) * 512 + (((8 * kp + 4 + fq) ^ (fr << 1)) << 3));
                    oacc[et] = __builtin_amdgcn_mfma_f32_16x16x32_bf16(af, (bf16x8){v0[0], v0[1], v0[2], v0[3], v1[0], v1[1], v1[2], v1[3]}, oacc[et], 0, 0, 0); } }
            const float rl = 1.0f / l;
#pragma unroll
            for (int r = 0; r < 4; ++r) { const float rr = __shfl(rl, 4 * fq + r);
#pragma unroll
                for (int et = 0; et < 8; ++et) { const float v = oacc[et][r] * rr, vn = __shfl_xor(v, 1);
                    if ((fr & 1) == 0) *(GAS unsigned*)(XO + (qrow + 4 * fq + r) * XAW + h * 128 + 16 * et + fr) = pk2(v, vn); } }
        }
        __syncthreads();
    }
}

__global__ void __launch_bounds__(NWAVES * 64, 2) mk_fwd(Args args) {
    extern __shared__ __attribute__((aligned(16))) unsigned char lds[];
    Frame F;
    F.lds = (LAS unsigned char*)lds;
    F.MISC = (volatile LAS unsigned*)(F.lds + MISC_OFF);
    F.wave = __builtin_amdgcn_readfirstlane((int)threadIdx.x >> 6);
    F.G = gridDim.x; { const int bx = blockIdx.x; F.vcu = (F.G % 8 == 0) ? (bx % 8) * (F.G / 8) + bx / 8 : bx; }
    unsigned char* ws = args.ws;
    F.ctl = (gu32*)(ws + WS_CTL);
    for (int u = threadIdx.x; u < (LDS_BYTES - LDSCTL_OFF) / 4; u += NWAVES * 64) ((LAS unsigned*)(F.lds + LDSCTL_OFF))[u] = 0u;
    __syncthreads();
    XcdBarrier bar; bar.bar = (unsigned*)(F.ctl + CW_BAR); bar.x = 0; bar.st = nullptr;
    if (N_LAUNCHES == 1) bar = xcd_barrier_post((unsigned*)(F.ctl + CW_BAR), F.MISC + 8, threadIdx.x == 0);
#define GRID_BAR() do { if (N_LAUNCHES == 1) xcd_barrier(bar, F.wave == 0 && mk_lane() == 0); } while (0)
    const int lo = args.ph_lo, hi = args.ph_hi;
#define IN(k) (lo <= (k) && (k) < hi)
#define SEAM(k) do { if (IN(k) && IN((k) + 1)) GRID_BAR(); } while (0)
    const int bid = (int)blockIdx.x;
#define XB ((bf16*)(ws + WS_XB))
#define Y ((float*)(ws + WS_Y))
#define XF ((float*)(ws + WS_XF))
#define HB ((bf16*)(ws + WS_H))

    if (IN(0)) { p0_prologue(F, ws); } SEAM(0);
    if (IN(1)) { pg8::Gemm g{XB, (const bf16*)(ws + WS_W1A), SEQ, 2 * DFF, DM, DM, nullptr, nullptr}; pg8::StaticOrder S; S.init(SEQ, 2 * DFF, F.G, bid);
        pg8::EpiSwiGLU E{HB, DFF}; pg8::gemm_phase<pg8::EpiSwiGLU, pg8::StaticOrder, true, true>(F.lds + RING_OFF, g, S, E, F.wave);
        { pg8::Gemm g2{(const bf16*)(ws + WS_MEMB), (const bf16*)(ws + WS_WXKV), MEM, 2 * XAW, DM, DM, nullptr, nullptr}; pg8::StaticOrder S2; S2.init(MEM, 2 * XAW, F.G, (bid + F.G - 192) % F.G);
          pg8::EpiBf16 E2{(bf16*)(ws + WS_XKV), 2 * XAW}; pg8::gemm_phase<pg8::EpiBf16, pg8::StaticOrder, true, true>(F.lds + RING_OFF, g2, S2, E2, F.wave); }
        p0_convert_down(F, arg_in(I_F1D), (bf16*)(ws + WS_W1D), F.G > 200 ? 196 : 0); } SEAM(1);
    if (IN(2)) { pg8::Gemm g{HB, (const bf16*)(ws + WS_W1D), SEQ, DM, DFF, DFF, nullptr, nullptr}; pg8::StaticOrder S; S.init(SEQ, DM, F.G, bid);
        pg8::EpiResF32 E{arg_in(I_X), Y, DM, DN_ALPHA, 0.5f}; pg8::gemm_phase<pg8::EpiResF32, pg8::StaticOrder, true, true>(F.lds + RING_OFF, g, S, E, F.wave); } SEAM(2);
    if (IN(3)) { ln_phase(F, Y, arg_in(I_LN1G), arg_in(I_LN1B), nullptr, XB, (float*)(ws + WS_ST)); } SEAM(3);
    if (IN(4)) { pg8::Gemm g{XB, (const bf16*)(ws + WS_WMI), SEQ, NMIX, DM, DM, nullptr, nullptr}; pg8::StaticOrder S; S.init(SEQ, NMIX, F.G, bid);
        pg8::EpiMixIn E{(bf16*)(ws + WS_PB), PB_SEG / 2, (float*)(ws + WS_HF), (bf16*)(ws + WS_GA), (bf16*)(ws + WS_GB), (const float*)(ws + WS_COS), (const float*)(ws + WS_SIN)};
        pg8::gemm_phase<pg8::EpiMixIn, pg8::StaticOrder, true, true>(F.lds + RING_OFF, g, S, E, F.wave); } SEAM(4);
    if (IN(5)) { da_attention(F, ws); hgrn_passA(F, ws); } SEAM(5);
    if (IN(6)) { hgrn_passB(F, ws); da_combine(F, ws); } SEAM(6);
    if (IN(7)) { hgrn_passC(F, ws); } SEAM(7);
    if (IN(8)) { pg8::Gemm g{(const bf16*)(ws + WS_OA), (const bf16*)(ws + WS_WDA), SEQ, DM, 2048, 2048, (const bf16*)(ws + WS_OB), (const bf16*)(ws + WS_WHG)};
        pg8::DualOrder S; S.init(SEQ, DM, F.G, bid); pg8::EpiMerge E{(const bf16*)(ws + WS_GA), (const bf16*)(ws + WS_GB), XB, DM};
        pg8::gemm_phase<pg8::EpiMerge, pg8::DualOrder, true, true>(F.lds + RING_OFF, g, S, E, F.wave); } SEAM(8);
    if (IN(9)) { pg8::Gemm g{XB, (const bf16*)(ws + WS_WMO), SEQ, DM, DM, DM, nullptr, nullptr}; pg8::StaticOrder S; S.init(SEQ, DM, F.G, bid);
        pg8::EpiResLN E{Y, (const float*)(ws + WS_ST), arg_in(I_LN1G), arg_in(I_LN1B), XF, DM, DN_ALPHA, 1.0f}; pg8::gemm_phase<pg8::EpiResLN, pg8::StaticOrder, true, true>(F.lds + RING_OFF, g, S, E, F.wave); } SEAM(9);
    if (IN(10)) { ln_phase(F, XF, arg_in(I_LN2G), arg_in(I_LN2B), nullptr, XB, (float*)(ws + WS_ST) + 2 * SEQ); } SEAM(10);
    if (IN(11)) { pg8::Gemm g{XB, (const bf16*)(ws + WS_WXQ), SEQ, XAW, DM / 4, DM, nullptr, nullptr}; pg8::SplitKOrder S; S.init(SEQ, XAW, DM / 4, 4, F.G, bid);
        pg8::EpiF32Part E{(float*)(ws + WS_XQP), XAW, DM / 4, (size_t)SEQ * XAW}; pg8::gemm_phase<pg8::EpiF32Part, pg8::SplitKOrder, true, true>(F.lds + RING_OFF, g, S, E, F.wave); } SEAM(11);
    if (IN(12)) { xa_attention(F, ws); } SEAM(12);
    if (IN(13)) { pg8::Gemm g{(const bf16*)(ws + WS_XO), (const bf16*)(ws + WS_WXO), SEQ, DM, XAW, XAW, nullptr, nullptr}; pg8::StaticOrder S; S.init(SEQ, DM, F.G, bid);
        pg8::EpiResLN E{XF, (const float*)(ws + WS_ST) + 2 * SEQ, arg_in(I_LN2G), arg_in(I_LN2B), Y, DM, DN_ALPHA, 1.0f}; pg8::gemm_phase<pg8::EpiResLN, pg8::StaticOrder, true, true>(F.lds + RING_OFF, g, S, E, F.wave); } SEAM(13);
    if (IN(14)) { ln_phase(F, Y, arg_in(I_LN3G), arg_in(I_LN3B), nullptr, XB, (float*)(ws + WS_ST) + 4 * SEQ); } SEAM(14);
    if (IN(15)) { pg8::Gemm g{XB, (const bf16*)(ws + WS_W2A), SEQ, 2 * DFF, DM, DM, nullptr, nullptr}; pg8::StaticOrder S; S.init(SEQ, 2 * DFF, F.G, bid);
        pg8::EpiSwiGLU E{HB, DFF}; pg8::gemm_phase<pg8::EpiSwiGLU, pg8::StaticOrder, true, true>(F.lds + RING_OFF, g, S, E, F.wave);
        p0_convert_down(F, arg_in(I_F2D), (bf16*)(ws + WS_W2D), F.G > 200 ? 192 : 0); } SEAM(15);
    if (IN(16)) { pg8::Gemm g{HB, (const bf16*)(ws + WS_W2D), SEQ, DM, DFF, DFF, nullptr, nullptr}; pg8::StaticOrder S; S.init(SEQ, DM, F.G, bid);
        pg8::EpiResLN E{Y, (const float*)(ws + WS_ST) + 4 * SEQ, arg_in(I_LN3G), arg_in(I_LN3B), XF, DM, DN_ALPHA, 0.5f}; pg8::gemm_phase<pg8::EpiResLN, pg8::StaticOrder, true, true>(F.lds + RING_OFF, g, S, E, F.wave); } SEAM(16);
    if (IN(17)) { ln_phase(F, XF, arg_in(I_LN4G), arg_in(I_LN4B), arg_out(), nullptr); }
#undef XB
#undef Y
#undef XF
#undef HB
#undef IN
#undef SEAM
#undef GRID_BAR
}

extern "C" void kernel_launch(void* const* d_in, const int* in_sizes, int n_in, void* d_out, int out_size, void* d_ws, size_t ws_size, hipStream_t stream) {
    static int grid = 0;
    if (grid == 0) {
        if (n_in != 31 || in_sizes[0] != SEQ * DM || out_size != SEQ * DM || ws_size < WS_END) { fprintf(stderr, "kernel_launch: built for 31 inputs, x/out of %d floats, >= %zu bytes of workspace; got n_in %d, in0 %d, out %d, ws %zu; nothing launched\n", SEQ * DM, (size_t)WS_END, n_in, n_in > 0 ? in_sizes[0] : -1, out_size, ws_size); grid = -1; return; }
        int dev = 0, cus = 0, per_cu = 0;
        if (hipGetDevice(&dev) != hipSuccess || hipDeviceGetAttribute(&cus, hipDeviceAttributeMultiprocessorCount, dev) != hipSuccess) { fprintf(stderr, "kernel_launch: device query failed\n"); grid = -1; return; }
        if (hipFuncSetAttribute((const void*)mk_fwd, hipFuncAttributeMaxDynamicSharedMemorySize, LDS_BYTES) != hipSuccess) { fprintf(stderr, "kernel_launch: hipFuncSetAttribute failed\n"); grid = -1; return; }
        if (hipOccupancyMaxActiveBlocksPerMultiprocessor(&per_cu, (const void*)mk_fwd, NWAVES * 64, LDS_BYTES) != hipSuccess || per_cu < 1)
            fprintf(stderr, "kernel_launch: note: occupancy query reports %d workgroups per CU\n", per_cu);
        (void)hipGetLastError();
        grid = cus;
    }
    if (grid < 0) return;
    if (hipMemsetAsync((char*)d_ws + WS_CTL, 0, CTL_ZERO_BYTES, stream) != hipSuccess) { fprintf(stderr, "kernel_launch: hipMemsetAsync failed\n"); return; }
    Args a{};
    for (int i = 0; i < 31; ++i) a.in[i] = (const float*)d_in[i];
    a.out = (float*)d_out; a.ws = (unsigned char*)d_ws;
    const int n_l = N_LAUNCHES;
    for (int li = 0; li < n_l; ++li) {
        a.ph_lo = (N_LAUNCHES == 1) ? 0 : li; a.ph_hi = (N_LAUNCHES == 1) ? NPHASES : li + 1;
        hipLaunchKernelGGL(mk_fwd, dim3(grid), dim3(NWAVES * 64), LDS_BYTES, stream, a);
        const hipError_t le = hipPeekAtLastError();
        if (le != hipSuccess) { fprintf(stderr, "kernel_launch: launch %d failed: %s\n", li, hipGetErrorName(le)); break; }
    }
}
```

```cpp
#include <hip/hip_runtime.h>
#include <cstdio>
#include <cstdint>
__device__ __forceinline__ int mk_lane() { int l; asm volatile("v_mbcnt_lo_u32_b32 %0, -1, 0\n\tv_mbcnt_hi_u32_b32 %0, -1, %0" : "=v"(l)); return l; }
namespace pg8 {
#define PG8_LAS __attribute__((address_space(3)))
typedef unsigned short bf16_t;
typedef short bf16x8 __attribute__((ext_vector_type(8)));
typedef float f32x4 __attribute__((ext_vector_type(4)));
typedef unsigned u32x4 __attribute__((ext_vector_type(4)));
constexpr int BM = 256, BK = 64, HALF = 128, HTB = HALF * BK * 2  , STAGE_BYTES = 8 * HTB, NXCD = 8, WGM = 8;

__host__ __device__ __forceinline__ int lds_byte(int r, int c) { const int st = (r >> 4) * 2 + (c >> 5), rr = r & 15, cc = c & 31, ob = rr * 64 + cc * 2; return st * 1024 + (ob ^ (((ob >> 9) & 1) << 5)); }
__host__ __device__ __forceinline__ void stage_rc(int b, int& R, int& C) { const int st = b / 1024, sb = b % 1024, swz = sb ^ (((sb >> 9) & 1) << 5); R = (st >> 1) * 16 + swz / 64; C = (st & 1) * 32 + (swz % 64) / 2; }
__host__ __device__ __forceinline__ int perm32(int rho) { const int n = rho >> 4, i = rho & 15; return 8 * (i >> 2) + 4 * n + (i & 3); }

struct Unit { int pm, pn, seg, ko; };
struct Gemm { const bf16_t* A; const bf16_t* Bt; int M, N, K, ld; const bf16_t* A2; const bf16_t* Bt2; };

struct StaticOrder {
    int nM, nN, nwg, G, c;
    __host__ __device__ void init(int M, int N, int G_, int c_) { nM = M / BM; nN = N / BM; nwg = nM * nN; G = G_; c = c_; }
    __host__ __device__ bool next(int i, Unit& u) const {
        const long L = (long)i * G + c; if (L >= nwg) return false;
        int wgid = (int)L; { const int q = nwg / NXCD, r = nwg % NXCD, xcd = wgid % NXCD, off = wgid / NXCD; wgid = (xcd < r ? xcd * (q + 1) : r * (q + 1) + (xcd - r) * q) + off; }
        const int nig = WGM * nN, gid = wgid / nig, fm = gid * WGM, gsz = (nM - fm) < WGM ? (nM - fm) : WGM;
        u.pm = fm + ((wgid % nig) % gsz); u.pn = (wgid % nig) / gsz; u.seg = 0; u.ko = 0; return true;
    }
    __device__ __forceinline__ void a_ready(const Unit&) const {}
    __device__ __forceinline__ void done(const Unit&) const {}
};
struct DualOrder : StaticOrder { __device__ __forceinline__ bool next(int i, Unit& u) const { if (!StaticOrder::next(i >> 1, u)) return false; u.seg = i & 1; return true; } };
struct SplitKOrder { int M, N, ntiles, nks, K, G, c;
    __device__ __forceinline__ void init(int M_, int N_, int K_, int nks_, int G_, int c_) { M = M_; N = N_; ntiles = (M_ / BM) * (N_ / BM); nks = nks_; K = K_; G = G_; c = c_; }
    __device__ __forceinline__ bool next(int i, Unit& u) const { const long L = (long)i * G + c; if (L >= (long)ntiles * nks) return false;
        StaticOrder b; b.init(M, N, ntiles, (int)(L % ntiles)); b.next(0, u); u.seg = 0; u.ko = (int)(L / ntiles) * K; return true; }
    __device__ __forceinline__ void a_ready(const Unit&) const {}
    __device__ __forceinline__ void done(const Unit&) const {}
};

typedef __bf16 bf16x2_cv __attribute__((ext_vector_type(2)));
typedef float f32x2_cv __attribute__((ext_vector_type(2)));
__device__ __forceinline__ unsigned cvt_pk_bf16_pinned(float lo, float hi) { unsigned r; asm volatile("s_nop 1\n\tv_cvt_pk_bf16_f32 %0, %1, %2" : "=v"(r) : "v"(lo), "v"(hi)); return r; }
__device__ __forceinline__ unsigned cvt_pk_bf16(float lo, float hi) { const bf16x2_cv v = __builtin_convertvector((f32x2_cv){lo, hi}, bf16x2_cv); return __builtin_bit_cast(unsigned, v); }
__device__ __forceinline__ u32x4 pack8(const f32x4 a, const f32x4 b) { u32x4 w; w.x = cvt_pk_bf16(a[0], a[1]); w.y = cvt_pk_bf16(a[2], a[3]); w.z = cvt_pk_bf16(b[0], b[1]); w.w = cvt_pk_bf16(b[2], b[3]); return w; }
__device__ __forceinline__ float sigm(float x) { return __builtin_amdgcn_rcpf(1.0f + __builtin_amdgcn_exp2f(-1.4426950408889634f * x)); }
__device__ __forceinline__ f32x4 sigm4(const f32x4 x) { return (f32x4){sigm(x[0]), sigm(x[1]), sigm(x[2]), sigm(x[3])}; }
__device__ __forceinline__ f32x4 bf_lo4(const u32x4 w) { return (f32x4){__uint_as_float(w.x << 16), __uint_as_float(w.x & 0xffff0000u), __uint_as_float(w.y << 16), __uint_as_float(w.y & 0xffff0000u)}; }
__device__ __forceinline__ f32x4 bf_hi4(const u32x4 w) { return (f32x4){__uint_as_float(w.z << 16), __uint_as_float(w.z & 0xffff0000u), __uint_as_float(w.w << 16), __uint_as_float(w.w & 0xffff0000u)}; }

struct EpiBf16 {
    static constexpr bool PERM = true, AFTER_DRAIN = false, CHAIN = false;
    bf16_t* O; int ldc;
    __device__ __forceinline__ void operator()(const f32x4 (&acc)[2][2][4][2], const Unit& u, int wr, int wc, int fr, int fq) const {
        const int row0 = u.pm * BM + wr * 64 + fr, col0 = u.pn * BM + wc * 32 + 8 * fq;
#pragma unroll
        for (int ai = 0; ai < 2; ++ai)
#pragma unroll
            for (int m = 0; m < 4; ++m) { bf16_t* rowp = O + (size_t)(row0 + ai * HALF + m * 16) * ldc + col0;
#pragma unroll
                for (int bj = 0; bj < 2; ++bj) *(u32x4*)(rowp + bj * HALF) = pack8(acc[ai][bj][m][0], acc[ai][bj][m][1]); }
    }
};
struct EpiSwiGLU {
    static constexpr bool PERM = true, AFTER_DRAIN = false, CHAIN = false;
    bf16_t* H; int ldh;
    __device__ __forceinline__ void operator()(const f32x4 (&acc)[2][2][4][2], const Unit& u, int wr, int wc, int fr, int fq) const {
        const int row0 = u.pm * BM + wr * 64 + fr, col0 = u.pn * HALF + wc * 32 + 8 * fq;
#pragma unroll
        for (int ai = 0; ai < 2; ++ai)
#pragma unroll
            for (int m = 0; m < 4; ++m) { bf16_t* rowp = H + (size_t)(row0 + ai * HALF + m * 16) * ldh + col0;
                const f32x4 g0 = acc[ai][0][m][0], g1 = acc[ai][0][m][1];
                const f32x4 v0 = g0 * sigm4(g0) * acc[ai][1][m][0], v1 = g1 * sigm4(g1) * acc[ai][1][m][1];
                *(u32x4*)rowp = pack8(v0, v1); }
    }
};
struct EpiResF32 {
    static constexpr bool PERM = false, AFTER_DRAIN = false, CHAIN = false;
    const float* R; float* Y; int ldc; float alpha, beta;
    __device__ __forceinline__ void operator()(const f32x4 (&acc)[2][2][4][2], const Unit& u, int wr, int wc, int fr, int fq) const {
        const int row0 = u.pm * BM + wr * 64 + fr, col0 = u.pn * BM + wc * 32 + 4 * fq;
#pragma unroll
        for (int ai = 0; ai < 2; ++ai)
#pragma unroll
            for (int m = 0; m < 4; ++m) { const size_t off = (size_t)(row0 + ai * HALF + m * 16) * ldc + col0;
#pragma unroll
                for (int bj = 0; bj < 2; ++bj)
#pragma unroll
                    for (int n = 0; n < 2; ++n) { const f32x4 r = *(const f32x4*)(R + off + bj * HALF + n * 16); *(f32x4*)(Y + off + bj * HALF + n * 16) = r * alpha + acc[ai][bj][m][n] * beta; }
                asm volatile("" ::: "memory"); }
    }
};
struct EpiMixIn {
    static constexpr bool PERM = true, AFTER_DRAIN = false, CHAIN = false;
    bf16_t* PB; size_t segstride;
    float* HF;
    bf16_t* GA; bf16_t* GB;
    const float* COS; const float* SIN;
    __device__ __forceinline__ void operator()(const f32x4 (&acc)[2][2][4][2], const Unit& u, int wr, int wc, int fr, int fq) const {
        const int seg = u.pn >> 3, row0 = u.pm * BM + wr * 64 + fr;
        if (seg < 2) {
            bf16_t* base = PB + (size_t)seg * segstride + (u.pn & 7) * 256 + (wc >> 1) * 128 + 32 * (wc & 1) + 8 * fq;
            const int d0 = 32 * (wc & 1) + 8 * fq;
#pragma unroll
            for (int ai = 0; ai < 2; ++ai) { f32x4 cs[4][4];
#pragma unroll
                for (int m = 0; m < 4; ++m) { const size_t ro = (size_t)(row0 + ai * HALF + m * 16) * 64 + d0;
                    cs[m][0] = *(const f32x4*)(COS + ro); cs[m][1] = *(const f32x4*)(COS + ro + 4); cs[m][2] = *(const f32x4*)(SIN + ro); cs[m][3] = *(const f32x4*)(SIN + ro + 4); }
#pragma unroll
                for (int m = 0; m < 4; ++m) { const int row = row0 + ai * HALF + m * 16;
                    const f32x4 c0 = cs[m][0], c1 = cs[m][1], s0 = cs[m][2], s1 = cs[m][3];
                    const f32x4 x1a = acc[ai][0][m][0], x1b = acc[ai][0][m][1], x2a = acc[ai][1][m][0], x2b = acc[ai][1][m][1];
                    bf16_t* dst = base + (size_t)row * 2048;
                    *(u32x4*)dst = pack8(x1a * c0 - x2a * s0, x1b * c1 - x2b * s1);
                    *(u32x4*)(dst + 64) = pack8(x2a * c0 + x1a * s0, x2b * c1 + x1b * s1); }
                asm volatile("" ::: "memory"); }
        } else if (seg == 4) {
            float* base = HF + (u.pn & 7) * 256 + wc * 32 + 8 * fq;
#pragma unroll
            for (int ai = 0; ai < 2; ++ai)
#pragma unroll
                for (int m = 0; m < 4; ++m) { float* dst = base + (size_t)(row0 + ai * HALF + m * 16) * 2048;
#pragma unroll
                    for (int bj = 0; bj < 2; ++bj) { *(f32x4*)(dst + bj * HALF) = acc[ai][bj][m][0]; *(f32x4*)(dst + bj * HALF + 4) = acc[ai][bj][m][1]; } }
        } else if (seg >= 7) {
            bf16_t* base = (seg >= 9 ? GB + (u.pn - 72) * 256 : GA + (u.pn - 56) * 256) + wc * 32 + 8 * fq;
#pragma unroll
            for (int ai = 0; ai < 2; ++ai)
#pragma unroll
                for (int m = 0; m < 4; ++m) { bf16_t* dst = base + (size_t)(row0 + ai * HALF + m * 16) * 4096;
#pragma unroll
                    for (int bj = 0; bj < 2; ++bj) *(u32x4*)(dst + bj * HALF) = pack8(sigm4(acc[ai][bj][m][0]), sigm4(acc[ai][bj][m][1])); }
        } else {
            const int slot = seg <= 3 ? seg : seg - 1;
            bf16_t* base = PB + (size_t)slot * segstride + (u.pn & 7) * 256 + wc * 32 + 8 * fq;
#pragma unroll
            for (int ai = 0; ai < 2; ++ai)
#pragma unroll
                for (int m = 0; m < 4; ++m) { bf16_t* dst = base + (size_t)(row0 + ai * HALF + m * 16) * 2048;
#pragma unroll
                    for (int bj = 0; bj < 2; ++bj) *(u32x4*)(dst + bj * HALF) = pack8(acc[ai][bj][m][0], acc[ai][bj][m][1]); }
        }
    }
};

struct EpiMerge {
    static constexpr bool PERM = true, AFTER_DRAIN = false, CHAIN = true;
    const bf16_t* GA; const bf16_t* GB; bf16_t* O; int ldc;
    __device__ __forceinline__ void mid(f32x4 (&acc)[2][2][4][2], const Unit& u, int wr, int wc, int fr, int fq) const {
        const int row0 = u.pm * BM + wr * 64 + fr, col0 = u.pn * BM + wc * 32 + 8 * fq;
#pragma unroll
        for (int ai = 0; ai < 2; ++ai)
#pragma unroll
            for (int m = 0; m < 4; ++m) { const size_t off = (size_t)(row0 + ai * HALF + m * 16) * ldc + col0;
#pragma unroll
                for (int bj = 0; bj < 2; ++bj) { const u32x4 ga = *(const u32x4*)(GA + off + bj * HALF), gb = *(const u32x4*)(GB + off + bj * HALF);
                    const f32x4 b0 = bf_lo4(gb), b1 = bf_hi4(gb);
                    const f32x4 r0 = bf_lo4(ga) * (f32x4){__builtin_amdgcn_rcpf(fmaxf(b0[0], 1e-30f)), __builtin_amdgcn_rcpf(fmaxf(b0[1], 1e-30f)), __builtin_amdgcn_rcpf(fmaxf(b0[2], 1e-30f)), __builtin_amdgcn_rcpf(fmaxf(b0[3], 1e-30f))};
                    const f32x4 r1 = bf_hi4(ga) * (f32x4){__builtin_amdgcn_rcpf(fmaxf(b1[0], 1e-30f)), __builtin_amdgcn_rcpf(fmaxf(b1[1], 1e-30f)), __builtin_amdgcn_rcpf(fmaxf(b1[2], 1e-30f)), __builtin_amdgcn_rcpf(fmaxf(b1[3], 1e-30f))};
                    acc[ai][bj][m][0] = acc[ai][bj][m][0] * r0; acc[ai][bj][m][1] = acc[ai][bj][m][1] * r1; } }
    }
    __device__ __forceinline__ void operator()(const f32x4 (&acc)[2][2][4][2], const Unit& u, int wr, int wc, int fr, int fq) const {
        const int row0 = u.pm * BM + wr * 64 + fr, col0 = u.pn * BM + wc * 32 + 8 * fq;
#pragma unroll
        for (int ai = 0; ai < 2; ++ai)
#pragma unroll
            for (int m = 0; m < 4; ++m) { const size_t off = (size_t)(row0 + ai * HALF + m * 16) * ldc + col0;
#pragma unroll
                for (int bj = 0; bj < 2; ++bj) { const u32x4 gb = *(const u32x4*)(GB + off + bj * HALF);
                    *(u32x4*)(O + off + bj * HALF) = pack8(bf_lo4(gb) * acc[ai][bj][m][0], bf_hi4(gb) * acc[ai][bj][m][1]); } }
    }
};
struct EpiF32Part {
    static constexpr bool PERM = false, AFTER_DRAIN = false, CHAIN = false;
    float* P; int ldc; int kslice; size_t slice_stride;
    __device__ __forceinline__ void operator()(const f32x4 (&acc)[2][2][4][2], const Unit& u, int wr, int wc, int fr, int fq) const {
        const int row0 = u.pm * BM + wr * 64 + fr, col0 = u.pn * BM + wc * 32 + 4 * fq; float* base = P + (size_t)(u.ko / kslice) * slice_stride;
#pragma unroll
        for (int ai = 0; ai < 2; ++ai)
#pragma unroll
            for (int m = 0; m < 4; ++m) { float* rowp = base + (size_t)(row0 + ai * HALF + m * 16) * ldc + col0;
#pragma unroll
                for (int bj = 0; bj < 2; ++bj)
#pragma unroll
                    for (int n = 0; n < 2; ++n) *(f32x4*)(rowp + bj * HALF + n * 16) = acc[ai][bj][m][n]; }
    }
};
struct EpiResLN {
    static constexpr bool PERM = false, AFTER_DRAIN = false, CHAIN = false;
    const float* Yp; const float* ST; const float* G; const float* B; float* Y; int ldc; float alpha, beta;
    __device__ __forceinline__ void operator()(const f32x4 (&acc)[2][2][4][2], const Unit& u, int wr, int wc, int fr, int fq) const {
        const int row0 = u.pm * BM + wr * 64 + fr, col0 = u.pn * BM + wc * 32 + 4 * fq;
        f32x4 g4[2][2], b4[2][2];
#pragma unroll
        for (int bj = 0; bj < 2; ++bj)
#pragma unroll
            for (int n = 0; n < 2; ++n) { g4[bj][n] = *(const f32x4*)(G + col0 + bj * HALF + n * 16); b4[bj][n] = *(const f32x4*)(B + col0 + bj * HALF + n * 16); }
#pragma unroll
        for (int ai = 0; ai < 2; ++ai)
#pragma unroll
            for (int m = 0; m < 4; ++m) { const int row = row0 + ai * HALF + m * 16; const size_t off = (size_t)row * ldc + col0;
                const float mean = ST[2 * row], rstd = ST[2 * row + 1];
#pragma unroll
                for (int bj = 0; bj < 2; ++bj)
#pragma unroll
                    for (int n = 0; n < 2; ++n) { const f32x4 yp = *(const f32x4*)(Yp + off + bj * HALF + n * 16);
                        const f32x4 x = (yp - mean) * rstd * g4[bj][n] + b4[bj][n];
                        *(f32x4*)(Y + off + bj * HALF + n * 16) = x * alpha + acc[ai][bj][m][n] * beta; }
                asm volatile("" ::: "memory"); }
    }
};
template <class Epi, class Sched, bool ALIGN_EPI = false, bool SP2 = false>
__device__ __forceinline__ void gemm_phase(PG8_LAS unsigned char* lds, const Gemm g, const Sched& S, const Epi& E, const int wid) {
    const int lane = mk_lane(), tid = wid * 64 + lane, wr = wid >> 2, wc = wid & 3, fr = lane & 15, fq = lane >> 4;
    const int K = g.K, LD = g.ld, nt = K / BK;
    unsigned voffA[2], voffB[2];
#pragma unroll
    for (int i = 0; i < 2; ++i) { int R, C; stage_rc(tid * 16 + i * 8192, R, C); const int Rb = Epi::PERM ? ((R & ~31) + perm32(R & 31)) : R;
        voffA[i] = (unsigned)(R * LD + C) * 2u; voffB[i] = (unsigned)(Rb * LD + C) * 2u; }
    const size_t kstep = (size_t)(BK * 2);
    const size_t hstep = (size_t)HALF * LD * 2;
    const size_t tstep = 2 * hstep;
    const unsigned ldsw = (unsigned)wid * 1024u;
    const int aoff = lds_byte(wr * 64 + fr, fq * 8), boff = lds_byte(wc * 32 + fr, fq * 8);
#define PG8_SA(b, h) (((b) * 2 + (h)) * HTB)
#define PG8_SB(b, h) ((4 + (b) * 2 + (h)) * HTB)
#define PG8_STAGE(bufoff, gbase, voff) do { _Pragma("unroll") for (int _i = 0; _i < 2; ++_i) \
        __builtin_amdgcn_global_load_lds((const unsigned*)((const char*)(gbase) + (voff)[_i]), (PG8_LAS unsigned*)(lds + (bufoff) + ldsw + _i * 8192), 16, 0, 0); } while (0)
#define PG8_LDA(dst, b, h) do { _Pragma("unroll") for (int m = 0; m < 4; ++m) _Pragma("unroll") for (int k = 0; k < 2; ++k) dst[m][k] = *(const PG8_LAS bf16x8*)(lds + PG8_SA(b, h) + aoff + m * 2048 + k * 1024); } while (0)
#define PG8_LDB(dst, b, h) do { _Pragma("unroll") for (int n = 0; n < 2; ++n) _Pragma("unroll") for (int k = 0; k < 2; ++k) dst[n][k] = *(const PG8_LAS bf16x8*)(lds + PG8_SB(b, h) + boff + n * 2048 + k * 1024); } while (0)
#define PG8_MMA(ai, bj, At, Bt) do { __builtin_amdgcn_s_setprio(1); _Pragma("unroll") for (int m = 0; m < 4; ++m) _Pragma("unroll") for (int n = 0; n < 2; ++n) _Pragma("unroll") for (int k = 0; k < 2; ++k) \
        acc[ai][bj][m][n] = __builtin_amdgcn_mfma_f32_16x16x32_bf16(Bt[n][k], At[m][k], acc[ai][bj][m][n], 0, 0, 0); __builtin_amdgcn_s_setprio(0); } while (0)
#define PG8_WAIT_V(n) asm volatile("s_waitcnt vmcnt(" #n ")" ::: "memory")
#define PG8_WAIT_L(n) asm volatile("s_waitcnt lgkmcnt(" #n ")" ::: "memory")
#define PG8_BAR __builtin_amdgcn_s_barrier()
#define PG8_SCHED __builtin_amdgcn_sched_barrier(0)
    Unit cur, nxt; int ui = 0;
    if (!S.next(0, cur)) return;
    f32x4 acc[2][2][4][2];
#pragma unroll
    for (int a = 0; a < 2; ++a)
#pragma unroll
        for (int b = 0; b < 2; ++b)
#pragma unroll
            for (int m = 0; m < 4; ++m)
#pragma unroll
                for (int n = 0; n < 2; ++n) acc[a][b][m][n] = (f32x4){0.f, 0.f, 0.f, 0.f};
    bf16x8 At[4][2], B0[2][2], B1[2][2];
#define PG8_UA(u) ((const char*)((u).seg ? g.A2 : g.A) + (size_t)(u).pm * tstep + (size_t)(u).ko * 2)
#define PG8_UB(u) ((const char*)((u).seg ? g.Bt2 : g.Bt) + (size_t)(u).pn * tstep + (size_t)(u).ko * 2)
    const char* cA = PG8_UA(cur); const char* cB = PG8_UB(cur);
    S.a_ready(cur);
    if constexpr (SP2) {
        PG8_STAGE(PG8_SB(0, 0), cB, voffB); PG8_STAGE(PG8_SB(0, 1), cB + hstep, voffB); PG8_STAGE(PG8_SA(0, 0), cA, voffA); PG8_STAGE(PG8_SA(0, 1), cA + hstep, voffA);
        if (wr == 1) PG8_BAR;
        PG8_WAIT_V(2); PG8_BAR;
        PG8_STAGE(PG8_SB(1, 0), cB + kstep, voffB); PG8_STAGE(PG8_SA(1, 0), cA + kstep, voffA); PG8_STAGE(PG8_SB(1, 1), cB + hstep + kstep, voffB);
        PG8_WAIT_V(6); PG8_BAR;
    } else {
        PG8_STAGE(PG8_SB(0, 0), cB, voffB); PG8_STAGE(PG8_SA(0, 0), cA, voffA); PG8_STAGE(PG8_SB(0, 1), cB + hstep, voffB); PG8_STAGE(PG8_SA(0, 1), cA + hstep, voffA);
        if (wr == 1) PG8_BAR;
        PG8_WAIT_V(4); PG8_BAR;
        PG8_STAGE(PG8_SB(1, 0), cB + kstep, voffB); PG8_STAGE(PG8_SA(1, 0), cA + kstep, voffA); PG8_STAGE(PG8_SB(1, 1), cB + hstep + kstep, voffB);
        PG8_WAIT_V(6); PG8_BAR;
    }
    for (;;) {
        const bool has_next = S.next(ui + 1, nxt);
        const char* nA = has_next ? PG8_UA(nxt) : cA; const char* nB = has_next ? PG8_UB(nxt) : cB;
        for (int t = 0; t < nt; t += 2) {
            const bool last = (t == nt - 2);
            const char* a1 = cA + (size_t)(t + 1) * kstep;
            const char* a2 = last ? nA : cA + (size_t)(t + 2) * kstep; const char* b2 = last ? nB : cB + (size_t)(t + 2) * kstep;
            const char* a3 = a2 + kstep; const char* b3 = b2 + kstep;
            if (last && has_next) S.a_ready(nxt);
            if constexpr (SP2) {
            PG8_LDB(B0, 0, 0); PG8_LDB(B1, 0, 1); PG8_SCHED; PG8_LDA(At, 0, 0); PG8_STAGE(PG8_SA(1, 1), a1 + hstep, voffA);
            PG8_WAIT_V(8); PG8_WAIT_L(0); PG8_BAR; PG8_MMA(0, 0, At, B0); PG8_MMA(0, 1, At, B1); PG8_BAR; PG8_SCHED;
            PG8_LDA(At, 0, 1); PG8_STAGE(PG8_SB(0, 0), b2, voffB); PG8_STAGE(PG8_SB(0, 1), b2 + hstep, voffB); PG8_STAGE(PG8_SA(0, 0), a2, voffA);
            PG8_WAIT_V(8); PG8_WAIT_L(0); PG8_BAR; PG8_MMA(1, 0, At, B0); PG8_MMA(1, 1, At, B1); PG8_BAR; PG8_SCHED;
            PG8_LDB(B0, 1, 0); PG8_LDB(B1, 1, 1); PG8_SCHED; PG8_LDA(At, 1, 0); PG8_STAGE(PG8_SA(0, 1), a2 + hstep, voffA);
            PG8_WAIT_V(8); PG8_WAIT_L(0); PG8_BAR; PG8_MMA(0, 0, At, B0); PG8_MMA(0, 1, At, B1); PG8_BAR; PG8_SCHED;
            PG8_LDA(At, 1, 1); PG8_STAGE(PG8_SB(1, 0), b3, voffB); PG8_STAGE(PG8_SB(1, 1), b3 + hstep, voffB); PG8_STAGE(PG8_SA(1, 0), a3, voffA);
            PG8_WAIT_V(8); PG8_WAIT_L(0); PG8_BAR; PG8_MMA(1, 0, At, B0); PG8_MMA(1, 1, At, B1); PG8_BAR; PG8_SCHED;
            } else {
            PG8_LDB(B0, 0, 0); PG8_SCHED; PG8_LDA(At, 0, 0); PG8_STAGE(PG8_SA(1, 1), a1 + hstep, voffA);
            PG8_WAIT_L(8); PG8_BAR; PG8_WAIT_L(0); PG8_MMA(0, 0, At, B0); PG8_BAR; PG8_SCHED;
            PG8_LDB(B1, 0, 1); PG8_STAGE(PG8_SB(0, 0), b2, voffB);
            PG8_BAR; PG8_WAIT_L(0); PG8_MMA(0, 1, At, B1); PG8_BAR;
            PG8_LDA(At, 0, 1); PG8_STAGE(PG8_SA(0, 0), a2, voffA);
            PG8_BAR; PG8_WAIT_L(0); PG8_MMA(1, 0, At, B0); PG8_BAR; PG8_SCHED;
            PG8_STAGE(PG8_SB(0, 1), b2 + hstep, voffB);
            PG8_WAIT_V(6); PG8_BAR; PG8_MMA(1, 1, At, B1); PG8_BAR;
            PG8_LDB(B0, 1, 0); PG8_SCHED; PG8_LDA(At, 1, 0); PG8_STAGE(PG8_SA(0, 1), a2 + hstep, voffA);
            PG8_WAIT_L(8); PG8_BAR; PG8_WAIT_L(0); PG8_MMA(0, 0, At, B0); PG8_BAR; PG8_SCHED;
            PG8_LDB(B1, 1, 1); PG8_STAGE(PG8_SB(1, 0), b3, voffB);
            PG8_BAR; PG8_WAIT_L(0); PG8_MMA(0, 1, At, B1); PG8_BAR;
            PG8_LDA(At, 1, 1); PG8_STAGE(PG8_SA(1, 0), a3, voffA);
            PG8_BAR; PG8_WAIT_L(0); PG8_MMA(1, 0, At, B0); PG8_BAR; PG8_SCHED;
            PG8_STAGE(PG8_SB(1, 1), b3 + hstep, voffB);
            PG8_WAIT_V(6); PG8_BAR; PG8_MMA(1, 1, At, B1); PG8_BAR;
            }
        }
        if constexpr (ALIGN_EPI) { if (wr == 0) PG8_BAR; }
        bool keep_acc = false;
        if constexpr (Epi::CHAIN) { if (cur.seg == 0) { E.mid(acc, cur, wr, wc, fr, fq); keep_acc = true; } else E(acc, cur, wr, wc, fr, fq); }
        else if constexpr (!Epi::AFTER_DRAIN) { E(acc, cur, wr, wc, fr, fq); S.done(cur); }
        if (!has_next) break;
        if (!keep_acc) {
#pragma unroll
        for (int a = 0; a < 2; ++a)
#pragma unroll
            for (int b = 0; b < 2; ++b)
#pragma unroll
                for (int m = 0; m < 4; ++m)
#pragma unroll
                    for (int n = 0; n < 2; ++n) acc[a][b][m][n] = (f32x4){0.f, 0.f, 0.f, 0.f};
        }
        cur = nxt; cA = nA; cB = nB; ++ui;
        if constexpr (ALIGN_EPI) { if (wr == 1) PG8_BAR; }
    }
    PG8_WAIT_V(0);
    if constexpr (!ALIGN_EPI) { if (wr == 0) PG8_BAR; }
    PG8_BAR;
    if constexpr (Epi::AFTER_DRAIN) { E.fused(acc, cur, wr, wc, fr, fq, lds, wid, lane); S.done(cur); }
#undef PG8_UA
#undef PG8_UB
#undef PG8_SA
#undef PG8_SB
#undef PG8_STAGE
#undef PG8_LDA
#undef PG8_LDB
#undef PG8_MMA
#undef PG8_WAIT_V
#undef PG8_WAIT_L
#undef PG8_BAR
#undef PG8_SCHED
}
}
namespace attn {
constexpr int D = 128;
constexpr float THR = 8.f;
constexpr bool WSKIP = false;
constexpr float SCALE = 0.08838834764831845f;
constexpr int NW = 8, QBLK = 32, KVBLK = 64, QB = NW * QBLK;
constexpr int SHM_V = KVBLK * D * 2, SHM_K = KVBLK * D * 2;
constexpr int LDS_BYTES = 2 * SHM_V + 2 * SHM_K + NW * 64 * 4;

typedef unsigned short bf16;
typedef short bf16x8 __attribute__((ext_vector_type(8)));
typedef short s16x4 __attribute__((ext_vector_type(4)));
typedef float f32x16 __attribute__((ext_vector_type(16)));
typedef float f32x4 __attribute__((ext_vector_type(4)));
typedef unsigned u32x4 __attribute__((ext_vector_type(4)));
template <class A, class Bt> struct same_t { static constexpr bool v = false; };
template <class A> struct same_t<A, A> { static constexpr bool v = true; };

#define KSWZ(row, colB) ((row) * 256 + ((colB) ^ (((row) & 7) << 4)))
#define SBAR() __builtin_amdgcn_sched_barrier(0)
__device__ __forceinline__ int v_st(int k, int c) { const int kk = (k & ~0xC) | ((k & 4) << 1) | ((k & 8) >> 1); return ((kk >> 3) * 4 + (c >> 5)) * 512 + ((kk & 7) * 32 + (c & 31)) * 2; }
__device__ __forceinline__ int v_rd_base(int lane) { return ((lane & 3) << 3) | (((lane >> 2) & 3) << 6) | (((lane >> 4) & 1) << 5) | (((lane >> 5) & 1) << 8); }
constexpr int v_rd_off(int d0, int ks, int half) { return d0 * 512 + ks * 4096 + half * 2048; }
__device__ __forceinline__ int crow(int r, int hi) { return (r & 3) + 8 * (r >> 2) + 4 * hi; }
__device__ __forceinline__ unsigned cvtpk(float lo, float hi) {
    unsigned r; asm volatile("v_cvt_pk_bf16_f32 %0, %1, %2" : "=v"(r) : "v"(lo), "v"(hi)); return r;
}
__device__ __forceinline__ bf16x8 pack8(f32x4 a, f32x4 b) {
    u32x4 w = {cvtpk(a[0], a[1]), cvtpk(a[2], a[3]), cvtpk(b[0], b[1]), cvtpk(b[2], b[3])};
    return *reinterpret_cast<bf16x8*>(&w);
}
template <class T> __device__ __forceinline__ bf16x8 load8(const T* p) {
    if constexpr (same_t<T, float>::v) { return pack8(*(const f32x4*)p, *(const f32x4*)(p + 4)); }
    else { return *reinterpret_cast<const bf16x8*>(p); }
}
__device__ __forceinline__ void mask_tile(f32x16& p0, f32x16& p1, int dq, unsigned W) {
    const float NEG = -__builtin_inff();
#pragma unroll
    for (int r = 0; r < 16; ++r) {
        const int c = (r & 3) + 8 * (r >> 2);
        if ((unsigned)(dq - c) >= W) p0[r] = NEG;
        if ((unsigned)(dq - c - 32) >= W) p1[r] = NEG;
    }
}
__device__ __forceinline__ void partialSM(f32x16& p0, f32x16& p1, float& m_reg, float& mn, float& alpha) {
    float pmax = p0[0]; for (int r = 1; r < 16; ++r) pmax = fmaxf(pmax, p0[r]); for (int r = 0; r < 16; ++r) pmax = fmaxf(pmax, p1[r]);
    { auto rr = __builtin_amdgcn_permlane32_swap(__float_as_uint(pmax), __float_as_uint(pmax), false, false);
      pmax = fmaxf(__uint_as_float(rr[0]), __uint_as_float(rr[1])); }
    constexpr float C2 = 1.4426950408889634f * SCALE;
    if (__builtin_expect(__all((pmax - m_reg) * SCALE <= THR), 1)) { mn = m_reg; alpha = 1.f; }
    else { mn = fmaxf(m_reg, pmax); alpha = __builtin_amdgcn_exp2f((m_reg - mn) * C2); m_reg = mn; }
    const float mnL = -mn * C2;
    for (int r = 0; r < 16; ++r) p0[r] = fmaf(p0[r], C2, mnL); for (int r = 0; r < 16; ++r) p1[r] = fmaf(p1[r], C2, mnL);
    for (int r = 0; r < 16; ++r) p0[r] = __builtin_amdgcn_exp2f(p0[r]);
}
__device__ __forceinline__ void finishSM(f32x16& p0, f32x16& p1, float alpha, float& l_reg, bf16x8& pa0, bf16x8& pa1, bf16x8& pa2, bf16x8& pa3) {
    for (int r = 0; r < 16; ++r) p1[r] = __builtin_amdgcn_exp2f(p1[r]);
    float ps = 0; for (int r = 0; r < 16; ++r) ps += p0[r]; for (int r = 0; r < 16; ++r) ps += p1[r];
    { auto rr = __builtin_amdgcn_permlane32_swap(__float_as_uint(ps), __float_as_uint(ps), false, false);
      ps = __uint_as_float(rr[0]) + __uint_as_float(rr[1]); }
    l_reg = l_reg * alpha + ps;
#define PK4(P, B_, OUT) do { unsigned a0 = cvtpk(P[B_+0], P[B_+1]), a1 = cvtpk(P[B_+2], P[B_+3]);                          \
        unsigned b0 = cvtpk(P[B_+4], P[B_+5]), b1 = cvtpk(P[B_+6], P[B_+7]);                                             \
        auto r0 = __builtin_amdgcn_permlane32_swap(a0, b0, false, false); auto r1 = __builtin_amdgcn_permlane32_swap(a1, b1, false, false); \
        u32x4 w = {r0[0], r1[0], r0[1], r1[1]}; OUT = *reinterpret_cast<bf16x8*>(&w); } while (0)
    PK4(p0, 0, pa0); PK4(p0, 8, pa1); PK4(p1, 0, pa2); PK4(p1, 8, pa3);
#undef PK4
}
template <int KB, bool SK>
__device__ __forceinline__ void qkt(f32x16& p0, f32x16& p1, const char* K_lds, int r32, int hi, const bf16x8* qr, bool act) {
    if (SK && !act) { const float NEG = -__builtin_inff();
#pragma unroll
        for (int r = 0; r < 16; ++r) { p0[r] = NEG; p1[r] = NEG; } return; }
    p0 = f32x16{}; p1 = f32x16{};
    const char* kb[4];
#pragma unroll
    for (int dd = 0; dd < 4; ++dd) kb[dd] = K_lds + KB * SHM_K + KSWZ(r32, (dd * 16 + hi * 8) * 2);
#pragma unroll
    for (int d0 = 0; d0 < 8; ++d0) { const char* a = kb[d0 & 3] + (d0 >> 2) * 128;
        bf16x8 b0 = *reinterpret_cast<const bf16x8*>(a);
        bf16x8 b1 = *reinterpret_cast<const bf16x8*>(a + 32 * 256);
        p0 = __builtin_amdgcn_mfma_f32_32x32x16_bf16(b0, qr[d0], p0, 0, 0, 0);
        p1 = __builtin_amdgcn_mfma_f32_32x32x16_bf16(b1, qr[d0], p1, 0, 0, 0); }
}
template <int VB, bool SK>
__device__ __forceinline__ void pv_tile(f32x16* o, int vb0, bf16x8 pa0, bf16x8 pa1, bf16x8 pa2, bf16x8 pa3, bool act) {
    if (SK && !act) return;
#define TRRD(dst, off) asm volatile("ds_read_b64_tr_b16 %0, %1 offset:%2" : "=&v"(dst) : "v"(vb0), "i"(off) : "memory")
#define PV_D0(d0) do { s16x4 l0, l1, l2, l3, h0, h1, h2, h3; constexpr int b_ = VB * SHM_V + v_rd_off(d0, 0, 0);     \
        TRRD(l0, b_); TRRD(h0, b_ + 2048); TRRD(l1, b_ + 4096); TRRD(h1, b_ + 6144); TRRD(l2, b_ + 8192); TRRD(h2, b_ + 10240); TRRD(l3, b_ + 12288); TRRD(h3, b_ + 14336); \
        asm volatile("s_waitcnt lgkmcnt(0)" ::: "memory"); SBAR();                 \
        o[d0] = __builtin_amdgcn_mfma_f32_32x32x16_bf16(pa0, (bf16x8){l0[0], l0[1], l0[2], l0[3], h0[0], h0[1], h0[2], h0[3]}, o[d0], 0, 0, 0);   \
        o[d0] = __builtin_amdgcn_mfma_f32_32x32x16_bf16(pa1, (bf16x8){l1[0], l1[1], l1[2], l1[3], h1[0], h1[1], h1[2], h1[3]}, o[d0], 0, 0, 0);   \
        o[d0] = __builtin_amdgcn_mfma_f32_32x32x16_bf16(pa2, (bf16x8){l2[0], l2[1], l2[2], l2[3], h2[0], h2[1], h2[2], h2[3]}, o[d0], 0, 0, 0);   \
        o[d0] = __builtin_amdgcn_mfma_f32_32x32x16_bf16(pa3, (bf16x8){l3[0], l3[1], l3[2], l3[3], h3[0], h3[1], h3[2], h3[3]}, o[d0], 0, 0, 0); } while (0)
    PV_D0(0); PV_D0(1); PV_D0(2); PV_D0(3);
#undef PV_D0
#undef TRRD
}

template <class TIn, class TOut> struct BlockRef { const TIn* Q; const TIn* K; const TIn* V; TOut* O; int P0; };
template <class TIn> struct Seam {
    bf16x8 qr[8];
    bf16x8 st_v0, st_v1, st_k0, st_k1; f32x4 sf0, sf1, sf2, sf3;
    f32x4 tq[16];
};
__device__ __forceinline__ int swa_jlo(int P0, int W) { const int lowk = P0 - W + 1; return lowk > 0 ? lowk / KVBLK : 0; }
#define ROW(p, k0, rr) ((p) + (size_t)((k0) + (rr)) * KS + sc)
#define VMW() asm volatile("s_waitcnt vmcnt(0)" ::: "memory")
#define VMWN(n) asm volatile("s_waitcnt vmcnt(%0)" :: "i"(n) : "memory")
#define SLOAD_H(Kp, Vp, k0) do { S.st_v0 = load8<TIn>(ROW(Vp, k0, sr)); S.st_v1 = load8<TIn>(ROW(Vp, k0, 32 + sr));              \
                         S.st_k0 = load8<TIn>(ROW(Kp, k0, sr)); S.st_k1 = load8<TIn>(ROW(Kp, k0, 32 + sr)); } while (0)
#define SWRITE_HK(bf) do { *(bf16x8*)(K_lds + (bf) * SHM_K + kws) = S.st_k0; *(bf16x8*)(K_lds + (bf) * SHM_K + kws + 32 * 256) = S.st_k1; } while (0)
#define SWRITE_HV(bf) do { *(bf16x8*)(V_lds + (bf) * SHM_V + vst0) = S.st_v0; *(bf16x8*)(V_lds + (bf) * SHM_V + vst1) = S.st_v1; } while (0)
#define SWRITE_H(bf) do { SWRITE_HV(bf); SWRITE_HK(bf); } while (0)
#define SLOAD_F(p, k0) do { S.sf0 = *(const f32x4*)ROW(p, k0, sr); S.sf1 = *(const f32x4*)(ROW(p, k0, sr) + 4);                \
                            S.sf2 = *(const f32x4*)ROW(p, k0, 32 + sr); S.sf3 = *(const f32x4*)(ROW(p, k0, 32 + sr) + 4); } while (0)
#define SWRITE_KF(bf) do { *(bf16x8*)(K_lds + (bf) * SHM_K + kws) = pack8(S.sf0, S.sf1); *(bf16x8*)(K_lds + (bf) * SHM_K + kws + 32 * 256) = pack8(S.sf2, S.sf3); } while (0)
#define SWRITE_VF(bf) do { *(bf16x8*)(V_lds + (bf) * SHM_V + vst0) = pack8(S.sf0, S.sf1); *(bf16x8*)(V_lds + (bf) * SHM_V + vst1) = pack8(S.sf2, S.sf3); } while (0)
template <class TIn, class TOut, int QS, int KS, int OS>
__device__ __forceinline__ void causal_swa_prime(const BlockRef<TIn, TOut>& cur, int W, char* lds, Seam<TIn>& S, const int wid) {
    constexpr bool F32 = same_t<TIn, float>::v;
    const int lane = mk_lane(), tid = wid * 64 + lane, r32 = lane & 31, hi = lane >> 5;
    const int sr = tid >> 4, sc = (tid & 15) * 8, kws = KSWZ(sr, sc * 2); char* K_lds = lds + 2 * SHM_V;
    const int kb0 = swa_jlo(cur.P0, W) * KVBLK;
    for (int d0 = 0; d0 < 8; ++d0) S.qr[d0] = load8<TIn>(cur.Q + (size_t)(wid * QBLK + r32) * QS + d0 * 16 + hi * 8);
    if constexpr (F32) { SLOAD_F((const float*)cur.K, kb0); VMW(); SWRITE_KF(0); SBAR(); SLOAD_F((const float*)cur.V, kb0); }
    else { SLOAD_H(cur.K, cur.V, kb0); VMW(); SWRITE_HK(0); }
    __syncthreads();
}
template <class TIn, class TOut, int QS, int KS, int OS>
__device__ __forceinline__ void causal_swa_block(const BlockRef<TIn, TOut>& cur, const BlockRef<TIn, TOut>& nxt, int skv, int W, char* lds, Seam<TIn>& S, const int wid) {
    constexpr bool F32 = same_t<TIn, float>::v;
    const int lane = mk_lane(), tid = wid * 64 + lane, r32 = lane & 31, hi = lane >> 5;
    const int j_lo = swa_jlo(cur.P0, W);
    int j_hi = (cur.P0 + QB - 1) / KVBLK + 1; if (j_hi > skv / KVBLK) j_hi = skv / KVBLK;
    const int NT = j_hi - j_lo;
    const int kbn = swa_jlo(nxt.P0, W) * KVBLK;
    const int qlo = cur.P0 + wid * QBLK, qm = qlo + r32 - 4 * hi;
    char* V_lds = lds; char* K_lds = lds + 2 * SHM_V;
    float* ws = (float*)(lds + 2 * SHM_V + 2 * SHM_K) + wid * 64; float* li_l = ws, * al_l = ws + 32;
    float m_reg = -1e30f, l_reg = 0; f32x16 o[4] = {};
    const int sr = tid >> 4, sc = (tid & 15) * 8, vst0 = v_st(sr, sc), vst1 = v_st(32 + sr, sc), kws = KSWZ(sr, sc * 2);
    const int vb0 = (int)(uintptr_t)V_lds + v_rd_base(lane);
    const TIn* Kh = cur.K; const TIn* Vh = cur.V;
#define RESC(a) do { if (__any((a) < 1.f)) { if (hi == 0) al_l[r32] = (a); asm volatile("s_waitcnt lgkmcnt(0)" ::: "memory");              \
                     for (int d_ = 0; d_ < 4; ++d_) for (int r = 0; r < 16; ++r) o[d_][r] *= al_l[crow(r, hi)]; } } while (0)
#define KBASE(t) ((j_lo + (t)) * KVBLK)
#define ACT(t) (KBASE(t) <= qlo + QBLK - 1 && KBASE(t) + KVBLK - 1 >= qlo - W + 1)
#define MASKT(P0_, P1_, t) do { const int kb_ = KBASE(t); if ((!SK || ACT(t)) && (kb_ + KVBLK - 1 > qlo || kb_ <= qlo + QBLK - 1 - W)) mask_tile(P0_, P1_, qm - kb_, (unsigned)W); } while (0)
    constexpr int NQL = F32 ? 16 : 8;
    constexpr bool SK = WSKIP && !F32;
#define SEAM_K0() do { VMWN(NQL); if constexpr (F32) { SWRITE_KF(0); SBAR(); SLOAD_F((const float*)nxt.V, kbn); } else { SWRITE_HK(0); } SBAR(); } while (0)
    f32x16 pA0, pA1, pB0, pB1; float mnA, mnB, alA, alB; bf16x8 pa0, pa1, pa2, pa3;
    if constexpr (F32) { VMW(); SWRITE_VF(0); SBAR(); } else { SWRITE_HV(0); SBAR(); }
    if (NT > 1) { if constexpr (F32) SLOAD_F((const float*)Kh, KBASE(1)); else SLOAD_H(Kh, Vh, KBASE(1)); }
    SBAR(); qkt<0, SK>(pA0, pA1, K_lds, r32, hi, S.qr, ACT(0));
    if constexpr (F32) { if (NT > 1) { VMW(); SWRITE_KF(1); SBAR(); SLOAD_F((const float*)Vh, KBASE(1)); } }
    MASKT(pA0, pA1, 0); partialSM(pA0, pA1, m_reg, mnA, alA);
    if (NT > 1) { VMW(); if constexpr (F32) { SWRITE_VF(1); SBAR(); if (NT > 2) SLOAD_F((const float*)Kh, KBASE(2)); } else SWRITE_H(1); }
    __syncthreads();
#define HALF_STEP(PX0, PX1, mnX, alX, PY0, PY1, alY, t, KB, VB, SB) do {                                                      \
        SBAR(); qkt<KB, SK>(PX0, PX1, K_lds, r32, hi, S.qr, ACT(t));                                             \
        finishSM(PY0, PY1, alY, l_reg, pa0, pa1, pa2, pa3); SBAR();                                                           \
        if ((t) + 1 < NT) { if constexpr (F32) { VMW(); SWRITE_KF(SB); SBAR(); SLOAD_F((const float*)Vh, KBASE((t) + 1)); }  \
                            else { SLOAD_H(Kh, Vh, KBASE((t) + 1)); } SBAR(); }                                               \
        pv_tile<VB, SK>(o, vb0, pa0, pa1, pa2, pa3, ACT((t) - 1)); MASKT(PX0, PX1, (t)); partialSM(PX0, PX1, m_reg, mnX, alX);                                        \
        __syncthreads();                                                                                                      \
        if ((t) + 1 < NT) { VMW(); if constexpr (F32) { SWRITE_VF(SB); SBAR(); if ((t) + 2 < NT) SLOAD_F((const float*)Kh, KBASE((t) + 2)); } \
                            else { SWRITE_H(SB); } }                                                                          \
        RESC(alX); __syncthreads(); } while (0)
    for (int t = 1; t + 1 < NT; t += 2) {
        HALF_STEP(pB0, pB1, mnB, alB, pA0, pA1, alA, t, 1, 0, 0);
        HALF_STEP(pA0, pA1, mnA, alA, pB0, pB1, alB, t + 1, 0, 1, 1);
    }
    const bool even = (NT & 1) == 0;
    if (even) { SBAR(); qkt<1, SK>(pB0, pB1, K_lds, r32, hi, S.qr, ACT(NT - 1)); SBAR(); }
#define QROW(e) (nxt.Q + (size_t)(wid * QBLK + r32) * QS + ((e) >> 1) * 16 + hi * 8 + ((e) & 1) * 4)
    if constexpr (F32) { SLOAD_F((const float*)nxt.K, kbn); SBAR();
#pragma unroll
        for (int e = 0; e < 8; ++e) S.tq[e] = *(const f32x4*)QROW(e); }
    else { SLOAD_H(nxt.K, nxt.V, kbn); SBAR();
#pragma unroll
        for (int d0 = 0; d0 < 8; ++d0) S.qr[d0] = load8<TIn>(nxt.Q + (size_t)(wid * QBLK + r32) * QS + d0 * 16 + hi * 8); }
    SBAR();
    finishSM(pA0, pA1, alA, l_reg, pa0, pa1, pa2, pa3); SBAR();
    if constexpr (F32) {
#pragma unroll
        for (int e = 8; e < 16; ++e) S.tq[e] = *(const f32x4*)QROW(e); SBAR(); }
#undef QROW
    pv_tile<0, SK>(o, vb0, pa0, pa1, pa2, pa3, ACT(even ? NT - 2 : NT - 1));
    if (even) { MASKT(pB0, pB1, NT - 1); partialSM(pB0, pB1, m_reg, mnB, alB); __syncthreads(); RESC(alB);
        finishSM(pB0, pB1, alB, l_reg, pa0, pa1, pa2, pa3); SBAR(); pv_tile<1, SK>(o, vb0, pa0, pa1, pa2, pa3, ACT(NT - 1)); }
    SBAR(); SEAM_K0();
    if (hi == 0) li_l[r32] = l_reg; asm volatile("s_waitcnt lgkmcnt(0)" ::: "memory");
    float rli[16];
#pragma unroll
    for (int r = 0; r < 16; ++r) rli[r] = __builtin_amdgcn_rcpf(li_l[crow(r, hi)]);
    TOut* Ow = cur.O + (size_t)(wid * QBLK) * OS;
#pragma unroll
    for (int r = 0; r < 16; ++r) { const int orow = crow(r, hi);
#pragma unroll
        for (int d0 = 0; d0 < 4; ++d0) { const float v = o[d0][r] * rli[r];
            if constexpr (same_t<TOut, float>::v) { Ow[(size_t)orow * OS + d0 * 32 + r32] = v; }
            else { const float vn = __shfl_xor(v, 1);
                   if ((r32 & 1) == 0) *(unsigned*)(Ow + (size_t)orow * OS + d0 * 32 + r32) = cvtpk(v, vn); } } }
    if constexpr (F32) {
#pragma unroll
        for (int d0 = 0; d0 < 8; ++d0) S.qr[d0] = pack8(S.tq[2 * d0], S.tq[2 * d0 + 1]); }
    __syncthreads();
#undef RESC
#undef KBASE
#undef ACT
#undef MASKT
#undef SEAM_K0
#undef HALF_STEP
}
#undef ROW
#undef VMW
#undef VMWN
#undef SLOAD_H
#undef SWRITE_HK
#undef SWRITE_HV
#undef SWRITE_H
#undef SLOAD_F
#undef SWRITE_KF
#undef SWRITE_VF
}
constexpr int NWAVES = 8;
#ifndef MK_N_LAUNCHES
#define MK_N_LAUNCHES 1
#endif
constexpr int NPHASES = 18;
constexpr int N_LAUNCHES = MK_N_LAUNCHES;
static_assert(N_LAUNCHES == 1 || N_LAUNCHES == NPHASES, "MK_N_LAUNCHES: 1 or NPHASES");

constexpr int SEQ = 8192, DM = 4096, DFF = 11008, NMIX = 22528, MEM = 256;
constexpr int DAW = 2048, HGW = 2048, XAW = 512;
constexpr float LN_EPS = 1e-5f;
constexpr int DOWN_TAIL_ITEMS = 22016;
constexpr float DN_ALPHA = 1.189207115002721f;
constexpr float LAMBDA_INIT = 0.2f;
constexpr size_t MiB = 1u << 20;
constexpr size_t WS_CTL = 0, CTL_ZERO_BYTES = 1 * MiB;
constexpr size_t WS_LB = 1 * MiB;
constexpr size_t WS_LAM = WS_LB + 8192;
constexpr size_t WS_ST = WS_LB + 65536;
constexpr size_t WS_COS = 2 * MiB, WS_SIN = 4 * MiB;
constexpr size_t WS_DEC = 6 * MiB;
constexpr size_t WS_XKV = 7 * MiB;
constexpr size_t WS_MEMB = 8 * MiB;
constexpr size_t WS_XO = 18 * MiB;
constexpr size_t WS_WXQ = 26 * MiB, WS_WXKV = 30 * MiB, WS_WXO = 38 * MiB, WS_WDA = 42 * MiB, WS_WHG = 58 * MiB, WS_WMO = 74 * MiB, WS_WMI = 106 * MiB, WS_W2A = 282 * MiB, WS_W2D = 454 * MiB;
constexpr size_t WS_R1 = 540 * MiB;
constexpr size_t WS_W1A = WS_R1, WS_W1D = WS_R1 + 172 * MiB;
constexpr size_t WS_PB = WS_R1, PB_SEG = 32 * MiB;
constexpr size_t WS_HF = WS_R1 + 192 * MiB;
constexpr size_t WS_XB = 798 * MiB;
constexpr size_t WS_Y = 862 * MiB;
constexpr size_t WS_XF = 990 * MiB;
constexpr size_t WS_H = 1118 * MiB;
constexpr size_t WS_SLT = WS_H;
constexpr size_t WS_GA = 1290 * MiB, WS_GB = 1354 * MiB;
constexpr size_t WS_O1 = 1418 * MiB, WS_O2 = 1482 * MiB;
constexpr size_t WS_XQP = WS_O2;
constexpr size_t WS_OA = 1546 * MiB, WS_OB = 1578 * MiB;
constexpr size_t WS_END = 1610 * MiB;
static_assert(WS_W1D + (size_t)DM * DFF * 2 <= WS_XB && WS_HF + (size_t)SEQ * 2048 * 4 <= WS_XB && WS_H + (size_t)SEQ * DFF * 2 <= WS_GA && WS_W2D + (size_t)DM * DFF * 2 <= WS_R1 && WS_WMI + (size_t)NMIX * DM * 2 <= WS_W2A && WS_W2A + (size_t)2 * DFF * DM * 2 <= WS_W2D, "d_ws map");
constexpr int CW_TMO = 0, CW_CODE = 1;
constexpr int CW_BAR = 4096;
constexpr int RING_OFF = 0, RING_BYTES = 131072;
constexpr int LDSCTL_OFF = RING_BYTES, MISC_OFF = LDSCTL_OFF + 320;
constexpr int LDS_BYTES = 147456;
constexpr int HG_KT = 0, HG_VT = 18432, HG_QD = 36864, HG_KD = 54272, HG_ST = 71680, HG_TOT = 106496, HG_ER = 108544, HG_SS = 109056;

#define GAS __attribute__((address_space(1)))
#define LAS __attribute__((address_space(3)))
typedef unsigned short bf16;
typedef unsigned v4u __attribute__((ext_vector_type(4)));
typedef unsigned v2u __attribute__((ext_vector_type(2)));
typedef float f32x4 __attribute__((ext_vector_type(4)));
typedef float f32x2 __attribute__((ext_vector_type(2)));
typedef short bf16x8 __attribute__((ext_vector_type(8)));
typedef short s16x4 __attribute__((ext_vector_type(4)));
typedef GAS unsigned gu32;
#define RLX_AGENT __ATOMIC_RELAXED, __HIP_MEMORY_SCOPE_AGENT
#define LDS_WAIT() asm volatile("s_waitcnt lgkmcnt(0)" ::: "memory")
#define VM_WAIT() asm volatile("s_waitcnt vmcnt(0)" ::: "memory")
__device__ __forceinline__ unsigned f2bf(float f) { unsigned u = __builtin_bit_cast(unsigned, f); return (u + 0x7fffu + ((u >> 16) & 1u)) >> 16; }
__device__ __forceinline__ unsigned pk2(float lo, float hi) { return f2bf(lo) | (f2bf(hi) << 16); }
__device__ __forceinline__ float bf2f(unsigned short b) { return __uint_as_float(((unsigned)b) << 16); }

#define XB_TMO      128
#define XB_XCNT(j)  (256  + 64 * (j))
#define XB_XSUB(j)  (1280 + 64 * (j))
#define XB_XGEN(j)  (2304 + 64 * (j))
#define XB_TOP      3328
#define XB_TOPGEN   3392
#define XCD_BAR_WORDS 3456
#define XB_SPIN_CAP (1u << 18)

__device__ __forceinline__ unsigned xb_ld(unsigned* p)              { return __hip_atomic_load(p, __ATOMIC_RELAXED, __HIP_MEMORY_SCOPE_AGENT); }
__device__ __forceinline__ unsigned xb_add(unsigned* p, unsigned v) { return __hip_atomic_fetch_add(p, v, __ATOMIC_RELAXED, __HIP_MEMORY_SCOPE_AGENT); }
__device__ __forceinline__ unsigned xb_xcc_id() { return (unsigned)__builtin_amdgcn_s_getreg((3 << 11) | 20) & 0xFu; }
#define XB_SPIN(cond, bar) do { unsigned _sp = 0; while (cond) { __builtin_amdgcn_s_sleep(1); \
    if ((++_sp & 255u) == 0u) { if (xb_ld(&(bar)[XB_TMO])) break; if (_sp > XB_SPIN_CAP) { atomicAdd(&(bar)[XB_TMO], 1u); break; } } } } while (0)

struct XcdBarrier {
    unsigned* bar; unsigned x;
    volatile LAS unsigned* st;
};

__device__ __forceinline__ XcdBarrier xcd_barrier_post(unsigned* bar, volatile LAS unsigned* st, const bool t0  ) {
    XcdBarrier b; b.bar = bar; b.x = xb_xcc_id(); b.st = st;
    if (t0) (void)xb_add(&bar[XB_XCNT(b.x)], 1u);
    return b;
}
__device__ __forceinline__ void xcd_barrier_complete(unsigned* bar, unsigned x, unsigned& nloc, unsigned& nx) {
    const unsigned G = gridDim.x * gridDim.y * gridDim.z;
    unsigned sum, cnt, mine, sp = 0u;
    for (;;) {
        sum = 0u; cnt = 0u; mine = 0u;
#pragma unroll
        for (unsigned j = 0; j < 16; ++j) { const unsigned c = xb_ld(&bar[XB_XCNT(j)]); sum += c; cnt += (c > 0u) ? 1u : 0u; mine = (j == x) ? c : mine; }
        if (sum == G) break;
        __builtin_amdgcn_s_sleep(1);
        if ((++sp & 255u) == 0u) { if (xb_ld(&bar[XB_TMO])) break; if (sp > XB_SPIN_CAP) { atomicAdd(&bar[XB_TMO], 1u); break; } }
    }
    nloc = mine > 0u ? mine : 1u; nx = cnt > 0u ? cnt : 1u;
}

__device__ __forceinline__ void xcd_barrier(const XcdBarrier& b, const bool t0) {
    asm volatile("s_waitcnt vmcnt(0)" ::: "memory");
    __syncthreads();
    if (t0) {
        unsigned* bar = b.bar;
        __builtin_amdgcn_s_waitcnt(0);
        unsigned nloc = b.st[0], nx = b.st[1];
        if (nloc == 0u) { xcd_barrier_complete(bar, b.x, nloc, nx); b.st[0] = nloc; b.st[1] = nx; }
        const unsigned old = xb_add(&bar[XB_XSUB(b.x)], 1u);
        const unsigned gen = old / nloc;
        if (old + 1u == (gen + 1u) * nloc) {
            __builtin_amdgcn_fence(__ATOMIC_RELEASE, "agent");
            asm volatile("s_waitcnt vmcnt(0)" ::: "memory");
            const unsigned og = xb_add(&bar[XB_TOP], 1u);
            const unsigned tg = og / nx;
            if (og + 1u == (tg + 1u) * nx) xb_add(&bar[XB_TOPGEN], 1u);
            else XB_SPIN(xb_ld(&bar[XB_TOPGEN]) == tg, bar);
            __builtin_amdgcn_fence(__ATOMIC_ACQUIRE, "agent");
            xb_add(&bar[XB_XGEN(b.x)], 1u);
            asm volatile("s_waitcnt vmcnt(0)" ::: "memory");
        } else {
            XB_SPIN(xb_ld(&bar[XB_XGEN(b.x)]) == gen, bar);
            __builtin_amdgcn_fence(__ATOMIC_ACQUIRE, "agent");
            asm volatile("s_waitcnt vmcnt(0)" ::: "memory");
        }
    }
    __syncthreads();
}

struct Args { const float* in[31]; float* out; unsigned char* ws; int ph_lo, ph_hi; };
enum InIdx { I_X = 0, I_MEM, I_F1G, I_F1U, I_F1D, I_LN1G, I_LN1B, I_MIXIN, I_LQ1, I_LK1, I_LQ2, I_LK2, I_SUBLN, I_DAUP, I_LBLOG, I_HGNORM, I_HGUP, I_MIXOUT, I_LN2G, I_LN2B,
             I_XAQ, I_XAK, I_XAV, I_XAO, I_LN3G, I_LN3B, I_F2G, I_F2U, I_F2D, I_LN4G, I_LN4B };
typedef const char __attribute__((address_space(4))) karg_c;
__device__ __forceinline__ const float* arg_in(int i) { karg_c* kp = (karg_c*)__builtin_amdgcn_kernarg_segment_ptr(); asm volatile("" : "+s"(kp)); return *(const float* const __attribute__((address_space(4)))*)(kp + 8 * i); }
__device__ __forceinline__ float* arg_out() { karg_c* kp = (karg_c*)__builtin_amdgcn_kernarg_segment_ptr(); asm volatile("" : "+s"(kp)); return *(float* const __attribute__((address_space(4)))*)(kp + 8 * 31); }
struct Frame {
    LAS unsigned char* lds;
    volatile LAS unsigned* MISC;
    gu32* ctl;
    int wave;
    int vcu, G;
};
__device__ __forceinline__ float wave_sum(float v) {
#pragma unroll
    for (int o = 1; o < 64; o <<= 1) v += __shfl_xor(v, o);
    return v;
}

__device__ __forceinline__ void p0_transpose_item(const float* W, int K, int N, bf16* WT, int k0, int n0, int drow0, LAS float* scr, int lane) {
    { float wv[32];
      const float* wp = W + (size_t)(k0 + (lane >> 5)) * N + n0 + (lane & 31);
#pragma unroll
      for (int i = 0; i < 32; ++i) wv[i] = wp[(size_t)(2 * i) * N];
#pragma unroll
      for (int i = 0; i < 32; ++i) scr[(2 * i + (lane >> 5)) * 33 + (lane & 31)] = wv[i]; }
    LDS_WAIT(); asm volatile("" ::: "memory");
    const int c = lane & 7;
#pragma unroll
    for (int j = 0; j < 4; ++j) { const int n = (lane >> 3) + 8 * j; const LAS float* s = scr + (8 * c) * 33 + n;
        v4u o; o.x = pk2(s[0 * 33], s[1 * 33]); o.y = pk2(s[2 * 33], s[3 * 33]); o.z = pk2(s[4 * 33], s[5 * 33]); o.w = pk2(s[6 * 33], s[7 * 33]);
        *(GAS v4u*)(WT + (size_t)(drow0 + n) * K + k0 + 8 * c) = o; }
    LDS_WAIT(); asm volatile("" ::: "memory");
}
__device__ __forceinline__ int map_gu(int n0, int up) { return (n0 >> 7) * 256 + up * 128 + (n0 & 127); }
__device__ __forceinline__ int map_mix(int n0) { if (n0 >= 4096) return n0; const int cc = n0 & 255; return (n0 & ~255) + ((cc >> 6) & 1) * 128 + (cc >> 7) * 64 + (cc & 63); }
__device__ __forceinline__ void sincos_d(double ang, float& sn_o, float& cs_o) {
    const double kd = __builtin_rint(ang * 0.63661977236758134308);
    double y = __builtin_fma(-kd, 1.57079632679489655800e+00, ang); y = __builtin_fma(-kd, 6.12323399573676603587e-17, y);
    const int q = ((int)kd) & 3; const double y2 = y * y;
    const double sp = y * (1.0 + y2 * (-1.0 / 6.0 + y2 * (1.0 / 120.0 + y2 * (-1.0 / 5040.0 + y2 * (1.0 / 362880.0 + y2 * (-1.0 / 39916800.0 + y2 * (1.0 / 6227020800.0 + y2 * (-1.0 / 1307674368000.0))))))));
    const double cp = 1.0 + y2 * (-0.5 + y2 * (1.0 / 24.0 + y2 * (-1.0 / 720.0 + y2 * (1.0 / 40320.0 + y2 * (-1.0 / 3628800.0 + y2 * (1.0 / 479001600.0 + y2 * (-1.0 / 87178291200.0 + y2 * (1.0 / 20922789888000.0))))))));
    const double sn = (q == 0) ? sp : (q == 1) ? cp : (q == 2) ? -sp : -cp;
    const double cs = (q == 0) ? cp : (q == 1) ? -sp : (q == 2) ? -cp : sp;
    sn_o = (float)sn; cs_o = (float)cs;
}
__device__ __forceinline__ void p0_prologue(Frame& F, unsigned char* ws) {
    LAS float* scr = (LAS float*)(F.lds + RING_OFF + F.wave * 16384); const int lane = mk_lane();
    const int gw = F.vcu * NWAVES + F.wave, NGW = F.G * NWAVES;
    bf16* ws16 = (bf16*)ws;
    constexpr int I_FF = (DM / 64) * (DFF / 32), I_DN = (DFF / 64) * (DM / 32), I_MI = (DM / 64) * (NMIX / 32), I_UP = (2048 / 64) * (DM / 32), I_MO = (DM / 64) * (DM / 32), I_XP = (DM / 64) * (XAW / 32), I_XO = (XAW / 64) * (DM / 32);
    constexpr int I_DR = I_DN - DOWN_TAIL_ITEMS;
    constexpr int NITEMS = 4 * I_FF + 2 * I_DR + I_MI + 2 * I_UP + I_MO + 3 * I_XP + I_XO;
    for (int it = gw; it < NITEMS; it += NGW) {
        int r = it; const float* W; int K, N, kind; bf16* WT;
        int off = 0;
        if (r < I_FF) { W = arg_in(I_F1G); K = DM; N = DFF; WT = (bf16*)(ws + WS_W1A); kind = 1; }
        else if ((r -= I_FF) < I_FF) { W = arg_in(I_F1U); K = DM; N = DFF; WT = (bf16*)(ws + WS_W1A); kind = 2; }
        else if ((r -= I_FF) < I_DR) { r += DOWN_TAIL_ITEMS; W = arg_in(I_F1D); K = DFF; N = DM; WT = (bf16*)(ws + WS_W1D); kind = 0; }
        else if ((r -= I_DR) < I_MI) { W = arg_in(I_MIXIN); K = DM; N = NMIX; WT = (bf16*)(ws + WS_WMI); kind = 3; }
        else if ((r -= I_MI) < I_UP) { W = arg_in(I_DAUP); K = 2048; N = DM; WT = (bf16*)(ws + WS_WDA); kind = 0; }
        else if ((r -= I_UP) < I_UP) { W = arg_in(I_HGUP); K = 2048; N = DM; WT = (bf16*)(ws + WS_WHG); kind = 0; }
        else if ((r -= I_UP) < I_MO) { W = arg_in(I_MIXOUT); K = DM; N = DM; WT = (bf16*)(ws + WS_WMO); kind = 0; }
        else if ((r -= I_MO) < I_XP) { W = arg_in(I_XAQ); K = DM; N = XAW; WT = (bf16*)(ws + WS_WXQ); kind = 0; }
        else if ((r -= I_XP) < I_XP) { W = arg_in(I_XAK); K = DM; N = XAW; WT = (bf16*)(ws + WS_WXKV); kind = 0; }
        else if ((r -= I_XP) < I_XP) { W = arg_in(I_XAV); K = DM; N = XAW; WT = (bf16*)(ws + WS_WXKV); kind = 0; off = XAW; }
        else if ((r -= I_XP) < I_XO) { W = arg_in(I_XAO); K = XAW; N = DM; WT = (bf16*)(ws + WS_WXO); kind = 0; }
        else if ((r -= I_XO) < I_FF) { W = arg_in(I_F2G); K = DM; N = DFF; WT = (bf16*)(ws + WS_W2A); kind = 1; }
        else if ((r -= I_FF) < I_FF) { W = arg_in(I_F2U); K = DM; N = DFF; WT = (bf16*)(ws + WS_W2A); kind = 2; }
        else { r -= I_FF; r += DOWN_TAIL_ITEMS; W = arg_in(I_F2D); K = DFF; N = DM; WT = (bf16*)(ws + WS_W2D); kind = 0; }
        const int nblk = N / 32, kb = r / nblk, nb = r - kb * nblk, n0 = 32 * nb;
        const int drow0 = kind == 0 ? n0 + off : kind == 3 ? map_mix(n0) : map_gu(n0, kind - 1);
        p0_transpose_item(W, K, N, WT, 64 * kb, n0, drow0, scr, lane);
    }
    (void)ws16;
    { const size_t gt = (size_t)gw * 64 + lane, NT = (size_t)NGW * 64;
      const GAS f32x4* x4 = (const GAS f32x4*)arg_in(I_X); GAS v4u* xb = (GAS v4u*)(ws + WS_XB);
      for (size_t i = gt; i < (size_t)SEQ * DM / 8; i += NT) { const f32x4 p = x4[2 * i], q = x4[2 * i + 1]; v4u o; o.x = pk2(p.x, p.y); o.y = pk2(p.z, p.w); o.z = pk2(q.x, q.y); o.w = pk2(q.z, q.w); xb[i] = o; }
      const GAS f32x4* m4 = (const GAS f32x4*)arg_in(I_MEM); GAS v4u* mb = (GAS v4u*)(ws + WS_MEMB);
      for (size_t i = gt; i < (size_t)MEM * DM / 8; i += NT) { const f32x4 p = m4[2 * i], q = m4[2 * i + 1]; v4u o; o.x = pk2(p.x, p.y); o.y = pk2(p.z, p.w); o.z = pk2(q.x, q.y); o.w = pk2(q.z, q.w); mb[i] = o; }
      float* COS = (float*)(ws + WS_COS); float* SIN = (float*)(ws + WS_SIN);
      for (size_t i = gt; i < (size_t)SEQ * 64; i += NT) { const int pos = (int)(i >> 6), fi = (int)(i & 63);
          double inv = 1.0, base = 0.86596432336006535;
#pragma unroll
          for (int bit = 0; bit < 6; ++bit) { if ((fi >> bit) & 1) inv *= base; base *= base; }
          const float invf = (float)inv; const float angf = (float)pos * invf;
          float sn, cs; sincos_d((double)angf, sn, cs); COS[i] = cs; SIN[i] = sn; }
      const float* lbl = arg_in(I_LBLOG); float* LB = (float*)(ws + WS_LB);
      for (size_t i = gt; i < 2048; i += NT) { const float l0 = lbl[i], l1 = lbl[2048 + i]; LB[i] = 1.0f / (1.0f + expf(l1 - l0)); }
    }
    if (blockIdx.x == 0 && F.wave == 0) {
        const int l = lane; const float* q1 = arg_in(I_LQ1); const float* k1 = arg_in(I_LK1); const float* q2 = arg_in(I_LQ2); const float* k2 = arg_in(I_LK2);
        const float s1 = wave_sum(q1[l] * k1[l] + q1[l + 64] * k1[l + 64]), s2 = wave_sum(q2[l] * k2[l] + q2[l + 64] * k2[l + 64]);
        if (l == 0) *(float*)(ws + WS_LAM) = expf(s1) - expf(s2) + LAMBDA_INIT;
    }
}

__device__ __forceinline__ void p0_convert_down(Frame& F, const float* W, bf16* WT, int t0) {
    const int nb = F.G - t0, b = (int)blockIdx.x - t0; if (b < 0) return;
    LAS float* scr = (LAS float*)(F.lds + RING_OFF + F.wave * 16384); const int lane = mk_lane();
    constexpr int nblk = DM / 32;
    for (int r = b * NWAVES + F.wave; r < DOWN_TAIL_ITEMS; r += nb * NWAVES) { const int kb = r / nblk, n0 = 32 * (r - kb * nblk);
        p0_transpose_item(W, DFF, DM, WT, 64 * kb, n0, n0, scr, lane); }
}
__device__ __forceinline__ void ln_phase(Frame& F, const float* Y, const float* g, const float* b, float* Xf, bf16* Xb, float* ST = nullptr) {
    const int gw = F.vcu * NWAVES + F.wave, NGW = F.G * NWAVES, lane = mk_lane();
    for (int m = gw; m < SEQ; m += NGW) {
        const GAS f32x4* yr = (const GAS f32x4*)(Y + (size_t)m * DM) + lane;
        f32x4 v[16]; float s = 0.f;
#pragma unroll
        for (int j = 0; j < 16; ++j) { v[j] = yr[64 * j]; s += (v[j].x + v[j].y) + (v[j].z + v[j].w); }
        const float mean = wave_sum(s) * (1.f / DM); float s2 = 0.f;
#pragma unroll
        for (int j = 0; j < 16; ++j) { v[j] = v[j] - mean; s2 += (v[j].x * v[j].x + v[j].y * v[j].y) + (v[j].z * v[j].z + v[j].w * v[j].w); }
        const float rstd = 1.f / sqrtf(wave_sum(s2) * (1.f / DM) + LN_EPS);
        if (ST && lane == 0) { ST[2 * m] = mean; ST[2 * m + 1] = rstd; }
        const GAS f32x4* g4 = (const GAS f32x4*)g + lane; const GAS f32x4* b4 = (const GAS f32x4*)b + lane;
#pragma unroll
        for (int j = 0; j < 16; ++j) { const f32x4 o = v[j] * rstd * g4[64 * j] + b4[64 * j];
            if (Xf) ((GAS f32x4*)(Xf + (size_t)m * DM) + lane)[64 * j] = o;
            if (Xb) { v2u w; w.x = pk2(o.x, o.y); w.y = pk2(o.z, o.w); ((GAS v2u*)(Xb + (size_t)m * DM) + lane)[64 * j] = w; } }
    }
}
__device__ __forceinline__ void da_combine(Frame& F, unsigned char* ws) {
    const int gw = F.vcu * NWAVES + F.wave, NGW = F.G * NWAVES, lane = mk_lane();
    const float lam = *(const float*)(ws + WS_LAM);
    const f32x4 g4 = ((const GAS f32x4*)arg_in(I_SUBLN))[lane];
    const float* O1 = (const float*)(ws + WS_O1); const float* O2 = (const float*)(ws + WS_O2); bf16* OA = (bf16*)(ws + WS_OA);
    for (int r = gw; r < SEQ * 8; r += NGW) {
        const size_t off = (size_t)r * 256 + 4 * lane;
        const f32x4 o1 = *(const GAS f32x4*)(O1 + off), o2 = *(const GAS f32x4*)(O2 + off);
        const f32x4 o = o1 - o2 * lam;
        const float ss = wave_sum((o.x * o.x + o.y * o.y) + (o.z * o.z + o.w * o.w));
        const float rs = (1.0f - LAMBDA_INIT) / sqrtf(ss * (1.f / 256.f) + LN_EPS);
        const f32x4 y = o * rs * g4;
        v2u w; w.x = pk2(y.x, y.y); w.y = pk2(y.z, y.w); *(GAS v2u*)(OA + off) = w;
    }
}
#define HG_GATES(ROWBASE)                                                                                           \
    float g[16], kk[16];                                                                                            \
    _Pragma("unroll") for (int i = 0; i < 16; ++i) { const float p = HF[(ROWBASE) + (size_t)i * 2048 + n];        \
        const float sg_ = __builtin_amdgcn_rcpf(1.0f + __expf(-p)); const float f = lb + (1.0f - lb) * sg_; kk[i] = 1.0f - f; g[i] = __logf(f); } \
    _Pragma("unroll") for (int i = 1; i < 16; ++i) g[i] += g[i - 1];
__device__ __forceinline__ void hgrn_passA(Frame& F, unsigned char* ws) {
    LAS unsigned char* L = F.lds + RING_OFF;
    const int lane = mk_lane(), w = F.wave, tid = w * 64 + lane, n = tid & 127, sg = tid >> 7, fr = lane & 15, fq = lane >> 4;
    const float* HF = (const float*)(ws + WS_HF); const bf16* HI = (const bf16*)(ws + WS_PB + 4 * PB_SEG); const float* LB = (const float*)(ws + WS_LB);
    float* SLT = (float*)(ws + WS_SLT); float* DEC = (float*)(ws + WS_DEC);
    LAS float* TOT = (LAS float*)(L + HG_TOT);
    for (int item = blockIdx.x; item < 2048; item += F.G) {
        const int h = item >> 7, c = item & 127;
        const float lb = LB[h * 128 + n];
        const size_t rowbase = (size_t)(c * 64 + sg * 16) * 2048 + h * 128;
        HG_GATES(rowbase)
        TOT[sg * 128 + n] = g[15];
        { unsigned vv[8];
#pragma unroll
          for (int i = 0; i < 8; ++i) vv[i] = (unsigned)HI[rowbase + (size_t)(2 * i) * 2048 + n] | ((unsigned)HI[rowbase + (size_t)(2 * i + 1) * 2048 + n] << 16);
          *(LAS v4u*)(L + HG_VT + n * 144 + sg * 32) = (v4u){vv[0], vv[1], vv[2], vv[3]}; *(LAS v4u*)(L + HG_VT + n * 144 + sg * 32 + 16) = (v4u){vv[4], vv[5], vv[6], vv[7]}; }
        __syncthreads();
        { const float t0 = TOT[n], t1 = TOT[128 + n], t2 = TOT[256 + n], t3 = TOT[384 + n];
          const float off = (sg > 0 ? t0 : 0.f) + (sg > 1 ? t1 : 0.f) + (sg > 2 ? t2 : 0.f), bl = (t0 + t1) + (t2 + t3);
          unsigned kw[8];
#pragma unroll
          for (int i = 0; i < 8; ++i) kw[i] = pg8::cvt_pk_bf16(kk[2 * i] * __expf(bl - (off + g[2 * i])), kk[2 * i + 1] * __expf(bl - (off + g[2 * i + 1])));
          *(LAS v4u*)(L + HG_KT + n * 144 + sg * 32) = (v4u){kw[0], kw[1], kw[2], kw[3]}; *(LAS v4u*)(L + HG_KT + n * 144 + sg * 32 + 16) = (v4u){kw[4], kw[5], kw[6], kw[7]};
          if (sg == 0) DEC[(size_t)(h * 128 + c) * 128 + n] = __expf(bl); }
        __syncthreads();
        f32x4 acc[8];
#pragma unroll
        for (int et = 0; et < 8; ++et) acc[et] = (f32x4){0.f, 0.f, 0.f, 0.f};
#pragma unroll
        for (int ks = 0; ks < 2; ++ks) { const bf16x8 af = *(const LAS bf16x8*)(L + HG_KT + (16 * w + fr) * 144 + (32 * ks + 8 * fq) * 2);
#pragma unroll
            for (int et = 0; et < 8; ++et) { const bf16x8 bfr = *(const LAS bf16x8*)(L + HG_VT + (16 * et + fr) * 144 + (32 * ks + 8 * fq) * 2);
                acc[et] = __builtin_amdgcn_mfma_f32_16x16x32_bf16(af, bfr, acc[et], 0, 0, 0); } }
        float* dst = SLT + (size_t)(h * 128 + c) * 16384 + 16 * w + 4 * fq;
#pragma unroll
        for (int et = 0; et < 8; ++et) *(GAS f32x4*)(dst + (size_t)(16 * et + fr) * 128) = acc[et];
        __syncthreads();
    }
}
__device__ __forceinline__ void hgrn_passB(Frame& F, unsigned char* ws) {
    const float* SLT = (const float*)(ws + WS_SLT); float* SP = (float*)(ws + WS_XF); const float* DEC = (const float*)(ws + WS_DEC);
    for (int idx = blockIdx.x * (NWAVES * 64) + F.wave * 64 + mk_lane(); idx < 16 * 128 * 64; idx += F.G * NWAVES * 64) {
        const int h = idx >> 13, e = (idx >> 6) & 127, np = idx & 63;
        const GAS f32x2* p = (const GAS f32x2*)(SLT + (size_t)h * 128 * 16384 + (size_t)e * 128 + 2 * np);
        GAS f32x2* q = (GAS f32x2*)(SP + (size_t)h * 128 * 16384 + (size_t)e * 128 + 2 * np);
        const GAS f32x2* d = (const GAS f32x2*)(DEC + (size_t)h * 128 * 128 + 2 * np);
        f32x2 st = (f32x2){0.f, 0.f};
        for (int c0 = 0; c0 < 128; c0 += 16) {
            f32x2 lv[16], dv[16];
#pragma unroll
            for (int k = 0; k < 16; ++k) { lv[k] = p[(size_t)(c0 + k) * 8192]; dv[k] = d[(size_t)(c0 + k) * 64]; }
#pragma unroll
            for (int k = 0; k < 16; ++k) { q[(size_t)(c0 + k) * 8192] = st; st = dv[k] * st + lv[k]; }
        }
    }
}
__device__ __forceinline__ void hgrn_passC(Frame& F, unsigned char* ws) {
    LAS unsigned char* L = F.lds + RING_OFF;
    const int lane = mk_lane(), w = F.wave, tid = w * 64 + lane, n = tid & 127, sg = tid >> 7, fr = lane & 15, fq = lane >> 4;
    const float* HF = (const float*)(ws + WS_HF); const bf16* HQ = (const bf16*)(ws + WS_PB + 3 * PB_SEG); const bf16* HI = (const bf16*)(ws + WS_PB + 4 * PB_SEG); const bf16* HGt = (const bf16*)(ws + WS_PB + 5 * PB_SEG);
    const float* LB = (const float*)(ws + WS_LB); const float* SLT = (const float*)(ws + WS_XF); const float* NG = arg_in(I_HGNORM); bf16* OB = (bf16*)(ws + WS_OB);
    LAS float* TOT = (LAS float*)(L + HG_TOT); LAS float* ER = (LAS float*)(L + HG_ER); LAS float* SS = (LAS float*)(L + HG_SS);
    const int ti = w & 3, eh = w >> 2;
    float ng[4];
#pragma unroll
    for (int q4 = 0; q4 < 4; ++q4) ng[q4] = NG[16 * (4 * eh + q4) + fr];
    for (int item = blockIdx.x; item < 2048; item += F.G) {
        const int h = item >> 7, c = item & 127;
        const float lb = LB[h * 128 + n];
        const size_t rowbase = (size_t)(c * 64 + sg * 16) * 2048 + h * 128;
        f32x4 sp[8];
        { const float* src = SLT + (size_t)(h * 128 + c) * 16384; const int n4 = (tid & 31) * 4;
#pragma unroll
          for (int k = 0; k < 8; ++k) sp[k] = *(const GAS f32x4*)(src + (size_t)((tid >> 5) + 16 * k) * 128 + n4); }
        unsigned short gtv[16];
#pragma unroll
        for (int i = 0; i < 4; ++i)
#pragma unroll
            for (int q4 = 0; q4 < 4; ++q4) gtv[4 * i + q4] = HGt[(size_t)(c * 64 + 16 * ti + 4 * fq + i) * 2048 + h * 128 + 16 * (4 * eh + q4) + fr];
        HG_GATES(rowbase)
        TOT[sg * 128 + n] = g[15];
        unsigned short qv[16];
#pragma unroll
        for (int i = 0; i < 16; ++i) qv[i] = HQ[rowbase + (size_t)i * 2048 + n];
        { unsigned vv[8];
#pragma unroll
          for (int i = 0; i < 8; ++i) vv[i] = (unsigned)HI[rowbase + (size_t)(2 * i) * 2048 + n] | ((unsigned)HI[rowbase + (size_t)(2 * i + 1) * 2048 + n] << 16);
          *(LAS v4u*)(L + HG_VT + n * 144 + sg * 32) = (v4u){vv[0], vv[1], vv[2], vv[3]}; *(LAS v4u*)(L + HG_VT + n * 144 + sg * 32 + 16) = (v4u){vv[4], vv[5], vv[6], vv[7]}; }
        __syncthreads();
        { const float t0 = TOT[n], t1 = TOT[128 + n], t2 = TOT[256 + n];
          const float off = (sg > 0 ? t0 : 0.f) + (sg > 1 ? t1 : 0.f) + (sg > 2 ? t2 : 0.f), r = t0 + t1;
#pragma unroll
          for (int i = 0; i < 16; ++i) { const float b = off + g[i];
              *(LAS unsigned short*)(L + HG_QD + (16 * sg + i) * 272 + n * 2) = (unsigned short)pg8::cvt_pk_bf16(bf2f(qv[i]) * __expf(b - r), 0.f);
              *(LAS unsigned short*)(L + HG_KD + (16 * sg + i) * 272 + n * 2) = (unsigned short)pg8::cvt_pk_bf16(kk[i] * __expf(r - b), 0.f); }
          if (sg == 0) ER[n] = __expf(r); }
        __syncthreads();
        { const int n4 = (tid & 31) * 4; const f32x4 er4 = *(const LAS f32x4*)(ER + n4);
#pragma unroll
          for (int k = 0; k < 8; ++k) { const int e = (tid >> 5) + 16 * k; const f32x4 s = sp[k] * er4;
              v2u o; o.x = pg8::cvt_pk_bf16(s.x, s.y); o.y = pg8::cvt_pk_bf16(s.z, s.w); *(LAS v2u*)(L + HG_ST + e * 272 + n4 * 2) = o; } }
        __syncthreads();
        bf16x8 qf[4];
#pragma unroll
        for (int ks = 0; ks < 4; ++ks) qf[ks] = *(const LAS bf16x8*)(L + HG_QD + (16 * ti + fr) * 272 + (32 * ks + 8 * fq) * 2);
        s16x4 pa[4];
#pragma unroll
        for (int j = 0; j < 4; ++j) { pa[j] = (s16x4){0, 0, 0, 0};
            if (j <= ti) { f32x4 at = (f32x4){0.f, 0.f, 0.f, 0.f};
#pragma unroll
                for (int ks = 0; ks < 4; ++ks) { const bf16x8 kf = *(const LAS bf16x8*)(L + HG_KD + (16 * j + fr) * 272 + (32 * ks + 8 * fq) * 2);
                    at = __builtin_amdgcn_mfma_f32_16x16x32_bf16(kf, qf[ks], at, 0, 0, 0); }
                if (j == ti) {
#pragma unroll
                    for (int i = 0; i < 4; ++i) at[i] = (4 * fq + i <= fr) ? at[i] : 0.f; }
                const unsigned w0 = pg8::cvt_pk_bf16(at[0], at[1]), w1 = pg8::cvt_pk_bf16(at[2], at[3]);
                pa[j] = (s16x4){(short)(w0 & 0xffffu), (short)(w0 >> 16), (short)(w1 & 0xffffu), (short)(w1 >> 16)}; } }
        f32x4 acc[4];
#pragma unroll
        for (int q4 = 0; q4 < 4; ++q4) { const int et = 4 * eh + q4; acc[q4] = (f32x4){0.f, 0.f, 0.f, 0.f};
#pragma unroll
            for (int ks = 0; ks < 4; ++ks) { const bf16x8 sf = *(const LAS bf16x8*)(L + HG_ST + (16 * et + fr) * 272 + (32 * ks + 8 * fq) * 2);
                acc[q4] = __builtin_amdgcn_mfma_f32_16x16x32_bf16(qf[ks], sf, acc[q4], 0, 0, 0); }
#pragma unroll
            for (int jp = 0; jp < 2; ++jp) if (2 * jp <= ti) {
                const s16x4 v0 = *(const LAS s16x4*)(L + HG_VT + (16 * et + fr) * 144 + (32 * jp + 4 * fq) * 2), v1 = *(const LAS s16x4*)(L + HG_VT + (16 * et + fr) * 144 + (32 * jp + 16 + 4 * fq) * 2);
                const bf16x8 af = (bf16x8){pa[2 * jp][0], pa[2 * jp][1], pa[2 * jp][2], pa[2 * jp][3], pa[2 * jp + 1][0], pa[2 * jp + 1][1], pa[2 * jp + 1][2], pa[2 * jp + 1][3]};
                const bf16x8 bfv = (bf16x8){v0[0], v0[1], v0[2], v0[3], v1[0], v1[1], v1[2], v1[3]};
                acc[q4] = __builtin_amdgcn_mfma_f32_16x16x32_bf16(af, bfv, acc[q4], 0, 0, 0); } }
        float ssq[4];
#pragma unroll
        for (int i = 0; i < 4; ++i) { float s = (acc[0][i] * acc[0][i] + acc[1][i] * acc[1][i]) + (acc[2][i] * acc[2][i] + acc[3][i] * acc[3][i]);
            s += __shfl_xor(s, 1); s += __shfl_xor(s, 2); s += __shfl_xor(s, 4); s += __shfl_xor(s, 8); ssq[i] = s; }
        if (fr == 0) { *(LAS f32x4*)(SS + w * 16 + 4 * fq) = (f32x4){ssq[0], ssq[1], ssq[2], ssq[3]}; }
        __syncthreads();
        { const f32x4 other = *(const LAS f32x4*)(SS + (w ^ 4) * 16 + 4 * fq);
#pragma unroll
          for (int i = 0; i < 4; ++i) { const float rs = __builtin_amdgcn_rsqf((ssq[i] + other[i]) * (1.f / 128.f) + LN_EPS);
              const size_t orow = (size_t)(c * 64 + 16 * ti + 4 * fq + i) * 2048 + h * 128;
#pragma unroll
              for (int q4 = 0; q4 < 4; ++q4) { const int e = 16 * (4 * eh + q4) + fr; const float gt = bf2f(gtv[4 * i + q4]);
                  const float v = acc[q4][i] * rs * ng[q4] * (gt * __builtin_amdgcn_rcpf(1.0f + __expf(-gt))), vn = __shfl_xor(v, 1);
                  if ((fr & 1) == 0) *(GAS unsigned*)(OB + orow + e) = pg8::cvt_pk_bf16(v, vn); } } }
        __syncthreads();
    }
}
struct AItem { int vh, qb0, qb1; };
__device__ __forceinline__ AItem a_decode(int L) { const int xcd = L & 7, k = L >> 3; AItem it; it.vh = (((k >> 5) * 8 + xcd) * 2 + ((k & 31) >> 4)) & 31; const int x = k & 15; it.qb0 = x; it.qb1 = 31 - x; return it; }
__device__ __forceinline__ attn::BlockRef<bf16, float> a_ref(const AItem& it, int pass, unsigned char* ws) {
    const int qb = pass ? it.qb1 : it.qb0, kvp = it.vh >> 1, vhalf = it.vh & 1, h = kvp >> 1, map = kvp & 1;
    attn::BlockRef<bf16, float> r;
    r.Q = (const bf16*)(ws + WS_PB) + (size_t)qb * 256 * 2048 + h * 256 + map * 128;
    r.K = (const bf16*)(ws + WS_PB + PB_SEG) + h * 256 + map * 128;
    r.V = (const bf16*)(ws + WS_PB + 2 * PB_SEG) + h * 256 + vhalf * 128;
    r.O = (float*)(ws + (map ? WS_O2 : WS_O1)) + (size_t)qb * 256 * 2048 + h * 256 + vhalf * 128;
    r.P0 = qb * 256;
    return r;
}
__device__ __forceinline__ void da_attention(Frame& F, unsigned char* ws) {
    constexpr int total = 512; const int stride = F.G;
    int L = blockIdx.x; if (L >= total) return;
    char* lds = (char*)F.lds;
    AItem it = a_decode(L); int pass = 0;
    attn::BlockRef<bf16, float> cur = a_ref(it, 0, ws);
    attn::Seam<bf16> S;
    attn::causal_swa_prime<bf16, float, 2048, 2048, 2048>(cur, SEQ, lds, S, F.wave);
    for (;;) {
        const bool more_pass = pass == 0 && it.qb1 != it.qb0, more_item = L + stride < total, last = !more_pass && !more_item;
        AItem itn = it; int passn = pass + 1, Ln = L;
        if (!more_pass) { passn = 0; Ln = more_item ? L + stride : L; itn = a_decode(Ln); }
        const attn::BlockRef<bf16, float> nxt = last ? cur : a_ref(itn, passn, ws);
        attn::causal_swa_block<bf16, float, 2048, 2048, 2048>(cur, nxt, SEQ, SEQ, lds, S, F.wave);
        if (last) break;
        cur = nxt; it = itn; pass = passn; L = Ln;
    }
}
__device__ __forceinline__ void xa_attention(Frame& F, unsigned char* ws) {
    LAS unsigned char* L = F.lds + RING_OFF;
    const int lane = mk_lane(), w = F.wave, tid = w * 64 + lane, fr = lane & 15, fq = lane >> 4;
    const float* XQP = (const float*)(ws + WS_XQP); const bf16* XKV = (const bf16*)(ws + WS_XKV); bf16* XO = (bf16*)(ws + WS_XO);
    constexpr float C2 = 0.08838834764831845f * 1.4426950408889634f;
    for (int item = blockIdx.x; item < 128; item += F.G) {
        const int h = item >> 5, qb = item & 31;
#pragma unroll
        for (int i = 0; i < 8; ++i) { const int idx = tid + 512 * i, key = idx >> 4, c = idx & 15;
            const v4u kv = *(const GAS v4u*)(XKV + (size_t)key * 1024 + h * 128 + 8 * c);
            *(LAS v4u*)(L + key * 256 + ((c ^ (key & 15)) << 4)) = kv; }
#pragma unroll 4
        for (int i = 0; i < 16; ++i) { const int idx = tid + 512 * i, e = idx & 127, kq = idx >> 7;
            const bf16* vp = XKV + (size_t)(4 * kq) * 1024 + 512 + h * 128 + e;
            v2u o; o.x = (unsigned)vp[0] | ((unsigned)vp[1024] << 16); o.y = (unsigned)vp[2048] | ((unsigned)vp[3072] << 16);
            *(LAS v2u*)(L + 65536 + e * 512 + ((kq ^ ((e & 15) << 1)) << 3)) = o; }
        __syncthreads();
#pragma unroll 1
        for (int qt = 0; qt < 2; ++qt) {
            const size_t qrow = (size_t)qb * 256 + 32 * w + 16 * qt;
            bf16x8 qf[4];
#pragma unroll
            for (int ks = 0; ks < 4; ++ks) { const float* qp = XQP + (qrow + fr) * XAW + h * 128 + 32 * ks + 8 * fq;
                f32x4 a = *(const GAS f32x4*)qp, b = *(const GAS f32x4*)(qp + 4);
#pragma unroll
                for (int p = 1; p < 4; ++p) { a = a + *(const GAS f32x4*)(qp + (size_t)p * SEQ * XAW); b = b + *(const GAS f32x4*)(qp + (size_t)p * SEQ * XAW + 4); }
                const v4u w4 = (v4u){pg8::cvt_pk_bf16(a[0], a[1]), pg8::cvt_pk_bf16(a[2], a[3]), pg8::cvt_pk_bf16(b[0], b[1]), pg8::cvt_pk_bf16(b[2], b[3])};
                qf[ks] = __builtin_bit_cast(bf16x8, w4); }
            f32x4 sacc[16];
#pragma unroll
            for (int kt = 0; kt < 16; ++kt) sacc[kt] = (f32x4){0.f, 0.f, 0.f, 0.f};
#pragma unroll
            for (int ks = 0; ks < 4; ++ks)
#pragma unroll
                for (int kt = 0; kt < 16; ++kt) { const bf16x8 kf = *(const LAS bf16x8*)(L + (16 * kt + fr) * 256 + (((4 * ks + fq) ^ fr) << 4));
                    sacc[kt] = __builtin_amdgcn_mfma_f32_16x16x32_bf16(kf, qf[ks], sacc[kt], 0, 0, 0); }
            float mx = sacc[0][0];
#pragma unroll
            for (int kt = 0; kt < 16; ++kt)
#pragma unroll
                for (int r = 0; r < 4; ++r) mx = fmaxf(mx, sacc[kt][r]);
            mx = fmaxf(mx, __shfl_xor(mx, 16)); mx = fmaxf(mx, __shfl_xor(mx, 32));
            const float mc = mx * C2; float l = 0.f; s16x4 pa[16];
#pragma unroll
            for (int kt = 0; kt < 16; ++kt) { f32x4 p;
#pragma unroll
                for (int r = 0; r < 4; ++r) { p[r] = __builtin_amdgcn_exp2f(sacc[kt][r] * C2 - mc); l += p[r]; }
                const unsigned w0 = pg8::cvt_pk_bf16_pinned(p[0], p[1]), w1 = pg8::cvt_pk_bf16_pinned(p[2], p[3]);
                pa[kt] = (s16x4){(short)(w0 & 0xffffu), (short)(w0 >> 16), (short)(w1 & 0xffffu), (short)(w1 >> 16)}; }
            l += __shfl_xor(l, 16); l += __shfl_xor(l, 32);
            f32x4 oacc[8];
#pragma unroll
            for (int et = 0; et < 8; ++et) oacc[et] = (f32x4){0.f, 0.f, 0.f, 0.f};
#pragma unroll
            for (int kp = 0; kp < 8; ++kp) {
                const bf16x8 af = (bf16x8){pa[2 * kp][0], pa[2 * kp][1], pa[2 * kp][2], pa[2 * kp][3], pa[2 * kp + 1][0], pa[2 * kp + 1][1], pa[2 * kp + 1][2], pa[2 * kp + 1][3]};
#pragma unroll
                for (int et = 0; et < 8; ++et) { const s16x4 v0 = *(const LAS s16x4*)(L + 65536 + (16 * et + fr) * 512 + (((8 * kp + fq) ^ (fr << 1)) << 3)), v1 = *(const LAS s16x4*)(L + 65536 + (16 * et + fr) * 512 + (((8 * kp + 4 + fq) ^ (fr << 1)) << 3));
                    oacc[et] = __builtin_amdgcn_mfma_f32_16x16x32_bf16(af, (bf16x8){v0[0], v0[1], v0[2], v0[3], v1[0], v1[1], v1[2], v1[3]}, oacc[et], 0, 0, 0); } }
            const float rl = 1.0f / l;
#pragma unroll
            for (int r = 0; r < 4; ++r) { const float rr = __shfl(rl, 4 * fq + r);
#pragma unroll
                for (int et = 0; et < 8; ++et) { const float v = oacc[et][r] * rr, vn = __shfl_xor(v, 1);
                    if ((fr & 1) == 0) *(GAS unsigned*)(XO + (qrow + 4 * fq + r) * XAW + h * 128 + 16 * et + fr) = pk2(v, vn); } }
        }
        __syncthreads();
    }
}

__global__ void __launch_bounds__(NWAVES * 64, 2) mk_fwd(Args args) {
    extern __shared__ __attribute__((aligned(16))) unsigned char lds[];
    Frame F;
    F.lds = (LAS unsigned char*)lds;
    F.MISC = (volatile LAS unsigned*)(F.lds + MISC_OFF);
    F.wave = __builtin_amdgcn_readfirstlane((int)threadIdx.x >> 6);
    F.G = gridDim.x; { const int bx = blockIdx.x; F.vcu = (F.G % 8 == 0) ? (bx % 8) * (F.G / 8) + bx / 8 : bx; }
    unsigned char* ws = args.ws;
    F.ctl = (gu32*)(ws + WS_CTL);
    for (int u = threadIdx.x; u < (LDS_BYTES - LDSCTL_OFF) / 4; u += NWAVES * 64) ((LAS unsigned*)(F.lds + LDSCTL_OFF))[u] = 0u;
    __syncthreads();
    XcdBarrier bar; bar.bar = (unsigned*)(F.ctl + CW_BAR); bar.x = 0; bar.st = nullptr;
    if (N_LAUNCHES == 1) bar = xcd_barrier_post((unsigned*)(F.ctl + CW_BAR), F.MISC + 8, threadIdx.x == 0);
#define GRID_BAR() do { if (N_LAUNCHES == 1) xcd_barrier(bar, F.wave == 0 && mk_lane() == 0); } while (0)
    const int lo = args.ph_lo, hi = args.ph_hi;
#define IN(k) (lo <= (k) && (k) < hi)
#define SEAM(k) do { if (IN(k) && IN((k) + 1)) GRID_BAR(); } while (0)
    const int bid = (int)blockIdx.x;
#define XB ((bf16*)(ws + WS_XB))
#define Y ((float*)(ws + WS_Y))
#define XF ((float*)(ws + WS_XF))
#define HB ((bf16*)(ws + WS_H))

    if (IN(0)) { p0_prologue(F, ws); } SEAM(0);
    if (IN(1)) { pg8::Gemm g{XB, (const bf16*)(ws + WS_W1A), SEQ, 2 * DFF, DM, DM, nullptr, nullptr}; pg8::StaticOrder S; S.init(SEQ, 2 * DFF, F.G, bid);
        pg8::EpiSwiGLU E{HB, DFF}; pg8::gemm_phase<pg8::EpiSwiGLU, pg8::StaticOrder, true, true>(F.lds + RING_OFF, g, S, E, F.wave);
        { pg8::Gemm g2{(const bf16*)(ws + WS_MEMB), (const bf16*)(ws + WS_WXKV), MEM, 2 * XAW, DM, DM, nullptr, nullptr}; pg8::StaticOrder S2; S2.init(MEM, 2 * XAW, F.G, (bid + F.G - 192) % F.G);
          pg8::EpiBf16 E2{(bf16*)(ws + WS_XKV), 2 * XAW}; pg8::gemm_phase<pg8::EpiBf16, pg8::StaticOrder, true, true>(F.lds + RING_OFF, g2, S2, E2, F.wave); }
        p0_convert_down(F, arg_in(I_F1D), (bf16*)(ws + WS_W1D), F.G > 200 ? 196 : 0); } SEAM(1);
    if (IN(2)) { pg8::Gemm g{HB, (const bf16*)(ws + WS_W1D), SEQ, DM, DFF, DFF, nullptr, nullptr}; pg8::StaticOrder S; S.init(SEQ, DM, F.G, bid);
        pg8::EpiResF32 E{arg_in(I_X), Y, DM, DN_ALPHA, 0.5f}; pg8::gemm_phase<pg8::EpiResF32, pg8::StaticOrder, true, true>(F.lds + RING_OFF, g, S, E, F.wave); } SEAM(2);
    if (IN(3)) { ln_phase(F, Y, arg_in(I_LN1G), arg_in(I_LN1B), nullptr, XB, (float*)(ws + WS_ST)); } SEAM(3);
    if (IN(4)) { pg8::Gemm g{XB, (const bf16*)(ws + WS_WMI), SEQ, NMIX, DM, DM, nullptr, nullptr}; pg8::StaticOrder S; S.init(SEQ, NMIX, F.G, bid);
        pg8::EpiMixIn E{(bf16*)(ws + WS_PB), PB_SEG / 2, (float*)(ws + WS_HF), (bf16*)(ws + WS_GA), (bf16*)(ws + WS_GB), (const float*)(ws + WS_COS), (const float*)(ws + WS_SIN)};
        pg8::gemm_phase<pg8::EpiMixIn, pg8::StaticOrder, true, true>(F.lds + RING_OFF, g, S, E, F.wave); } SEAM(4);
    if (IN(5)) { da_attention(F, ws); hgrn_passA(F, ws); } SEAM(5);
    if (IN(6)) { hgrn_passB(F, ws); da_combine(F, ws); } SEAM(6);
    if (IN(7)) { hgrn_passC(F, ws); } SEAM(7);
    if (IN(8)) { pg8::Gemm g{(const bf16*)(ws + WS_OA), (const bf16*)(ws + WS_WDA), SEQ, DM, 2048, 2048, (const bf16*)(ws + WS_OB), (const bf16*)(ws + WS_WHG)};
        pg8::DualOrder S; S.init(SEQ, DM, F.G, bid); pg8::EpiMerge E{(const bf16*)(ws + WS_GA), (const bf16*)(ws + WS_GB), XB, DM};
        pg8::gemm_phase<pg8::EpiMerge, pg8::DualOrder, true, true>(F.lds + RING_OFF, g, S, E, F.wave); } SEAM(8);
    if (IN(9)) { pg8::Gemm g{XB, (const bf16*)(ws + WS_WMO), SEQ, DM, DM, DM, nullptr, nullptr}; pg8::StaticOrder S; S.init(SEQ, DM, F.G, bid);
        pg8::EpiResLN E{Y, (const float*)(ws + WS_ST), arg_in(I_LN1G), arg_in(I_LN1B), XF, DM, DN_ALPHA, 1.0f}; pg8::gemm_phase<pg8::EpiResLN, pg8::StaticOrder, true, true>(F.lds + RING_OFF, g, S, E, F.wave); } SEAM(9);
    if (IN(10)) { ln_phase(F, XF, arg_in(I_LN2G), arg_in(I_LN2B), nullptr, XB, (float*)(ws + WS_ST) + 2 * SEQ); } SEAM(10);
    if (IN(11)) { pg8::Gemm g{XB, (const bf16*)(ws + WS_WXQ), SEQ, XAW, DM / 4, DM, nullptr, nullptr}; pg8::SplitKOrder S; S.init(SEQ, XAW, DM / 4, 4, F.G, bid);
        pg8::EpiF32Part E{(float*)(ws + WS_XQP), XAW, DM / 4, (size_t)SEQ * XAW}; pg8::gemm_phase<pg8::EpiF32Part, pg8::SplitKOrder, true, true>(F.lds + RING_OFF, g, S, E, F.wave); } SEAM(11);
    if (IN(12)) { xa_attention(F, ws); } SEAM(12);
    if (IN(13)) { pg8::Gemm g{(const bf16*)(ws + WS_XO), (const bf16*)(ws + WS_WXO), SEQ, DM, XAW, XAW, nullptr, nullptr}; pg8::StaticOrder S; S.init(SEQ, DM, F.G, bid);
        pg8::EpiResLN E{XF, (const float*)(ws + WS_ST) + 2 * SEQ, arg_in(I_LN2G), arg_in(I_LN2B), Y, DM, DN_ALPHA, 1.0f}; pg8::gemm_phase<pg8::EpiResLN, pg8::StaticOrder, true, true>(F.lds + RING_OFF, g, S, E, F.wave); } SEAM(13);
    if (IN(14)) { ln_phase(F, Y, arg_in(I_LN3G), arg_in(I_LN3B), nullptr, XB, (float*)(ws + WS_ST) + 4 * SEQ); } SEAM(14);
    if (IN(15)) { pg8::Gemm g{XB, (const bf16*)(ws + WS_W2A), SEQ, 2 * DFF, DM, DM, nullptr, nullptr}; pg8::StaticOrder S; S.init(SEQ, 2 * DFF, F.G, bid);
        pg8::EpiSwiGLU E{HB, DFF}; pg8::gemm_phase<pg8::EpiSwiGLU, pg8::StaticOrder, true, true>(F.lds + RING_OFF, g, S, E, F.wave);
        p0_convert_down(F, arg_in(I_F2D), (bf16*)(ws + WS_W2D), F.G > 200 ? 192 : 0); } SEAM(15);
    if (IN(16)) { pg8::Gemm g{HB, (const bf16*)(ws + WS_W2D), SEQ, DM, DFF, DFF, nullptr, nullptr}; pg8::StaticOrder S; S.init(SEQ, DM, F.G, bid);
        pg8::EpiResLN E{Y, (const float*)(ws + WS_ST) + 4 * SEQ, arg_in(I_LN3G), arg_in(I_LN3B), XF, DM, DN_ALPHA, 0.5f}; pg8::gemm_phase<pg8::EpiResLN, pg8::StaticOrder, true, true>(F.lds + RING_OFF, g, S, E, F.wave); } SEAM(16);
    if (IN(17)) { ln_phase(F, XF, arg_in(I_LN4G), arg_in(I_LN4B), arg_out(), nullptr); }
#undef XB
#undef Y
#undef XF
#undef HB
#undef IN
#undef SEAM
#undef GRID_BAR
}

extern "C" void kernel_launch(void* const* d_in, const int* in_sizes, int n_in, void* d_out, int out_size, void* d_ws, size_t ws_size, hipStream_t stream) {
    static int grid = 0;
    if (grid == 0) {
        if (n_in != 31 || in_sizes[0] != SEQ * DM || out_size != SEQ * DM || ws_size < WS_END) { fprintf(stderr, "kernel_launch: built for 31 inputs, x/out of %d floats, >= %zu bytes of workspace; got n_in %d, in0 %d, out %d, ws %zu; nothing launched\n", SEQ * DM, (size_t)WS_END, n_in, n_in > 0 ? in_sizes[0] : -1, out_size, ws_size); grid = -1; return; }
        int dev = 0, cus = 0, per_cu = 0;
        if (hipGetDevice(&dev) != hipSuccess || hipDeviceGetAttribute(&cus, hipDeviceAttributeMultiprocessorCount, dev) != hipSuccess) { fprintf(stderr, "kernel_launch: device query failed\n"); grid = -1; return; }
        if (hipFuncSetAttribute((const void*)mk_fwd, hipFuncAttributeMaxDynamicSharedMemorySize, LDS_BYTES) != hipSuccess) { fprintf(stderr, "kernel_launch: hipFuncSetAttribute failed\n"); grid = -1; return; }
        if (hipOccupancyMaxActiveBlocksPerMultiprocessor(&per_cu, (const void*)mk_fwd, NWAVES * 64, LDS_BYTES) != hipSuccess || per_cu < 1)
            fprintf(stderr, "kernel_launch: note: occupancy query reports %d workgroups per CU\n", per_cu);
        (void)hipGetLastError();
        grid = cus;
    }
    if (grid < 0) return;
    if (hipMemsetAsync((char*)d_ws + WS_CTL, 0, CTL_ZERO_BYTES, stream) != hipSuccess) { fprintf(stderr, "kernel_launch: hipMemsetAsync failed\n"); return; }
    Args a{};
    for (int i = 0; i < 31; ++i) a.in[i] = (const float*)d_in[i];
    a.out = (float*)d_out; a.ws = (unsigned char*)d_ws;
    const int n_l = N_LAUNCHES;
    for (int li = 0; li < n_l; ++li) {
        a.ph_lo = (N_LAUNCHES == 1) ? 0 : li; a.ph_hi = (N_LAUNCHES == 1) ? NPHASES : li + 1;
        hipLaunchKernelGGL(mk_fwd, dim3(grid), dim3(NWAVES * 64), LDS_BYTES, stream, a);
        const hipError_t le = hipPeekAtLastError();
        if (le != hipSuccess) { fprintf(stderr, "kernel_launch: launch %d failed: %s\n", li, hipGetErrorName(le)); break; }
    }
}
```

```cpp
#include <hip/hip_runtime.h>
#include <cstdio>
#include <cstdint>
__device__ __forceinline__ int mk_lane() { int l; asm volatile("v_mbcnt_lo_u32_b32 %0, -1, 0\n\tv_mbcnt_hi_u32_b32 %0, -1, %0" : "=v"(l)); return l; }
namespace pg8 {
#define PG8_LAS __attribute__((address_space(3)))
typedef unsigned short bf16_t;
typedef short bf16x8 __attribute__((ext_vector_type(8)));
typedef float f32x4 __attribute__((ext_vector_type(4)));
typedef unsigned u32x4 __attribute__((ext_vector_type(4)));
constexpr int BM = 256, BK = 64, HALF = 128, HTB = HALF * BK * 2  , STAGE_BYTES = 8 * HTB, NXCD = 8, WGM = 8;

__host__ __device__ __forceinline__ int lds_byte(int r, int c) { const int st = (r >> 4) * 2 + (c >> 5), rr = r & 15, cc = c & 31, ob = rr * 64 + cc * 2; return st * 1024 + (ob ^ (((ob >> 9) & 1) << 5)); }
__host__ __device__ __forceinline__ void stage_rc(int b, int& R, int& C) { const int st = b / 1024, sb = b % 1024, swz = sb ^ (((sb >> 9) & 1) << 5); R = (st >> 1) * 16 + swz / 64; C = (st & 1) * 32 + (swz % 64) / 2; }
__host__ __device__ __forceinline__ int perm32(int rho) { const int n = rho >> 4, i = rho & 15; return 8 * (i >> 2) + 4 * n + (i & 3); }

struct Unit { int pm, pn, seg, ko; };
struct Gemm { const bf16_t* A; const bf16_t* Bt; int M, N, K, ld; const bf16_t* A2; const bf16_t* Bt2; };

struct StaticOrder {
    int nM, nN, nwg, G, c;
    __host__ __device__ void init(int M, int N, int G_, int c_) { nM = M / BM; nN = N / BM; nwg = nM * nN; G = G_; c = c_; }
    __host__ __device__ bool next(int i, Unit& u) const {
        const long L = (long)i * G + c; if (L >= nwg) return false;
        int wgid = (int)L; { const int q = nwg / NXCD, r = nwg % NXCD, xcd = wgid % NXCD, off = wgid / NXCD; wgid = (xcd < r ? xcd * (q + 1) : r * (q + 1) + (xcd - r) * q) + off; }
        const int nig = WGM * nN, gid = wgid / nig, fm = gid * WGM, gsz = (nM - fm) < WGM ? (nM - fm) : WGM;
        u.pm = fm + ((wgid % nig) % gsz); u.pn = (wgid % nig) / gsz; u.seg = 0; u.ko = 0; return true;
    }
    __device__ __forceinline__ void a_ready(const Unit&) const {}
    __device__ __forceinline__ void done(const Unit&) const {}
};
struct DualOrder : StaticOrder { __device__ __forceinline__ bool next(int i, Unit& u) const { if (!StaticOrder::next(i >> 1, u)) return false; u.seg = i & 1; return true; } };
struct SplitKOrder { int M, N, ntiles, nks, K, G, c;
    __device__ __forceinline__ void init(int M_, int N_, int K_, int nks_, int G_, int c_) { M = M_; N = N_; ntiles = (M_ / BM) * (N_ / BM); nks = nks_; K = K_; G = G_; c = c_; }
    __device__ __forceinline__ bool next(int i, Unit& u) const { const long L = (long)i * G + c; if (L >= (long)ntiles * nks) return false;
        StaticOrder b; b.init(M, N, ntiles, (int)(L % ntiles)); b.next(0, u); u.seg = 0; u.ko = (int)(L / ntiles) * K; return true; }
    __device__ __forceinline__ void a_ready(const Unit&) const {}
    __device__ __forceinline__ void done(const Unit&) const {}
};

typedef __bf16 bf16x2_cv __attribute__((ext_vector_type(2)));
typedef float f32x2_cv __attribute__((ext_vector_type(2)));
__device__ __forceinline__ unsigned cvt_pk_bf16_pinned(float lo, float hi) { unsigned r; asm volatile("s_nop 1\n\tv_cvt_pk_bf16_f32 %0, %1, %2" : "=v"(r) : "v"(lo), "v"(hi)); return r; }
__device__ __forceinline__ unsigned cvt_pk_bf16(float lo, float hi) { const bf16x2_cv v = __builtin_convertvector((f32x2_cv){lo, hi}, bf16x2_cv); return __builtin_bit_cast(unsigned, v); }
__device__ __forceinline__ u32x4 pack8(const f32x4 a, const f32x4 b) { u32x4 w; w.x = cvt_pk_bf16(a[0], a[1]); w.y = cvt_pk_bf16(a[2], a[3]); w.z = cvt_pk_bf16(b[0], b[1]); w.w = cvt_pk_bf16(b[2], b[3]); return w; }
__device__ __forceinline__ float sigm(float x) { return __builtin_amdgcn_rcpf(1.0f + __builtin_amdgcn_exp2f(-1.4426950408889634f * x)); }
__device__ __forceinline__ f32x4 sigm4(const f32x4 x) { return (f32x4){sigm(x[0]), sigm(x[1]), sigm(x[2]), sigm(x[3])}; }
__device__ __forceinline__ f32x4 bf_lo4(const u32x4 w) { return (f32x4){__uint_as_float(w.x << 16), __uint_as_float(w.x & 0xffff0000u), __uint_as_float(w.y << 16), __uint_as_float(w.y & 0xffff0000u)}; }
__device__ __forceinline__ f32x4 bf_hi4(const u32x4 w) { return (f32x4){__uint_as_float(w.z << 16), __uint_as_float(w.z & 0xffff0000u), __uint_as_float(w.w << 16), __uint_as_float(w.w & 0xffff0000u)}; }

struct EpiBf16 {
    static constexpr bool PERM = true, AFTER_DRAIN = false, CHAIN = false;
    bf16_t* O; int ldc;
    __device__ __forceinline__ void operator()(const f32x4 (&acc)[2][2][4][2], const Unit& u, int wr, int wc, int fr, int fq) const {
        const int row0 = u.pm * BM + wr * 64 + fr, col0 = u.pn * BM + wc * 32 + 8 * fq;
#pragma unroll
        for (int ai = 0; ai < 2; ++ai)
#pragma unroll
            for (int m = 0; m < 4; ++m) { bf16_t* rowp = O + (size_t)(row0 + ai * HALF + m * 16) * ldc + col0;
#pragma unroll
                for (int bj = 0; bj < 2; ++bj) *(u32x4*)(rowp + bj * HALF) = pack8(acc[ai][bj][m][0], acc[ai][bj][m][1]); }
    }
};
struct EpiSwiGLU {
    static constexpr bool PERM = true, AFTER_DRAIN = false, CHAIN = false;
    bf16_t* H; int ldh;
    __device__ __forceinline__ void operator()(const f32x4 (&acc)[2][2][4][2], const Unit& u, int wr, int wc, int fr, int fq) const {
        const int row0 = u.pm * BM + wr * 64 + fr, col0 = u.pn * HALF + wc * 32 + 8 * fq;
#pragma unroll
        for (int ai = 0; ai < 2; ++ai)
#pragma unroll
            for (int m = 0; m < 4; ++m) { bf16_t* rowp = H + (size_t)(row0 + ai * HALF + m * 16) * ldh + col0;
                const f32x4 g0 = acc[ai][0][m][0], g1 = acc[ai][0][m][1];
                const f32x4 v0 = g0 * sigm4(g0) * acc[ai][1][m][0], v1 = g1 * sigm4(g1) * acc[ai][1][m][1];
                *(u32x4*)rowp = pack8(v0, v1); }
    }
};
struct EpiResF32 {
    static constexpr bool PERM = false, AFTER_DRAIN = false, CHAIN = false;
    const float* R; float* Y; int ldc; float alpha, beta;
    __device__ __forceinline__ void operator()(const f32x4 (&acc)[2][2][4][2], const Unit& u, int wr, int wc, int fr, int fq) const {
        const int row0 = u.pm * BM + wr * 64 + fr, col0 = u.pn * BM + wc * 32 + 4 * fq;
#pragma unroll
        for (int ai = 0; ai < 2; ++ai)
#pragma unroll
            for (int m = 0; m < 4; ++m) { const size_t off = (size_t)(row0 + ai * HALF + m * 16) * ldc + col0;
#pragma unroll
                for (int bj = 0; bj < 2; ++bj)
#pragma unroll
                    for (int n = 0; n < 2; ++n) { const f32x4 r = *(const f32x4*)(R + off + bj * HALF + n * 16); *(f32x4*)(Y + off + bj * HALF + n * 16) = r * alpha + acc[ai][bj][m][n] * beta; }
                asm volatile("" ::: "memory"); }
    }
};
struct EpiMixIn {
    static constexpr bool PERM = true, AFTER_DRAIN = false, CHAIN = false;
    bf16_t* PB; size_t segstride;
    float* HF;
    bf16_t* GA; bf16_t* GB;
    const float* COS; const float* SIN;
    __device__ __forceinline__ void operator()(const f32x4 (&acc)[2][2][4][2], const Unit& u, int wr, int wc, int fr, int fq) const {
        const int seg = u.pn >> 3, row0 = u.pm * BM + wr * 64 + fr;
        if (seg < 2) {
            bf16_t* base = PB + (size_t)seg * segstride + (u.pn & 7) * 256 + (wc >> 1) * 128 + 32 * (wc & 1) + 8 * fq;
            const int d0 = 32 * (wc & 1) + 8 * fq;
#pragma unroll
            for (int ai = 0; ai < 2; ++ai) { f32x4 cs[4][4];
#pragma unroll
                for (int m = 0; m < 4; ++m) { const size_t ro = (size_t)(row0 + ai * HALF + m * 16) * 64 + d0;
                    cs[m][0] = *(const f32x4*)(COS + ro); cs[m][1] = *(const f32x4*)(COS + ro + 4); cs[m][2] = *(const f32x4*)(SIN + ro); cs[m][3] = *(const f32x4*)(SIN + ro + 4); }
#pragma unroll
                for (int m = 0; m < 4; ++m) { const int row = row0 + ai * HALF + m * 16;
                    const f32x4 c0 = cs[m][0], c1 = cs[m][1], s0 = cs[m][2], s1 = cs[m][3];
                    const f32x4 x1a = acc[ai][0][m][0], x1b = acc[ai][0][m][1], x2a = acc[ai][1][m][0], x2b = acc[ai][1][m][1];
                    bf16_t* dst = base + (size_t)row * 2048;
                    *(u32x4*)dst = pack8(x1a * c0 - x2a * s0, x1b * c1 - x2b * s1);
                    *(u32x4*)(dst + 64) = pack8(x2a * c0 + x1a * s0, x2b * c1 + x1b * s1); }
                asm volatile("" ::: "memory"); }
        } else if (seg == 4) {
            float* base = HF + (u.pn & 7) * 256 + wc * 32 + 8 * fq;
#pragma unroll
            for (int ai = 0; ai < 2; ++ai)
#pragma unroll
                for (int m = 0; m < 4; ++m) { float* dst = base + (size_t)(row0 + ai * HALF + m * 16) * 2048;
#pragma unroll
                    for (int bj = 0; bj < 2; ++bj) { *(f32x4*)(dst + bj * HALF) = acc[ai][bj][m][0]; *(f32x4*)(dst + bj * HALF + 4) = acc[ai][bj][m][1]; } }
        } else if (seg >= 7) {
            bf16_t* base = (seg >= 9 ? GB + (u.pn - 72) * 256 : GA + (u.pn - 56) * 256) + wc * 32 + 8 * fq;
#pragma unroll
            for (int ai = 0; ai < 2; ++ai)
#pragma unroll
                for (int m = 0; m < 4; ++m) { bf16_t* dst = base + (size_t)(row0 + ai * HALF + m * 16) * 4096;
#pragma unroll
                    for (int bj = 0; bj < 2; ++bj) *(u32x4*)(dst + bj * HALF) = pack8(sigm4(acc[ai][bj][m][0]), sigm4(acc[ai][bj][m][1])); }
        } else {
            const int slot = seg <= 3 ? seg : seg - 1;
            bf16_t* base = PB + (size_t)slot * segstride + (u.pn & 7) * 256 + wc * 32 + 8 * fq;
#pragma unroll
            for (int ai = 0; ai < 2; ++ai)
#pragma unroll
                for (int m = 0; m < 4; ++m) { bf16_t* dst = base + (size_t)(row0 + ai * HALF + m * 16) * 2048;
#pragma unroll
                    for (int bj = 0; bj < 2; ++bj) *(u32x4*)(dst + bj * HALF) = pack8(acc[ai][bj][m][0], acc[ai][bj][m][1]); }
        }
    }
};

struct EpiMerge {
    static constexpr bool PERM = true, AFTER_DRAIN = false, CHAIN = true;
    const bf16_t* GA; const bf16_t* GB; bf16_t* O; int ldc;
    __device__ __forceinline__ void mid(f32x4 (&acc)[2][2][4][2], const Unit& u, int wr, int wc, int fr, int fq) const {
        const int row0 = u.pm * BM + wr * 64 + fr, col0 = u.pn * BM + wc * 32 + 8 * fq;
#pragma unroll
        for (int ai = 0; ai < 2; ++ai)
#pragma unroll
            for (int m = 0; m < 4; ++m) { const size_t off = (size_t)(row0 + ai * HALF + m * 16) * ldc + col0;
#pragma unroll
                for (int bj = 0; bj < 2; ++bj) { const u32x4 ga = *(const u32x4*)(GA + off + bj * HALF), gb = *(const u32x4*)(GB + off + bj * HALF);
                    const f32x4 b0 = bf_lo4(gb), b1 = bf_hi4(gb);
                    const f32x4 r0 = bf_lo4(ga) * (f32x4){__builtin_amdgcn_rcpf(fmaxf(b0[0], 1e-30f)), __builtin_amdgcn_rcpf(fmaxf(b0[1], 1e-30f)), __builtin_amdgcn_rcpf(fmaxf(b0[2], 1e-30f)), __builtin_amdgcn_rcpf(fmaxf(b0[3], 1e-30f))};
                    const f32x4 r1 = bf_hi4(ga) * (f32x4){__builtin_amdgcn_rcpf(fmaxf(b1[0], 1e-30f)), __builtin_amdgcn_rcpf(fmaxf(b1[1], 1e-30f)), __builtin_amdgcn_rcpf(fmaxf(b1[2], 1e-30f)), __builtin_amdgcn_rcpf(fmaxf(b1[3], 1e-30f))};
                    acc[ai][bj][m][0] = acc[ai][bj][m][0] * r0; acc[ai][bj][m][1] = acc[ai][bj][m][1] * r1; } }
    }
    __device__ __forceinline__ void operator()(const f32x4 (&acc)[2][2][4][2], const Unit& u, int wr, int wc, int fr, int fq) const {
        const int row0 = u.pm * BM + wr * 64 + fr, col0 = u.pn * BM + wc * 32 + 8 * fq;
#pragma unroll
        for (int ai = 0; ai < 2; ++ai)
#pragma unroll
            for (int m = 0; m < 4; ++m) { const size_t off = (size_t)(row0 + ai * HALF + m * 16) * ldc + col0;
#pragma unroll
                for (int bj = 0; bj < 2; ++bj) { const u32x4 gb = *(const u32x4*)(GB + off + bj * HALF);
                    *(u32x4*)(O + off + bj * HALF) = pack8(bf_lo4(gb) * acc[ai][bj][m][0], bf_hi4(gb) * acc[ai][bj][m][1]); } }
    }
};
struct EpiF32Part {
    static constexpr bool PERM = false, AFTER_DRAIN = false, CHAIN = false;
    float* P; int ldc; int kslice; size_t slice_stride;
    __device__ __forceinline__ void operator()(const f32x4 (&acc)[2][2][4][2], const Unit& u, int wr, int wc, int fr, int fq) const {
        const int row0 = u.pm * BM + wr * 64 + fr, col0 = u.pn * BM + wc * 32 + 4 * fq; float* base = P + (size_t)(u.ko / kslice) * slice_stride;
#pragma unroll
        for (int ai = 0; ai < 2; ++ai)
#pragma unroll
            for (int m = 0; m < 4; ++m) { float* rowp = base + (size_t)(row0 + ai * HALF + m * 16) * ldc + col0;
#pragma unroll
                for (int bj = 0; bj < 2; ++bj)
#pragma unroll
                    for (int n = 0; n < 2; ++n) *(f32x4*)(rowp + bj * HALF + n * 16) = acc[ai][bj][m][n]; }
    }
};
struct EpiResLN {
    static constexpr bool PERM = false, AFTER_DRAIN = false, CHAIN = false;
    const float* Yp; const float* ST; const float* G; const float* B; float* Y; int ldc; float alpha, beta;
    __device__ __forceinline__ void operator()(const f32x4 (&acc)[2][2][4][2], const Unit& u, int wr, int wc, int fr, int fq) const {
        const int row0 = u.pm * BM + wr * 64 + fr, col0 = u.pn * BM + wc * 32 + 4 * fq;
        f32x4 g4[2][2], b4[2][2];
#pragma unroll
        for (int bj = 0; bj < 2; ++bj)
#pragma unroll
            for (int n = 0; n < 2; ++n) { g4[bj][n] = *(const f32x4*)(G + col0 + bj * HALF + n * 16); b4[bj][n] = *(const f32x4*)(B + col0 + bj * HALF + n * 16); }
#pragma unroll
        for (int ai = 0; ai < 2; ++ai)
#pragma unroll
            for (int m = 0; m < 4; ++m) { const int row = row0 + ai * HALF + m * 16; const size_t off = (size_t)row * ldc + col0;
                const float mean = ST[2 * row], rstd = ST[2 * row + 1];
#pragma unroll
                for (int bj = 0; bj < 2; ++bj)
#pragma unroll
                    for (int n = 0; n < 2; ++n) { const f32x4 yp = *(const f32x4*)(Yp + off + bj * HALF + n * 16);
                        const f32x4 x = (yp - mean) * rstd * g4[bj][n] + b4[bj][n];
                        *(f32x4*)(Y + off + bj * HALF + n * 16) = x * alpha + acc[ai][bj][m][n] * beta; }
                asm volatile("" ::: "memory"); }
    }
};
template <class Epi, class Sched, bool ALIGN_EPI = false, bool SP2 = false>
__device__ __forceinline__ void gemm_phase(PG8_LAS unsigned char* lds, const Gemm g, const Sched& S, const Epi& E, const int wid) {
    const int lane = mk_lane(), tid = wid * 64 + lane, wr = wid >> 2, wc = wid & 3, fr = lane & 15, fq = lane >> 4;
    const int K = g.K, LD = g.ld, nt = K / BK;
    unsigned voffA[2], voffB[2];
#pragma unroll
    for (int i = 0; i < 2; ++i) { int R, C; stage_rc(tid * 16 + i * 8192, R, C); const int Rb = Epi::PERM ? ((R & ~31) + perm32(R & 31)) : R;
        voffA[i] = (unsigned)(R * LD + C) * 2u; voffB[i] = (unsigned)(Rb * LD + C) * 2u; }
    const size_t kstep = (size_t)(BK * 2);
    const size_t hstep = (size_t)HALF * LD * 2;
    const size_t tstep = 2 * hstep;
    const unsigned ldsw = (unsigned)wid * 1024u;
    const int aoff = lds_byte(wr * 64 + fr, fq * 8), boff = lds_byte(wc * 32 + fr, fq * 8);
#define PG8_SA(b, h) (((b) * 2 + (h)) * HTB)
#define PG8_SB(b, h) ((4 + (b) * 2 + (h)) * HTB)
#define PG8_STAGE(bufoff, gbase, voff) do { _Pragma("unroll") for (int _i = 0; _i < 2; ++_i) \
        __builtin_amdgcn_global_load_lds((const unsigned*)((const char*)(gbase) + (voff)[_i]), (PG8_LAS unsigned*)(lds + (bufoff) + ldsw + _i * 8192), 16, 0, 0); } while (0)
#define PG8_LDA(dst, b, h) do { _Pragma("unroll") for (int m = 0; m < 4; ++m) _Pragma("unroll") for (int k = 0; k < 2; ++k) dst[m][k] = *(const PG8_LAS bf16x8*)(lds + PG8_SA(b, h) + aoff + m * 2048 + k * 1024); } while (0)
#define PG8_LDB(dst, b, h) do { _Pragma("unroll") for (int n = 0; n < 2; ++n) _Pragma("unroll") for (int k = 0; k < 2; ++k) dst[n][k] = *(const PG8_LAS bf16x8*)(lds + PG8_SB(b, h) + boff + n * 2048 + k * 1024); } while (0)
#define PG8_MMA(ai, bj, At, Bt) do { __builtin_amdgcn_s_setprio(1); _Pragma("unroll") for (int m = 0; m < 4; ++m) _Pragma("unroll") for (int n = 0; n < 2; ++n) _Pragma("unroll") for (int k = 0; k < 2; ++k) \
        acc[ai][bj][m][n] = __builtin_amdgcn_mfma_f32_16x16x32_bf16(Bt[n][k], At[m][k], acc[ai][bj][m][n], 0, 0, 0); __builtin_amdgcn_s_setprio(0); } while (0)
#define PG8_WAIT_V(n) asm volatile("s_waitcnt vmcnt(" #n ")" ::: "memory")
#define PG8_WAIT_L(n) asm volatile("s_waitcnt lgkmcnt(" #n ")" ::: "memory")
#define PG8_BAR __builtin_amdgcn_s_barrier()
#define PG8_SCHED __builtin_amdgcn_sched_barrier(0)
    Unit cur, nxt; int ui = 0;
    if (!S.next(0, cur)) return;
    f32x4 acc[2][2][4][2];
#pragma unroll
    for (int a = 0; a < 2; ++a)
#pragma unroll
        for (int b = 0; b < 2; ++b)
#pragma unroll
            for (int m = 0; m < 4; ++m)
#pragma unroll
                for (int n = 0; n < 2; ++n) acc[a][b][m][n] = (f32x4){0.f, 0.f, 0.f, 0.f};
    bf16x8 At[4][2], B0[2][2], B1[2][2];
#define PG8_UA(u) ((const char*)((u).seg ? g.A2 : g.A) + (size_t)(u).pm * tstep + (size_t)(u).ko * 2)
#define PG8_UB(u) ((const char*)((u).seg ? g.Bt2 : g.Bt) + (size_t)(u).pn * tstep + (size_t)(u).ko * 2)
    const char* cA = PG8_UA(cur); const char* cB = PG8_UB(cur);
    S.a_ready(cur);
    if constexpr (SP2) {
        PG8_STAGE(PG8_SB(0, 0), cB, voffB); PG8_STAGE(PG8_SB(0, 1), cB + hstep, voffB); PG8_STAGE(PG8_SA(0, 0), cA, voffA); PG8_STAGE(PG8_SA(0, 1), cA + hstep, voffA);
        if (wr == 1) PG8_BAR;
        PG8_WAIT_V(2); PG8_BAR;
        PG8_STAGE(PG8_SB(1, 0), cB + kstep, voffB); PG8_STAGE(PG8_SA(1, 0), cA + kstep, voffA); PG8_STAGE(PG8_SB(1, 1), cB + hstep + kstep, voffB);
        PG8_WAIT_V(6); PG8_BAR;
    } else {
        PG8_STAGE(PG8_SB(0, 0), cB, voffB); PG8_STAGE(PG8_SA(0, 0), cA, voffA); PG8_STAGE(PG8_SB(0, 1), cB + hstep, voffB); PG8_STAGE(PG8_SA(0, 1), cA + hstep, voffA);
        if (wr == 1) PG8_BAR;
        PG8_WAIT_V(4); PG8_BAR;
        PG8_STAGE(PG8_SB(1, 0), cB + kstep, voffB); PG8_STAGE(PG8_SA(1, 0), cA + kstep, voffA); PG8_STAGE(PG8_SB(1, 1), cB + hstep + kstep, voffB);
        PG8_WAIT_V(6); PG8_BAR;
    }
    for (;;) {
        const bool has_next = S.next(ui + 1, nxt);
        const char* nA = has_next ? PG8_UA(nxt) : cA; const char* nB = has_next ? PG8_UB(nxt) : cB;
        for (int t = 0; t < nt; t += 2) {
            const bool last = (t == nt - 2);
            const char* a1 = cA + (size_t)(t + 1) * kstep;
            const char* a2 = last ? nA : cA + (size_t)(t + 2) * kstep; const char* b2 = last ? nB : cB + (size_t)(t + 2) * kstep;
            const char* a3 = a2 + kstep; const char* b3 = b2 + kstep;
            if (last && has_next) S.a_ready(nxt);
            if constexpr (SP2) {
            PG8_LDB(B0, 0, 0); PG8_LDB(B1, 0, 1); PG8_SCHED; PG8_LDA(At, 0, 0); PG8_STAGE(PG8_SA(1, 1), a1 + hstep, voffA);
            PG8_WAIT_V(8); PG8_WAIT_L(0); PG8_BAR; PG8_MMA(0, 0, At, B0); PG8_MMA(0, 1, At, B1); PG8_BAR; PG8_SCHED;
            PG8_LDA(At, 0, 1); PG8_STAGE(PG8_SB(0, 0), b2, voffB); PG8_STAGE(PG8_SB(0, 1), b2 + hstep, voffB); PG8_STAGE(PG8_SA(0, 0), a2, voffA);
            PG8_WAIT_V(8); PG8_WAIT_L(0); PG8_BAR; PG8_MMA(1, 0, At, B0); PG8_MMA(1, 1, At, B1); PG8_BAR; PG8_SCHED;
            PG8_LDB(B0, 1, 0); PG8_LDB(B1, 1, 1); PG8_SCHED; PG8_LDA(At, 1, 0); PG8_STAGE(PG8_SA(0, 1), a2 + hstep, voffA);
            PG8_WAIT_V(8); PG8_WAIT_L(0); PG8_BAR; PG8_MMA(0, 0, At, B0); PG8_MMA(0, 1, At, B1); PG8_BAR; PG8_SCHED;
            PG8_LDA(At, 1, 1); PG8_STAGE(PG8_SB(1, 0), b3, voffB); PG8_STAGE(PG8_SB(1, 1), b3 + hstep, voffB); PG8_STAGE(PG8_SA(1, 0), a3, voffA);
            PG8_WAIT_V(8); PG8_WAIT_L(0); PG8_BAR; PG8_MMA(1, 0, At, B0); PG8_MMA(1, 1, At, B1); PG8_BAR; PG8_SCHED;
            } else {
            PG8_LDB(B0, 0, 0); PG8_SCHED; PG8_LDA(At, 0, 0); PG8_STAGE(PG8_SA(1, 1), a1 + hstep, voffA);
            PG8_WAIT_L(8); PG8_BAR; PG8_WAIT_L(0); PG8_MMA(0, 0, At, B0); PG8_BAR; PG8_SCHED;
            PG8_LDB(B1, 0, 1); PG8_STAGE(PG8_SB(0, 0), b2, voffB);
            PG8_BAR; PG8_WAIT_L(0); PG8_MMA(0, 1, At, B1); PG8_BAR;
            PG8_LDA(At, 0, 1); PG8_STAGE(PG8_SA(0, 0), a2, voffA);
            PG8_BAR; PG8_WAIT_L(0); PG8_MMA(1, 0, At, B0); PG8_BAR; PG8_SCHED;
            PG8_STAGE(PG8_SB(0, 1), b2 + hstep, voffB);
            PG8_WAIT_V(6); PG8_BAR; PG8_MMA(1, 1, At, B1); PG8_BAR;
            PG8_LDB(B0, 1, 0); PG8_SCHED; PG8_LDA(At, 1, 0); PG8_STAGE(PG8_SA(0, 1), a2 + hstep, voffA);
            PG8_WAIT_L(8); PG8_BAR; PG8_WAIT_L(0); PG8_MMA(0, 0, At, B0); PG8_BAR; PG8_SCHED;
            PG8_LDB(B1, 1, 1); PG8_STAGE(PG8_SB(1, 0), b3, voffB);
            PG8_BAR; PG8_WAIT_L(0); PG8_MMA(0, 1, At, B1); PG8_BAR;
            PG8_LDA(At, 1, 1); PG8_STAGE(PG8_SA(1, 0), a3, voffA);
            PG8_BAR; PG8_WAIT_L(0); PG8_MMA(1, 0, At, B0); PG8_BAR; PG8_SCHED;
            PG8_STAGE(PG8_SB(1, 1), b3 + hstep, voffB);
            PG8_WAIT_V(6); PG8_BAR; PG8_MMA(1, 1, At, B1); PG8_BAR;
            }
        }
        if constexpr (ALIGN_EPI) { if (wr == 0) PG8_BAR; }
        bool keep_acc = false;
        if constexpr (Epi::CHAIN) { if (cur.seg == 0) { E.mid(acc, cur, wr, wc, fr, fq); keep_acc = true; } else E(acc, cur, wr, wc, fr, fq); }
        else if constexpr (!Epi::AFTER_DRAIN) { E(acc, cur, wr, wc, fr, fq); S.done(cur); }
        if (!has_next) break;
        if (!keep_acc) {
#pragma unroll
        for (int a = 0; a < 2; ++a)
#pragma unroll
            for (int b = 0; b < 2; ++b)
#pragma unroll
                for (int m = 0; m < 4; ++m)
#pragma unroll
                    for (int n = 0; n < 2; ++n) acc[a][b][m][n] = (f32x4){0.f, 0.f, 0.f, 0.f};
        }
        cur = nxt; cA = nA; cB = nB; ++ui;
        if constexpr (ALIGN_EPI) { if (wr == 1) PG8_BAR; }
    }
    PG8_WAIT_V(0);
    if constexpr (!ALIGN_EPI) { if (wr == 0) PG8_BAR; }
    PG8_BAR;
    if constexpr (Epi::AFTER_DRAIN) { E.fused(acc, cur, wr, wc, fr, fq, lds, wid, lane); S.done(cur); }
#undef PG8_UA
#undef PG8_UB
#undef PG8_SA
#undef PG8_SB
#undef PG8_STAGE
#undef PG8_LDA
#undef PG8_LDB
#undef PG8_MMA
#undef PG8_WAIT_V
#undef PG8_WAIT_L
#undef PG8_BAR
#undef PG8_SCHED
}
}
namespace attn {
constexpr int D = 128;
constexpr float THR = 8.f;
constexpr bool WSKIP = false;
constexpr float SCALE = 0.08838834764831845f;
constexpr int NW = 8, QBLK = 32, KVBLK = 64, QB = NW * QBLK;
constexpr int SHM_V = KVBLK * D * 2, SHM_K = KVBLK * D * 2;
constexpr int LDS_BYTES = 2 * SHM_V + 2 * SHM_K + NW * 64 * 4;

typedef unsigned short bf16;
typedef short bf16x8 __attribute__((ext_vector_type(8)));
typedef short s16x4 __attribute__((ext_vector_type(4)));
typedef float f32x16 __attribute__((ext_vector_type(16)));
typedef float f32x4 __attribute__((ext_vector_type(4)));
typedef unsigned u32x4 __attribute__((ext_vector_type(4)));
template <class A, class Bt> struct same_t { static constexpr bool v = false; };
template <class A> struct same_t<A, A> { static constexpr bool v = true; };

#define KSWZ(row, colB) ((row) * 256 + ((colB) ^ (((row) & 7) << 4)))
#define SBAR() __builtin_amdgcn_sched_barrier(0)
__device__ __forceinline__ int v_st(int k, int c) { const int kk = (k & ~0xC) | ((k & 4) << 1) | ((k & 8) >> 1); return ((kk >> 3) * 4 + (c >> 5)) * 512 + ((kk & 7) * 32 + (c & 31)) * 2; }
__device__ __forceinline__ int v_rd_base(int lane) { return ((lane & 3) << 3) | (((lane >> 2) & 3) << 6) | (((lane >> 4) & 1) << 5) | (((lane >> 5) & 1) << 8); }
constexpr int v_rd_off(int d0, int ks, int half) { return d0 * 512 + ks * 4096 + half * 2048; }
__device__ __forceinline__ int crow(int r, int hi) { return (r & 3) + 8 * (r >> 2) + 4 * hi; }
__device__ __forceinline__ unsigned cvtpk(float lo, float hi) {
    unsigned r; asm volatile("v_cvt_pk_bf16_f32 %0, %1, %2" : "=v"(r) : "v"(lo), "v"(hi)); return r;
}
__device__ __forceinline__ bf16x8 pack8(f32x4 a, f32x4 b) {
    u32x4 w = {cvtpk(a[0], a[1]), cvtpk(a[2], a[3]), cvtpk(b[0], b[1]), cvtpk(b[2], b[3])};
    return *reinterpret_cast<bf16x8*>(&w);
}
template <class T> __device__ __forceinline__ bf16x8 load8(const T* p) {
    if constexpr (same_t<T, float>::v) { return pack8(*(const f32x4*)p, *(const f32x4*)(p + 4)); }
    else { return *reinterpret_cast<const bf16x8*>(p); }
}
__device__ __forceinline__ void mask_tile(f32x16& p0, f32x16& p1, int dq, unsigned W) {
    const float NEG = -__builtin_inff();
#pragma unroll
    for (int r = 0; r < 16; ++r) {
        const int c = (r & 3) + 8 * (r >> 2);
        if ((unsigned)(dq - c) >= W) p0[r] = NEG;
        if ((unsigned)(dq - c - 32) >= W) p1[r] = NEG;
    }
}
__device__ __forceinline__ void partialSM(f32x16& p0, f32x16& p1, float& m_reg, float& mn, float& alpha) {
    float pmax = p0[0]; for (int r = 1; r < 16; ++r) pmax = fmaxf(pmax, p0[r]); for (int r = 0; r < 16; ++r) pmax = fmaxf(pmax, p1[r]);
    { auto rr = __builtin_amdgcn_permlane32_swap(__float_as_uint(pmax), __float_as_uint(pmax), false, false);
      pmax = fmaxf(__uint_as_float(rr[0]), __uint_as_float(rr[1])); }
    constexpr float C2 = 1.4426950408889634f * SCALE;
    if (__builtin_expect(__all((pmax - m_reg) * SCALE <= THR), 1)) { mn = m_reg; alpha = 1.f; }
    else { mn = fmaxf(m_reg, pmax); alpha = __builtin_amdgcn_exp2f((m_reg - mn) * C2); m_reg = mn; }
    const float mnL = -mn * C2;
    for (int r = 0; r < 16; ++r) p0[r] = fmaf(p0[r], C2, mnL); for (int r = 0; r < 16; ++r) p1[r] = fmaf(p1[r], C2, mnL);
    for (int r = 0; r < 16; ++r) p0[r] = __builtin_amdgcn_exp2f(p0[r]);
}
__device__ __forceinline__ void finishSM(f32x16& p0, f32x16& p1, float alpha, float& l_reg, bf16x8& pa0, bf16x8& pa1, bf16x8& pa2, bf16x8& pa3) {
    for (int r = 0; r < 16; ++r) p1[r] = __builtin_amdgcn_exp2f(p1[r]);
    float ps = 0; for (int r = 0; r < 16; ++r) ps += p0[r]; for (int r = 0; r < 16; ++r) ps += p1[r];
    { auto rr = __builtin_amdgcn_permlane32_swap(__float_as_uint(ps), __float_as_uint(ps), false, false);
      ps = __uint_as_float(rr[0]) + __uint_as_float(rr[1]); }
    l_reg = l_reg * alpha + ps;
#define PK4(P, B_, OUT) do { unsigned a0 = cvtpk(P[B_+0], P[B_+1]), a1 = cvtpk(P[B_+2], P[B_+3]);                          \
        unsigned b0 = cvtpk(P[B_+4], P[B_+5]), b1 = cvtpk(P[B_+6], P[B_+7]);                                             \
        auto r0 = __builtin_amdgcn_permlane32_swap(a0, b0, false, false); auto r1 = __builtin_amdgcn_permlane32_swap(a1, b1, false, false); \
        u32x4 w = {r0[0], r1[0], r0[1], r1[1]}; OUT = *reinterpret_cast<bf16x8*>(&w); } while (0)
    PK4(p0, 0, pa0); PK4(p0, 8, pa1); PK4(p1, 0, pa2); PK4(p1, 8, pa3);
#undef PK4
}
template <int KB, bool SK>
__device__ __forceinline__ void qkt(f32x16& p0, f32x16& p1, const char* K_lds, int r32, int hi, const bf16x8* qr, bool act) {
    if (SK && !act) { const float NEG = -__builtin_inff();
#pragma unroll
        for (int r = 0; r < 16; ++r) { p0[r] = NEG; p1[r] = NEG; } return; }
    p0 = f32x16{}; p1 = f32x16{};
    const char* kb[4];
#pragma unroll
    for (int dd = 0; dd < 4; ++dd) kb[dd] = K_lds + KB * SHM_K + KSWZ(r32, (dd * 16 + hi * 8) * 2);
#pragma unroll
    for (int d0 = 0; d0 < 8; ++d0) { const char* a = kb[d0 & 3] + (d0 >> 2) * 128;
        bf16x8 b0 = *reinterpret_cast<const bf16x8*>(a);
        bf16x8 b1 = *reinterpret_cast<const bf16x8*>(a + 32 * 256);
        p0 = __builtin_amdgcn_mfma_f32_32x32x16_bf16(b0, qr[d0], p0, 0, 0, 0);
        p1 = __builtin_amdgcn_mfma_f32_32x32x16_bf16(b1, qr[d0], p1, 0, 0, 0); }
}
template <int VB, bool SK>
__device__ __forceinline__ void pv_tile(f32x16* o, int vb0, bf16x8 pa0, bf16x8 pa1, bf16x8 pa2, bf16x8 pa3, bool act) {
    if (SK && !act) return;
#define TRRD(dst, off) asm volatile("ds_read_b64_tr_b16 %0, %1 offset:%2" : "=&v"(dst) : "v"(vb0), "i"(off) : "memory")
#define PV_D0(d0) do { s16x4 l0, l1, l2, l3, h0, h1, h2, h3; constexpr int b_ = VB * SHM_V + v_rd_off(d0, 0, 0);     \
        TRRD(l0, b_); TRRD(h0, b_ + 2048); TRRD(l1, b_ + 4096); TRRD(h1, b_ + 6144); TRRD(l2, b_ + 8192); TRRD(h2, b_ + 10240); TRRD(l3, b_ + 12288); TRRD(h3, b_ + 14336); \
        asm volatile("s_waitcnt lgkmcnt(0)" ::: "memory"); SBAR();                 \
        o[d0] = __builtin_amdgcn_mfma_f32_32x32x16_bf16(pa0, (bf16x8){l0[0], l0[1], l0[2], l0[3], h0[0], h0[1], h0[2], h0[3]}, o[d0], 0, 0, 0);   \
        o[d0] = __builtin_amdgcn_mfma_f32_32x32x16_bf16(pa1, (bf16x8){l1[0], l1[1], l1[2], l1[3], h1[0], h1[1], h1[2], h1[3]}, o[d0], 0, 0, 0);   \
        o[d0] = __builtin_amdgcn_mfma_f32_32x32x16_bf16(pa2, (bf16x8){l2[0], l2[1], l2[2], l2[3], h2[0], h2[1], h2[2], h2[3]}, o[d0], 0, 0, 0);   \
        o[d0] = __builtin_amdgcn_mfma_f32_32x32x16_bf16(pa3, (bf16x8){l3[0], l3[1], l3[2], l3[3], h3[0], h3[1], h3[2], h3[3]}, o[d0], 0, 0, 0); } while (0)
    PV_D0(0); PV_D0(1); PV_D0(2); PV_D0(3);
#undef PV_D0
#undef TRRD
}

template <class TIn, class TOut> struct BlockRef { const TIn* Q; const TIn* K; const TIn* V; TOut* O; int P0; };
template <class TIn> struct Seam {
    bf16x8 qr[8];
    bf16x8 st_v0, st_v1, st_k0, st_k1; f32x4 sf0, sf1, sf2, sf3;
    f32x4 tq[16];
};
__device__ __forceinline__ int swa_jlo(int P0, int W) { const int lowk = P0 - W + 1; return lowk > 0 ? lowk / KVBLK : 0; }
#define ROW(p, k0, rr) ((p) + (size_t)((k0) + (rr)) * KS + sc)
#define VMW() asm volatile("s_waitcnt vmcnt(0)" ::: "memory")
#define VMWN(n) asm volatile("s_waitcnt vmcnt(%0)" :: "i"(n) : "memory")
#define SLOAD_H(Kp, Vp, k0) do { S.st_v0 = load8<TIn>(ROW(Vp, k0, sr)); S.st_v1 = load8<TIn>(ROW(Vp, k0, 32 + sr));              \
                         S.st_k0 = load8<TIn>(ROW(Kp, k0, sr)); S.st_k1 = load8<TIn>(ROW(Kp, k0, 32 + sr)); } while (0)
#define SWRITE_HK(bf) do { *(bf16x8*)(K_lds + (bf) * SHM_K + kws) = S.st_k0; *(bf16x8*)(K_lds + (bf) * SHM_K + kws + 32 * 256) = S.st_k1; } while (0)
#define SWRITE_HV(bf) do { *(bf16x8*)(V_lds + (bf) * SHM_V + vst0) = S.st_v0; *(bf16x8*)(V_lds + (bf) * SHM_V + vst1) = S.st_v1; } while (0)
#define SWRITE_H(bf) do { SWRITE_HV(bf); SWRITE_HK(bf); } while (0)
#define SLOAD_F(p, k0) do { S.sf0 = *(const f32x4*)ROW(p, k0, sr); S.sf1 = *(const f32x4*)(ROW(p, k0, sr) + 4);                \
                            S.sf2 = *(const f32x4*)ROW(p, k0, 32 + sr); S.sf3 = *(const f32x4*)(ROW(p, k0, 32 + sr) + 4); } while (0)
#define SWRITE_KF(bf) do { *(bf16x8*)(K_lds + (bf) * SHM_K + kws) = pack8(S.sf0, S.sf1); *(bf16x8*)(K_lds + (bf) * SHM_K + kws + 32 * 256) = pack8(S.sf2, S.sf3); } while (0)
#define SWRITE_VF(bf) do { *(bf16x8*)(V_lds + (bf) * SHM_V + vst0) = pack8(S.sf0, S.sf1); *(bf16x8*)(V_lds + (bf) * SHM_V + vst1) = pack8(S.sf2, S.sf3); } while (0)
template <class TIn, class TOut, int QS, int KS, int OS>
__device__ __forceinline__ void causal_swa_prime(const BlockRef<TIn, TOut>& cur, int W, char* lds, Seam<TIn>& S, const int wid) {
    constexpr bool F32 = same_t<TIn, float>::v;
    const int lane = mk_lane(), tid = wid * 64 + lane, r32 = lane & 31, hi = lane >> 5;
    const int sr = tid >> 4, sc = (tid & 15) * 8, kws = KSWZ(sr, sc * 2); char* K_lds = lds + 2 * SHM_V;
    const int kb0 = swa_jlo(cur.P0, W) * KVBLK;
    for (int d0 = 0; d0 < 8; ++d0) S.qr[d0] = load8<TIn>(cur.Q + (size_t)(wid * QBLK + r32) * QS + d0 * 16 + hi * 8);
    if constexpr (F32) { SLOAD_F((const float*)cur.K, kb0); VMW(); SWRITE_KF(0); SBAR(); SLOAD_F((const float*)cur.V, kb0); }
    else { SLOAD_H(cur.K, cur.V, kb0); VMW(); SWRITE_HK(0); }
    __syncthreads();
}
template <class TIn, class TOut, int QS, int KS, int OS>
__device__ __forceinline__ void causal_swa_block(const BlockRef<TIn, TOut>& cur, const BlockRef<TIn, TOut>& nxt, int skv, int W, char* lds, Seam<TIn>& S, const int wid) {
    constexpr bool F32 = same_t<TIn, float>::v;
    const int lane = mk_lane(), tid = wid * 64 + lane, r32 = lane & 31, hi = lane >> 5;
    const int j_lo = swa_jlo(cur.P0, W);
    int j_hi = (cur.P0 + QB - 1) / KVBLK + 1; if (j_hi > skv / KVBLK) j_hi = skv / KVBLK;
    const int NT = j_hi - j_lo;
    const int kbn = swa_jlo(nxt.P0, W) * KVBLK;
    const int qlo = cur.P0 + wid * QBLK, qm = qlo + r32 - 4 * hi;
    char* V_lds = lds; char* K_lds = lds + 2 * SHM_V;
    float* ws = (float*)(lds + 2 * SHM_V + 2 * SHM_K) + wid * 64; float* li_l = ws, * al_l = ws + 32;
    float m_reg = -1e30f, l_reg = 0; f32x16 o[4] = {};
    const int sr = tid >> 4, sc = (tid & 15) * 8, vst0 = v_st(sr, sc), vst1 = v_st(32 + sr, sc), kws = KSWZ(sr, sc * 2);
    const int vb0 = (int)(uintptr_t)V_lds + v_rd_base(lane);
    const TIn* Kh = cur.K; const TIn* Vh = cur.V;
#define RESC(a) do { if (__any((a) < 1.f)) { if (hi == 0) al_l[r32] = (a); asm volatile("s_waitcnt lgkmcnt(0)" ::: "memory");              \
                     for (int d_ = 0; d_ < 4; ++d_) for (int r = 0; r < 16; ++r) o[d_][r] *= al_l[crow(r, hi)]; } } while (0)
#define KBASE(t) ((j_lo + (t)) * KVBLK)
#define ACT(t) (KBASE(t) <= qlo + QBLK - 1 && KBASE(t) + KVBLK - 1 >= qlo - W + 1)
#define MASKT(P0_, P1_, t) do { const int kb_ = KBASE(t); if ((!SK || ACT(t)) && (kb_ + KVBLK - 1 > qlo || kb_ <= qlo + QBLK - 1 - W)) mask_tile(P0_, P1_, qm - kb_, (unsigned)W); } while (0)
    constexpr int NQL = F32 ? 16 : 8;
    constexpr bool SK = WSKIP && !F32;
#define SEAM_K0() do { VMWN(NQL); if constexpr (F32) { SWRITE_KF(0); SBAR(); SLOAD_F((const float*)nxt.V, kbn); } else { SWRITE_HK(0); } SBAR(); } while (0)
    f32x16 pA0, pA1, pB0, pB1; float mnA, mnB, alA, alB; bf16x8 pa0, pa1, pa2, pa3;
    if constexpr (F32) { VMW(); SWRITE_VF(0); SBAR(); } else { SWRITE_HV(0); SBAR(); }
    if (NT > 1) { if constexpr (F32) SLOAD_F((const float*)Kh, KBASE(1)); else SLOAD_H(Kh, Vh, KBASE(1)); }
    SBAR(); qkt<0, SK>(pA0, pA1, K_lds, r32, hi, S.qr, ACT(0));
    if constexpr (F32) { if (NT > 1) { VMW(); SWRITE_KF(1); SBAR(); SLOAD_F((const float*)Vh, KBASE(1)); } }
    MASKT(pA0, pA1, 0); partialSM(pA0, pA1, m_reg, mnA, alA);
    if (NT > 1) { VMW(); if constexpr (F32) { SWRITE_VF(1); SBAR(); if (NT > 2) SLOAD_F((const float*)Kh, KBASE(2)); } else SWRITE_H(1); }
    __syncthreads();
#define HALF_STEP(PX0, PX1, mnX, alX, PY0, PY1, alY, t, KB, VB, SB) do {                                                      \
        SBAR(); qkt<KB, SK>(PX0, PX1, K_lds, r32, hi, S.qr, ACT(t));                                             \
        finishSM(PY0, PY1, alY, l_reg, pa0, pa1, pa2, pa3); SBAR();                                                           \
        if ((t) + 1 < NT) { if constexpr (F32) { VMW(); SWRITE_KF(SB); SBAR(); SLOAD_F((const float*)Vh, KBASE((t) + 1)); }  \
                            else { SLOAD_H(Kh, Vh, KBASE((t) + 1)); } SBAR(); }                                               \
        pv_tile<VB, SK>(o, vb0, pa0, pa1, pa2, pa3, ACT((t) - 1)); MASKT(PX0, PX1, (t)); partialSM(PX0, PX1, m_reg, mnX, alX);                                        \
        __syncthreads();                                                                                                      \
        if ((t) + 1 < NT) { VMW(); if constexpr (F32) { SWRITE_VF(SB); SBAR(); if ((t) + 2 < NT) SLOAD_F((const float*)Kh, KBASE((t) + 2)); } \
                            else { SWRITE_H(SB); } }                                                                          \
        RESC(alX); __syncthreads(); } while (0)
    for (int t = 1; t + 1 < NT; t += 2) {
        HALF_STEP(pB0, pB1, mnB, alB, pA0, pA1, alA, t, 1, 0, 0);
        HALF_STEP(pA0, pA1, mnA, alA, pB0, pB1, alB, t + 1, 0, 1, 1);
    }
    const bool even = (NT & 1) == 0;
    if (even) { SBAR(); qkt<1, SK>(pB0, pB1, K_lds, r32, hi, S.qr, ACT(NT - 1)); SBAR(); }
#define QROW(e) (nxt.Q + (size_t)(wid * QBLK + r32) * QS + ((e) >> 1) * 16 + hi * 8 + ((e) & 1) * 4)
    if constexpr (F32) { SLOAD_F((const float*)nxt.K, kbn); SBAR();
#pragma unroll
        for (int e = 0; e < 8; ++e) S.tq[e] = *(const f32x4*)QROW(e); }
    else { SLOAD_H(nxt.K, nxt.V, kbn); SBAR();
#pragma unroll
        for (int d0 = 0; d0 < 8; ++d0) S.qr[d0] = load8<TIn>(nxt.Q + (size_t)(wid * QBLK + r32) * QS + d0 * 16 + hi * 8); }
    SBAR();
    finishSM(pA0, pA1, alA, l_reg, pa0, pa1, pa2, pa3); SBAR();
    if constexpr (F32) {
#pragma unroll
        for (int e = 8; e < 16; ++e) S.tq[e] = *(const f32x4*)QROW(e); SBAR(); }
#undef QROW
    pv_tile<0, SK>(o, vb0, pa0, pa1, pa2, pa3, ACT(even ? NT - 2 : NT - 1));
    if (even) { MASKT(pB0, pB1, NT - 1); partialSM(pB0, pB1, m_reg, mnB, alB); __syncthreads(); RESC(alB);
        finishSM(pB0, pB1, alB, l_reg, pa0, pa1, pa2, pa3); SBAR(); pv_tile<1, SK>(o, vb0, pa0, pa1, pa2, pa3, ACT(NT - 1)); }
    SBAR(); SEAM_K0();
    if (hi == 0) li_l[r32] = l_reg; asm volatile("s_waitcnt lgkmcnt(0)" ::: "memory");
    float rli[16];
#pragma unroll
    for (int r = 0; r < 16; ++r) rli[r] = __builtin_amdgcn_rcpf(li_l[crow(r, hi)]);
    TOut* Ow = cur.O + (size_t)(wid * QBLK) * OS;
#pragma unroll
    for (int r = 0; r < 16; ++r) { const int orow = crow(r, hi);
#pragma unroll
        for (int d0 = 0; d0 < 4; ++d0) { const float v = o[d0][r] * rli[r];
            if constexpr (same_t<TOut, float>::v) { Ow[(size_t)orow * OS + d0 * 32 + r32] = v; }
            else { const float vn = __shfl_xor(v, 1);
                   if ((r32 & 1) == 0) *(unsigned*)(Ow + (size_t)orow * OS + d0 * 32 + r32) = cvtpk(v, vn); } } }
    if constexpr (F32) {
#pragma unroll
        for (int d0 = 0; d0 < 8; ++d0) S.qr[d0] = pack8(S.tq[2 * d0], S.tq[2 * d0 + 1]); }
    __syncthreads();
#undef RESC
#undef KBASE
#undef ACT
#undef MASKT
#undef SEAM_K0
#undef HALF_STEP
}
#undef ROW
#undef VMW
#undef VMWN
#undef SLOAD_H
#undef SWRITE_HK
#undef SWRITE_HV
#undef SWRITE_H
#undef SLOAD_F
#undef SWRITE_KF
#undef SWRITE_VF
}
constexpr int NWAVES = 8;
#ifndef MK_N_LAUNCHES
#define MK_N_LAUNCHES 1
#endif
constexpr int NPHASES = 18;
constexpr int N_LAUNCHES = MK_N_LAUNCHES;
static_assert(N_LAUNCHES == 1 || N_LAUNCHES == NPHASES, "MK_N_LAUNCHES: 1 or NPHASES");

constexpr int SEQ = 8192, DM = 4096, DFF = 11008, NMIX = 22528, MEM = 256;
constexpr int DAW = 2048, HGW = 2048, XAW = 512;
constexpr float LN_EPS = 1e-5f;
constexpr int DOWN_TAIL_ITEMS = 22016;
constexpr float DN_ALPHA = 1.189207115002721f;
constexpr float LAMBDA_INIT = 0.2f;
constexpr size_t MiB = 1u << 20;
constexpr size_t WS_CTL = 0, CTL_ZERO_BYTES = 1 * MiB;
constexpr size_t WS_LB = 1 * MiB;
constexpr size_t WS_LAM = WS_LB + 8192;
constexpr size_t WS_ST = WS_LB + 65536;
constexpr size_t WS_COS = 2 * MiB, WS_SIN = 4 * MiB;
constexpr size_t WS_DEC = 6 * MiB;
constexpr size_t WS_XKV = 7 * MiB;
constexpr size_t WS_MEMB = 8 * MiB;
constexpr size_t WS_XO = 18 * MiB;
constexpr size_t WS_WXQ = 26 * MiB, WS_WXKV = 30 * MiB, WS_WXO = 38 * MiB, WS_WDA = 42 * MiB, WS_WHG = 58 * MiB, WS_WMO = 74 * MiB, WS_WMI = 106 * MiB, WS_W2A = 282 * MiB, WS_W2D = 454 * MiB;
constexpr size_t WS_R1 = 540 * MiB;
constexpr size_t WS_W1A = WS_R1, WS_W1D = WS_R1 + 172 * MiB;
constexpr size_t WS_PB = WS_R1, PB_SEG = 32 * MiB;
constexpr size_t WS_HF = WS_R1 + 192 * MiB;
constexpr size_t WS_XB = 798 * MiB;
constexpr size_t WS_Y = 862 * MiB;
constexpr size_t WS_XF = 990 * MiB;
constexpr size_t WS_H = 1118 * MiB;
constexpr size_t WS_SLT = WS_H;
constexpr size_t WS_GA = 1290 * MiB, WS_GB = 1354 * MiB;
constexpr size_t WS_O1 = 1418 * MiB, WS_O2 = 1482 * MiB;
constexpr size_t WS_XQP = WS_O2;
constexpr size_t WS_OA = 1546 * MiB, WS_OB = 1578 * MiB;
constexpr size_t WS_END = 1610 * MiB;
static_assert(WS_W1D + (size_t)DM * DFF * 2 <= WS_XB && WS_HF + (size_t)SEQ * 2048 * 4 <= WS_XB && WS_H + (size_t)SEQ * DFF * 2 <= WS_GA && WS_W2D + (size_t)DM * DFF * 2 <= WS_R1 && WS_WMI + (size_t)NMIX * DM * 2 <= WS_W2A && WS_W2A + (size_t)2 * DFF * DM * 2 <= WS_W2D, "d_ws map");
constexpr int CW_TMO = 0, CW_CODE = 1;
constexpr int CW_BAR = 4096;
constexpr int RING_OFF = 0, RING_BYTES = 131072;
constexpr int LDSCTL_OFF = RING_BYTES, MISC_OFF = LDSCTL_OFF + 320;
constexpr int LDS_BYTES = 147456;
constexpr int HG_KT = 0, HG_VT = 18432, HG_QD = 36864, HG_KD = 54272, HG_ST = 71680, HG_TOT = 106496, HG_ER = 108544, HG_SS = 109056;

#define GAS __attribute__((address_space(1)))
#define LAS __attribute__((address_space(3)))
typedef unsigned short bf16;
typedef unsigned v4u __attribute__((ext_vector_type(4)));
typedef unsigned v2u __attribute__((ext_vector_type(2)));
typedef float f32x4 __attribute__((ext_vector_type(4)));
typedef float f32x2 __attribute__((ext_vector_type(2)));
typedef short bf16x8 __attribute__((ext_vector_type(8)));
typedef short s16x4 __attribute__((ext_vector_type(4)));
typedef GAS unsigned gu32;
#define RLX_AGENT __ATOMIC_RELAXED, __HIP_MEMORY_SCOPE_AGENT
#define LDS_WAIT() asm volatile("s_waitcnt lgkmcnt(0)" ::: "memory")
#define VM_WAIT() asm volatile("s_waitcnt vmcnt(0)" ::: "memory")
__device__ __forceinline__ unsigned f2bf(float f) { unsigned u = __builtin_bit_cast(unsigned, f); return (u + 0x7fffu + ((u >> 16) & 1u)) >> 16; }
__device__ __forceinline__ unsigned pk2(float lo, float hi) { return f2bf(lo) | (f2bf(hi) << 16); }
__device__ __forceinline__ float bf2f(unsigned short b) { return __uint_as_float(((unsigned)b) << 16); }

#define XB_TMO      128
#define XB_XCNT(j)  (256  + 64 * (j))
#define XB_XSUB(j)  (1280 + 64 * (j))
#define XB_XGEN(j)  (2304 + 64 * (j))
#define XB_TOP      3328
#define XB_TOPGEN   3392
#define XCD_BAR_WORDS 3456
#define XB_SPIN_CAP (1u << 18)

__device__ __forceinline__ unsigned xb_ld(unsigned* p)              { return __hip_atomic_load(p, __ATOMIC_RELAXED, __HIP_MEMORY_SCOPE_AGENT); }
__device__ __forceinline__ unsigned xb_add(unsigned* p, unsigned v) { return __hip_atomic_fetch_add(p, v, __ATOMIC_RELAXED, __HIP_MEMORY_SCOPE_AGENT); }
__device__ __forceinline__ unsigned xb_xcc_id() { return (unsigned)__builtin_amdgcn_s_getreg((3 << 11) | 20) & 0xFu; }
#define XB_SPIN(cond, bar) do { unsigned _sp = 0; while (cond) { __builtin_amdgcn_s_sleep(1); \
    if ((++_sp & 255u) == 0u) { if (xb_ld(&(bar)[XB_TMO])) break; if (_sp > XB_SPIN_CAP) { atomicAdd(&(bar)[XB_TMO], 1u); break; } } } } while (0)

struct XcdBarrier {
    unsigned* bar; unsigned x;
    volatile LAS unsigned* st;
};

__device__ __forceinline__ XcdBarrier xcd_barrier_post(unsigned* bar, volatile LAS unsigned* st, const bool t0  ) {
    XcdBarrier b; b.bar = bar; b.x = xb_xcc_id(); b.st = st;
    if (t0) (void)xb_add(&bar[XB_XCNT(b.x)], 1u);
    return b;
}
__device__ __forceinline__ void xcd_barrier_complete(unsigned* bar, unsigned x, unsigned& nloc, unsigned& nx) {
    const unsigned G = gridDim.x * gridDim.y * gridDim.z;
    unsigned sum, cnt, mine, sp = 0u;
    for (;;) {
        sum = 0u; cnt = 0u; mine = 0u;
#pragma unroll
        for (unsigned j = 0; j < 16; ++j) { const unsigned c = xb_ld(&bar[XB_XCNT(j)]); sum += c; cnt += (c > 0u) ? 1u : 0u; mine = (j == x) ? c : mine; }
        if (sum == G) break;
        __builtin_amdgcn_s_sleep(1);
        if ((++sp & 255u) == 0u) { if (xb_ld(&bar[XB_TMO])) break; if (sp > XB_SPIN_CAP) { atomicAdd(&bar[XB_TMO], 1u); break; } }
    }
    nloc = mine > 0u ? mine : 1u; nx = cnt > 0u ? cnt : 1u;
}

__device__ __forceinline__ void xcd_barrier(const XcdBarrier& b, const bool t0) {
    asm volatile("s_waitcnt vmcnt(0)" ::: "memory");
    __syncthreads();
    if (t0) {
        unsigned* bar = b.bar;
        __builtin_amdgcn_s_waitcnt(0);
        unsigned nloc = b.st[0], nx = b.st[1];
        if (nloc == 0u) { xcd_barrier_complete(bar, b.x, nloc, nx); b.st[0] = nloc; b.st[1] = nx; }
        const unsigned old = xb_add(&bar[XB_XSUB(b.x)], 1u);
        const unsigned gen = old / nloc;
        if (old + 1u == (gen + 1u) * nloc) {
            __builtin_amdgcn_fence(__ATOMIC_RELEASE, "agent");
            asm volatile("s_waitcnt vmcnt(0)" ::: "memory");
            const unsigned og = xb_add(&bar[XB_TOP], 1u);
            const unsigned tg = og / nx;
            if (og + 1u == (tg + 1u) * nx) xb_add(&bar[XB_TOPGEN], 1u);
            else XB_SPIN(xb_ld(&bar[XB_TOPGEN]) == tg, bar);
            __builtin_amdgcn_fence(__ATOMIC_ACQUIRE, "agent");
            xb_add(&bar[XB_XGEN(b.x)], 1u);
            asm volatile("s_waitcnt vmcnt(0)" ::: "memory");
        } else {
            XB_SPIN(xb_ld(&bar[XB_XGEN(b.x)]) == gen, bar);
            __builtin_amdgcn_fence(__ATOMIC_ACQUIRE, "agent");
            asm volatile("s_waitcnt vmcnt(0)" ::: "memory");
        }
    }
    __syncthreads();
}

struct Args { const float* in[31]; float* out; unsigned char* ws; int ph_lo, ph_hi; };
enum InIdx { I_X = 0, I_MEM, I_F1G, I_F1U, I_F1D, I_LN1G, I_LN1B, I_MIXIN, I_LQ1, I_LK1, I_LQ2, I_LK2, I_SUBLN, I_DAUP, I_LBLOG, I_HGNORM, I_HGUP, I_MIXOUT, I_LN2G, I_LN2B,
             I_XAQ, I_XAK, I_XAV, I_XAO, I_LN3G, I_LN3B, I_F2G, I_F2U, I_F2D, I_LN4G, I_LN4B };
typedef const char __attribute__((address_space(4))) karg_c;
__device__ __forceinline__ const float* arg_in(int i) { karg_c* kp = (karg_c*)__builtin_amdgcn_kernarg_segment_ptr(); asm volatile("" : "+s"(kp)); return *(const float* const __attribute__((address_space(4)))*)(kp + 8 * i); }
__device__ __forceinline__ float* arg_out() { karg_c* kp = (karg_c*)__builtin_amdgcn_kernarg_segment_ptr(); asm volatile("" : "+s"(kp)); return *(float* const __attribute__((address_space(4)))*)(kp + 8 * 31); }
struct Frame {
    LAS unsigned char* lds;
    volatile LAS unsigned* MISC;
    gu32* ctl;
    int wave;
    int vcu, G;
};
__device__ __forceinline__ float wave_sum(float v) {
#pragma unroll
    for (int o = 1; o < 64; o <<= 1) v += __shfl_xor(v, o);
    return v;
}

__device__ __forceinline__ void p0_transpose_item(const float* W, int K, int N, bf16* WT, int k0, int n0, int drow0, LAS float* scr, int lane) {
    { f32x4 wv[8];
      const float* wp = W + (size_t)(k0 + (lane >> 3)) * N + n0 + 4 * (lane & 7);
#pragma unroll
      for (int i = 0; i < 8; ++i) wv[i] = *(const GAS f32x4*)(wp + (size_t)(8 * i) * N);
#pragma unroll
      for (int i = 0; i < 8; ++i) { LAS float* d = scr + (8 * i + (lane >> 3)) * 33 + 4 * (lane & 7); d[0] = wv[i].x; d[1] = wv[i].y; d[2] = wv[i].z; d[3] = wv[i].w; } }
    LDS_WAIT(); asm volatile("" ::: "memory");
    const int c = lane & 7;
#pragma unroll
    for (int j = 0; j < 4; ++j) { const int n = (lane >> 3) + 8 * j; const LAS float* s = scr + (8 * c) * 33 + n;
        v4u o; o.x = pk2(s[0 * 33], s[1 * 33]); o.y = pk2(s[2 * 33], s[3 * 33]); o.z = pk2(s[4 * 33], s[5 * 33]); o.w = pk2(s[6 * 33], s[7 * 33]);
        *(GAS v4u*)(WT + (size_t)(drow0 + n) * K + k0 + 8 * c) = o; }
    LDS_WAIT(); asm volatile("" ::: "memory");
}
__device__ __forceinline__ int map_gu(int n0, int up) { return (n0 >> 7) * 256 + up * 128 + (n0 & 127); }
__device__ __forceinline__ int map_mix(int n0) { if (n0 >= 4096) return n0; const int cc = n0 & 255; return (n0 & ~255) + ((cc >> 6) & 1) * 128 + (cc >> 7) * 64 + (cc & 63); }
__device__ __forceinline__ void sincos_d(double ang, float& sn_o, float& cs_o) {
    const double kd = __builtin_rint(ang * 0.63661977236758134308);
    double y = __builtin_fma(-kd, 1.57079632679489655800e+00, ang); y = __builtin_fma(-kd, 6.12323399573676603587e-17, y);
    const int q = ((int)kd) & 3; const double y2 = y * y;
    const double sp = y * (1.0 + y2 * (-1.0 / 6.0 + y2 * (1.0 / 120.0 + y2 * (-1.0 / 5040.0 + y2 * (1.0 / 362880.0 + y2 * (-1.0 / 39916800.0 + y2 * (1.0 / 6227020800.0 + y2 * (-1.0 / 1307674368000.0))))))));
    const double cp = 1.0 + y2 * (-0.5 + y2 * (1.0 / 24.0 + y2 * (-1.0 / 720.0 + y2 * (1.0 / 40320.0 + y2 * (-1.0 / 3628800.0 + y2 * (1.0 / 479001600.0 + y2 * (-1.0 / 87178291200.0 + y2 * (1.0 / 20922789888000.0))))))));
    const double sn = (q == 0) ? sp : (q == 1) ? cp : (q == 2) ? -sp : -cp;
    const double cs = (q == 0) ? cp : (q == 1) ? -sp : (q == 2) ? -cp : sp;
    sn_o = (float)sn; cs_o = (float)cs;
}
__device__ __forceinline__ void p0_prologue(Frame& F, unsigned char* ws) {
    LAS float* scr = (LAS float*)(F.lds + RING_OFF + F.wave * 16384); const int lane = mk_lane();
    const int gw = F.vcu * NWAVES + F.wave, NGW = F.G * NWAVES;
    bf16* ws16 = (bf16*)ws;
    constexpr int I_FF = (DM / 64) * (DFF / 32), I_DN = (DFF / 64) * (DM / 32), I_MI = (DM / 64) * (NMIX / 32), I_UP = (2048 / 64) * (DM / 32), I_MO = (DM / 64) * (DM / 32), I_XP = (DM / 64) * (XAW / 32), I_XO = (XAW / 64) * (DM / 32);
    constexpr int I_DR = I_DN - DOWN_TAIL_ITEMS;
    constexpr int NITEMS = 4 * I_FF + 2 * I_DR + I_MI + 2 * I_UP + I_MO + 3 * I_XP + I_XO;
    for (int it = gw; it < NITEMS; it += NGW) {
        int r = it; const float* W; int K, N, kind; bf16* WT;
        int off = 0;
        if (r < I_FF) { W = arg_in(I_F1G); K = DM; N = DFF; WT = (bf16*)(ws + WS_W1A); kind = 1; }
        else if ((r -= I_FF) < I_FF) { W = arg_in(I_F1U); K = DM; N = DFF; WT = (bf16*)(ws + WS_W1A); kind = 2; }
        else if ((r -= I_FF) < I_DR) { r += DOWN_TAIL_ITEMS; W = arg_in(I_F1D); K = DFF; N = DM; WT = (bf16*)(ws + WS_W1D); kind = 0; }
        else if ((r -= I_DR) < I_MI) { W = arg_in(I_MIXIN); K = DM; N = NMIX; WT = (bf16*)(ws + WS_WMI); kind = 3; }
        else if ((r -= I_MI) < I_UP) { W = arg_in(I_DAUP); K = 2048; N = DM; WT = (bf16*)(ws + WS_WDA); kind = 0; }
        else if ((r -= I_UP) < I_UP) { W = arg_in(I_HGUP); K = 2048; N = DM; WT = (bf16*)(ws + WS_WHG); kind = 0; }
        else if ((r -= I_UP) < I_MO) { W = arg_in(I_MIXOUT); K = DM; N = DM; WT = (bf16*)(ws + WS_WMO); kind = 0; }
        else if ((r -= I_MO) < I_XP) { W = arg_in(I_XAQ); K = DM; N = XAW; WT = (bf16*)(ws + WS_WXQ); kind = 0; }
        else if ((r -= I_XP) < I_XP) { W = arg_in(I_XAK); K = DM; N = XAW; WT = (bf16*)(ws + WS_WXKV); kind = 0; }
        else if ((r -= I_XP) < I_XP) { W = arg_in(I_XAV); K = DM; N = XAW; WT = (bf16*)(ws + WS_WXKV); kind = 0; off = XAW; }
        else if ((r -= I_XP) < I_XO) { W = arg_in(I_XAO); K = XAW; N = DM; WT = (bf16*)(ws + WS_WXO); kind = 0; }
        else if ((r -= I_XO) < I_FF) { W = arg_in(I_F2G); K = DM; N = DFF; WT = (bf16*)(ws + WS_W2A); kind = 1; }
        else if ((r -= I_FF) < I_FF) { W = arg_in(I_F2U); K = DM; N = DFF; WT = (bf16*)(ws + WS_W2A); kind = 2; }
        else { r -= I_FF; r += DOWN_TAIL_ITEMS; W = arg_in(I_F2D); K = DFF; N = DM; WT = (bf16*)(ws + WS_W2D); kind = 0; }
        const int nblk = N / 32, kb = r / nblk, nb = r - kb * nblk, n0 = 32 * nb;
        const int drow0 = kind == 0 ? n0 + off : kind == 3 ? map_mix(n0) : map_gu(n0, kind - 1);
        p0_transpose_item(W, K, N, WT, 64 * kb, n0, drow0, scr, lane);
    }
    (void)ws16;
    { const size_t gt = (size_t)gw * 64 + lane, NT = (size_t)NGW * 64;
      const GAS f32x4* x4 = (const GAS f32x4*)arg_in(I_X); GAS v4u* xb = (GAS v4u*)(ws + WS_XB);
      for (size_t i = gt; i < (size_t)SEQ * DM / 8; i += NT) { const f32x4 p = x4[2 * i], q = x4[2 * i + 1]; v4u o; o.x = pk2(p.x, p.y); o.y = pk2(p.z, p.w); o.z = pk2(q.x, q.y); o.w = pk2(q.z, q.w); xb[i] = o; }
      const GAS f32x4* m4 = (const GAS f32x4*)arg_in(I_MEM); GAS v4u* mb = (GAS v4u*)(ws + WS_MEMB);
      for (size_t i = gt; i < (size_t)MEM * DM / 8; i += NT) { const f32x4 p = m4[2 * i], q = m4[2 * i + 1]; v4u o; o.x = pk2(p.x, p.y); o.y = pk2(p.z, p.w); o.z = pk2(q.x, q.y); o.w = pk2(q.z, q.w); mb[i] = o; }
      float* COS = (float*)(ws + WS_COS); float* SIN = (float*)(ws + WS_SIN);
      for (size_t i = gt; i < (size_t)SEQ * 64; i += NT) { const int pos = (int)(i >> 6), fi = (int)(i & 63);
          double inv = 1.0, base = 0.86596432336006535;
#pragma unroll
          for (int bit = 0; bit < 6; ++bit) { if ((fi >> bit) & 1) inv *= base; base *= base; }
          const float invf = (float)inv; const float angf = (float)pos * invf;
          float sn, cs; sincos_d((double)angf, sn, cs); COS[i] = cs; SIN[i] = sn; }
      const float* lbl = arg_in(I_LBLOG); float* LB = (float*)(ws + WS_LB);
      for (size_t i = gt; i < 2048; i += NT) { const float l0 = lbl[i], l1 = lbl[2048 + i]; LB[i] = 1.0f / (1.0f + expf(l1 - l0)); }
    }
    if (blockIdx.x == 0 && F.wave == 0) {
        const int l = lane; const float* q1 = arg_in(I_LQ1); const float* k1 = arg_in(I_LK1); const float* q2 = arg_in(I_LQ2); const float* k2 = arg_in(I_LK2);
        const float s1 = wave_sum(q1[l] * k1[l] + q1[l + 64] * k1[l + 64]), s2 = wave_sum(q2[l] * k2[l] + q2[l + 64] * k2[l + 64]);
        if (l == 0) *(float*)(ws + WS_LAM) = expf(s1) - expf(s2) + LAMBDA_INIT;
    }
}

__device__ __forceinline__ void p0_convert_down(Frame& F, const float* W, bf16* WT, int t0) {
    const int nb = F.G - t0, b = (int)blockIdx.x - t0; if (b < 0) return;
    LAS float* scr = (LAS float*)(F.lds + RING_OFF + F.wave * 16384); const int lane = mk_lane();
    constexpr int nblk = DM / 32;
    for (int r = b * NWAVES + F.wave; r < DOWN_TAIL_ITEMS; r += nb * NWAVES) { const int kb = r / nblk, n0 = 32 * (r - kb * nblk);
        p0_transpose_item(W, DFF, DM, WT, 64 * kb, n0, n0, scr, lane); }
}
__device__ __forceinline__ void ln_phase(Frame& F, const float* Y, const float* g, const float* b, float* Xf, bf16* Xb, float* ST = nullptr) {
    const int gw = F.vcu * NWAVES + F.wave, NGW = F.G * NWAVES, lane = mk_lane();
    for (int m = gw; m < SEQ; m += NGW) {
        const GAS f32x4* yr = (const GAS f32x4*)(Y + (size_t)m * DM) + lane;
        f32x4 v[16]; float s = 0.f;
#pragma unroll
        for (int j = 0; j < 16; ++j) { v[j] = yr[64 * j]; s += (v[j].x + v[j].y) + (v[j].z + v[j].w); }
        const float mean = wave_sum(s) * (1.f / DM); float s2 = 0.f;
#pragma unroll
        for (int j = 0; j < 16; ++j) { v[j] = v[j] - mean; s2 += (v[j].x * v[j].x + v[j].y * v[j].y) + (v[j].z * v[j].z + v[j].w * v[j].w); }
        const float rstd = 1.f / sqrtf(wave_sum(s2) * (1.f / DM) + LN_EPS);
        if (ST && lane == 0) { ST[2 * m] = mean; ST[2 * m + 1] = rstd; }
        const GAS f32x4* g4 = (const GAS f32x4*)g + lane; const GAS f32x4* b4 = (const GAS f32x4*)b + lane;
#pragma unroll
        for (int j = 0; j < 16; ++j) { const f32x4 o = v[j] * rstd * g4[64 * j] + b4[64 * j];
            if (Xf) ((GAS f32x4*)(Xf + (size_t)m * DM) + lane)[64 * j] = o;
            if (Xb) { v2u w; w.x = pk2(o.x, o.y); w.y = pk2(o.z, o.w); ((GAS v2u*)(Xb + (size_t)m * DM) + lane)[64 * j] = w; } }
    }
}
__device__ __forceinline__ void da_combine(Frame& F, unsigned char* ws) {
    const int gw = F.vcu * NWAVES + F.wave, NGW = F.G * NWAVES, lane = mk_lane();
    const float lam = *(const float*)(ws + WS_LAM);
    const f32x4 g4 = ((const GAS f32x4*)arg_in(I_SUBLN))[lane];
    const float* O1 = (const float*)(ws + WS_O1); const float* O2 = (const float*)(ws + WS_O2); bf16* OA = (bf16*)(ws + WS_OA);
    for (int r = gw; r < SEQ * 8; r += NGW) {
        const size_t off = (size_t)r * 256 + 4 * lane;
        const f32x4 o1 = *(const GAS f32x4*)(O1 + off), o2 = *(const GAS f32x4*)(O2 + off);
        const f32x4 o = o1 - o2 * lam;
        const float ss = wave_sum((o.x * o.x + o.y * o.y) + (o.z * o.z + o.w * o.w));
        const float rs = (1.0f - LAMBDA_INIT) / sqrtf(ss * (1.f / 256.f) + LN_EPS);
        const f32x4 y = o * rs * g4;
        v2u w; w.x = pk2(y.x, y.y); w.y = pk2(y.z, y.w); *(GAS v2u*)(OA + off) = w;
    }
}
#define HG_GATES(ROWBASE)                                                                                           \
    float g[16], kk[16];                                                                                            \
    _Pragma("unroll") for (int i = 0; i < 16; ++i) { const float p = HF[(ROWBASE) + (size_t)i * 2048 + n];        \
        const float sg_ = __builtin_amdgcn_rcpf(1.0f + __expf(-p)); const float f = lb + (1.0f - lb) * sg_; kk[i] = 1.0f - f; g[i] = __logf(f); } \
    _Pragma("unroll") for (int i = 1; i < 16; ++i) g[i] += g[i - 1];
__device__ __forceinline__ void hgrn_passA(Frame& F, unsigned char* ws) {
    LAS unsigned char* L = F.lds + RING_OFF;
    const int lane = mk_lane(), w = F.wave, tid = w * 64 + lane, n = tid & 127, sg = tid >> 7, fr = lane & 15, fq = lane >> 4;
    const float* HF = (const float*)(ws + WS_HF); const bf16* HI = (const bf16*)(ws + WS_PB + 4 * PB_SEG); const float* LB = (const float*)(ws + WS_LB);
    float* SLT = (float*)(ws + WS_SLT); float* DEC = (float*)(ws + WS_DEC);
    LAS float* TOT = (LAS float*)(L + HG_TOT);
    for (int item = blockIdx.x; item < 2048; item += F.G) {
        const int h = item >> 7, c = item & 127;
        const float lb = LB[h * 128 + n];
        const size_t rowbase = (size_t)(c * 64 + sg * 16) * 2048 + h * 128;
        HG_GATES(rowbase)
        TOT[sg * 128 + n] = g[15];
        { unsigned vv[8];
#pragma unroll
          for (int i = 0; i < 8; ++i) vv[i] = (unsigned)HI[rowbase + (size_t)(2 * i) * 2048 + n] | ((unsigned)HI[rowbase + (size_t)(2 * i + 1) * 2048 + n] << 16);
          *(LAS v4u*)(L + HG_VT + n * 144 + sg * 32) = (v4u){vv[0], vv[1], vv[2], vv[3]}; *(LAS v4u*)(L + HG_VT + n * 144 + sg * 32 + 16) = (v4u){vv[4], vv[5], vv[6], vv[7]}; }
        __syncthreads();
        { const float t0 = TOT[n], t1 = TOT[128 + n], t2 = TOT[256 + n], t3 = TOT[384 + n];
          const float off = (sg > 0 ? t0 : 0.f) + (sg > 1 ? t1 : 0.f) + (sg > 2 ? t2 : 0.f), bl = (t0 + t1) + (t2 + t3);
          unsigned kw[8];
#pragma unroll
          for (int i = 0; i < 8; ++i) kw[i] = pg8::cvt_pk_bf16(kk[2 * i] * __expf(bl - (off + g[2 * i])), kk[2 * i + 1] * __expf(bl - (off + g[2 * i + 1])));
          *(LAS v4u*)(L + HG_KT + n * 144 + sg * 32) = (v4u){kw[0], kw[1], kw[2], kw[3]}; *(LAS v4u*)(L + HG_KT + n * 144 + sg * 32 + 16) = (v4u){kw[4], kw[5], kw[6], kw[7]};
          if (sg == 0) DEC[(size_t)(h * 128 + c) * 128 + n] = __expf(bl); }
        __syncthreads();
        f32x4 acc[8];
#pragma unroll
        for (int et = 0; et < 8; ++et) acc[et] = (f32x4){0.f, 0.f, 0.f, 0.f};
#pragma unroll
        for (int ks = 0; ks < 2; ++ks) { const bf16x8 af = *(const LAS bf16x8*)(L + HG_KT + (16 * w + fr) * 144 + (32 * ks + 8 * fq) * 2);
#pragma unroll
            for (int et = 0; et < 8; ++et) { const bf16x8 bfr = *(const LAS bf16x8*)(L + HG_VT + (16 * et + fr) * 144 + (32 * ks + 8 * fq) * 2);
                acc[et] = __builtin_amdgcn_mfma_f32_16x16x32_bf16(af, bfr, acc[et], 0, 0, 0); } }
        float* dst = SLT + (size_t)(h * 128 + c) * 16384 + 16 * w + 4 * fq;
#pragma unroll
        for (int et = 0; et < 8; ++et) *(GAS f32x4*)(dst + (size_t)(16 * et + fr) * 128) = acc[et];
        __syncthreads();
    }
}
__device__ __forceinline__ void hgrn_passB(Frame& F, unsigned char* ws) {
    const float* SLT = (const float*)(ws + WS_SLT); float* SP = (float*)(ws + WS_XF); const float* DEC = (const float*)(ws + WS_DEC);
    for (int idx = blockIdx.x * (NWAVES * 64) + F.wave * 64 + mk_lane(); idx < 16 * 128 * 64; idx += F.G * NWAVES * 64) {
        const int h = idx >> 13, e = (idx >> 6) & 127, np = idx & 63;
        const GAS f32x2* p = (const GAS f32x2*)(SLT + (size_t)h * 128 * 16384 + (size_t)e * 128 + 2 * np);
        GAS f32x2* q = (GAS f32x2*)(SP + (size_t)h * 128 * 16384 + (size_t)e * 128 + 2 * np);
        const GAS f32x2* d = (const GAS f32x2*)(DEC + (size_t)h * 128 * 128 + 2 * np);
        f32x2 st = (f32x2){0.f, 0.f};
        for (int c0 = 0; c0 < 128; c0 += 16) {
            f32x2 lv[16], dv[16];
#pragma unroll
            for (int k = 0; k < 16; ++k) { lv[k] = p[(size_t)(c0 + k) * 8192]; dv[k] = d[(size_t)(c0 + k) * 64]; }
#pragma unroll
            for (int k = 0; k < 16; ++k) { q[(size_t)(c0 + k) * 8192] = st; st = dv[k] * st + lv[k]; }
        }
    }
}
__device__ __forceinline__ void hgrn_passC(Frame& F, unsigned char* ws) {
    LAS unsigned char* L = F.lds + RING_OFF;
    const int lane = mk_lane(), w = F.wave, tid = w * 64 + lane, n = tid & 127, sg = tid >> 7, fr = lane & 15, fq = lane >> 4;
    const float* HF = (const float*)(ws + WS_HF); const bf16* HQ = (const bf16*)(ws + WS_PB + 3 * PB_SEG); const bf16* HI = (const bf16*)(ws + WS_PB + 4 * PB_SEG); const bf16* HGt = (const bf16*)(ws + WS_PB + 5 * PB_SEG);
    const float* LB = (const float*)(ws + WS_LB); const float* SLT = (const float*)(ws + WS_XF); const float* NG = arg_in(I_HGNORM); bf16* OB = (bf16*)(ws + WS_OB);
    LAS float* TOT = (LAS float*)(L + HG_TOT); LAS float* ER = (LAS float*)(L + HG_ER); LAS float* SS = (LAS float*)(L + HG_SS);
    const int ti = w & 3, eh = w >> 2;
    float ng[4];
#pragma unroll
    for (int q4 = 0; q4 < 4; ++q4) ng[q4] = NG[16 * (4 * eh + q4) + fr];
    for (int item = blockIdx.x; item < 2048; item += F.G) {
        const int h = item >> 7, c = item & 127;
        const float lb = LB[h * 128 + n];
        const size_t rowbase = (size_t)(c * 64 + sg * 16) * 2048 + h * 128;
        f32x4 sp[8];
        { const float* src = SLT + (size_t)(h * 128 + c) * 16384; const int n4 = (tid & 31) * 4;
#pragma unroll
          for (int k = 0; k < 8; ++k) sp[k] = *(const GAS f32x4*)(src + (size_t)((tid >> 5) + 16 * k) * 128 + n4); }
        unsigned short gtv[16];
#pragma unroll
        for (int i = 0; i < 4; ++i)
#pragma unroll
            for (int q4 = 0; q4 < 4; ++q4) gtv[4 * i + q4] = HGt[(size_t)(c * 64 + 16 * ti + 4 * fq + i) * 2048 + h * 128 + 16 * (4 * eh + q4) + fr];
        HG_GATES(rowbase)
        TOT[sg * 128 + n] = g[15];
        unsigned short qv[16];
#pragma unroll
        for (int i = 0; i < 16; ++i) qv[i] = HQ[rowbase + (size_t)i * 2048 + n];
        { unsigned vv[8];
#pragma unroll
          for (int i = 0; i < 8; ++i) vv[i] = (unsigned)HI[rowbase + (size_t)(2 * i) * 2048 + n] | ((unsigned)HI[rowbase + (size_t)(2 * i + 1) * 2048 + n] << 16);
          *(LAS v4u*)(L + HG_VT + n * 144 + sg * 32) = (v4u){vv[0], vv[1], vv[2], vv[3]}; *(LAS v4u*)(L + HG_VT + n * 144 + sg * 32 + 16) = (v4u){vv[4], vv[5], vv[6], vv[7]}; }
        __syncthreads();
        { const float t0 = TOT[n], t1 = TOT[128 + n], t2 = TOT[256 + n];
          const float off = (sg > 0 ? t0 : 0.f) + (sg > 1 ? t1 : 0.f) + (sg > 2 ? t2 : 0.f), r = t0 + t1;
#pragma unroll
          for (int i = 0; i < 16; ++i) { const float b = off + g[i];
              *(LAS unsigned short*)(L + HG_QD + (16 * sg + i) * 272 + n * 2) = (unsigned short)pg8::cvt_pk_bf16(bf2f(qv[i]) * __expf(b - r), 0.f);
              *(LAS unsigned short*)(L + HG_KD + (16 * sg + i) * 272 + n * 2) = (unsigned short)pg8::cvt_pk_bf16(kk[i] * __expf(r - b), 0.f); }
          if (sg == 0) ER[n] = __expf(r); }
        __syncthreads();
        { const int n4 = (tid & 31) * 4; const f32x4 er4 = *(const LAS f32x4*)(ER + n4);
#pragma unroll
          for (int k = 0; k < 8; ++k) { const int e = (tid >> 5) + 16 * k; const f32x4 s = sp[k] * er4;
              v2u o; o.x = pg8::cvt_pk_bf16(s.x, s.y); o.y = pg8::cvt_pk_bf16(s.z, s.w); *(LAS v2u*)(L + HG_ST + e * 272 + n4 * 2) = o; } }
        __syncthreads();
        bf16x8 qf[4];
#pragma unroll
        for (int ks = 0; ks < 4; ++ks) qf[ks] = *(const LAS bf16x8*)(L + HG_QD + (16 * ti + fr) * 272 + (32 * ks + 8 * fq) * 2);
        s16x4 pa[4];
#pragma unroll
        for (int j = 0; j < 4; ++j) { pa[j] = (s16x4){0, 0, 0, 0};
            if (j <= ti) { f32x4 at = (f32x4){0.f, 0.f, 0.f, 0.f};
#pragma unroll
                for (int ks = 0; ks < 4; ++ks) { const bf16x8 kf = *(const LAS bf16x8*)(L + HG_KD + (16 * j + fr) * 272 + (32 * ks + 8 * fq) * 2);
                    at = __builtin_amdgcn_mfma_f32_16x16x32_bf16(kf, qf[ks], at, 0, 0, 0); }
                if (j == ti) {
#pragma unroll
                    for (int i = 0; i < 4; ++i) at[i] = (4 * fq + i <= fr) ? at[i] : 0.f; }
                const unsigned w0 = pg8::cvt_pk_bf16(at[0], at[1]), w1 = pg8::cvt_pk_bf16(at[2], at[3]);
                pa[j] = (s16x4){(short)(w0 & 0xffffu), (short)(w0 >> 16), (short)(w1 & 0xffffu), (short)(w1 >> 16)}; } }
        f32x4 acc[4];
#pragma unroll
        for (int q4 = 0; q4 < 4; ++q4) { const int et = 4 * eh + q4; acc[q4] = (f32x4){0.f, 0.f, 0.f, 0.f};
#pragma unroll
            for (int ks = 0; ks < 4; ++ks) { const bf16x8 sf = *(const LAS bf16x8*)(L + HG_ST + (16 * et + fr) * 272 + (32 * ks + 8 * fq) * 2);
                acc[q4] = __builtin_amdgcn_mfma_f32_16x16x32_bf16(qf[ks], sf, acc[q4], 0, 0, 0); }
#pragma unroll
            for (int jp = 0; jp < 2; ++jp) if (2 * jp <= ti) {
                const s16x4 v0 = *(const LAS s16x4*)(L + HG_VT + (16 * et + fr) * 144 + (32 * jp + 4 * fq) * 2), v1 = *(const LAS s16x4*)(L + HG_VT + (16 * et + fr) * 144 + (32 * jp + 16 + 4 * fq) * 2);
                const bf16x8 af = (bf16x8){pa[2 * jp][0], pa[2 * jp][1], pa[2 * jp][2], pa[2 * jp][3], pa[2 * jp + 1][0], pa[2 * jp + 1][1], pa[2 * jp + 1][2], pa[2 * jp + 1][3]};
                const bf16x8 bfv = (bf16x8){v0[0], v0[1], v0[2], v0[3], v1[0], v1[1], v1[2], v1[3]};
                acc[q4] = __builtin_amdgcn_mfma_f32_16x16x32_bf16(af, bfv, acc[q4], 0, 0, 0); } }
        float ssq[4];
#pragma unroll
        for (int i = 0; i < 4; ++i) { float s = (acc[0][i] * acc[0][i] + acc[1][i] * acc[1][i]) + (acc[2][i] * acc[2][i] + acc[3][i] * acc[3][i]);
            s += __shfl_xor(s, 1); s += __shfl_xor(s, 2); s += __shfl_xor(s, 4); s += __shfl_xor(s, 8); ssq[i] = s; }
        if (fr == 0) { *(LAS f32x4*)(SS + w * 16 + 4 * fq) = (f32x4){ssq[0], ssq[1], ssq[2], ssq[3]}; }
        __syncthreads();
        { const f32x4 other = *(const LAS f32x4*)(SS + (w ^ 4) * 16 + 4 * fq);
#pragma unroll
          for (int i = 0; i < 4; ++i) { const float rs = __builtin_amdgcn_rsqf((ssq[i] + other[i]) * (1.f / 128.f) + LN_EPS);
              const size_t orow = (size_t)(c * 64 + 16 * ti + 4 * fq + i) * 2048 + h * 128;
#pragma unroll
              for (int q4 = 0; q4 < 4; ++q4) { const int e = 16 * (4 * eh + q4) + fr; const float gt = bf2f(gtv[4 * i + q4]);
                  const float v = acc[q4][i] * rs * ng[q4] * (gt * __builtin_amdgcn_rcpf(1.0f + __expf(-gt))), vn = __shfl_xor(v, 1);
                  if ((fr & 1) == 0) *(GAS unsigned*)(OB + orow + e) = pg8::cvt_pk_bf16(v, vn); } } }
        __syncthreads();
    }
}
struct AItem { int vh, qb0, qb1; };
__device__ __forceinline__ AItem a_decode(int L) { const int xcd = L & 7, k = L >> 3; AItem it; it.vh = (((k >> 5) * 8 + xcd) * 2 + ((k & 31) >> 4)) & 31; const int x = k & 15; it.qb0 = x; it.qb1 = 31 - x; return it; }
__device__ __forceinline__ attn::BlockRef<bf16, float> a_ref(const AItem& it, int pass, unsigned char* ws) {
    const int qb = pass ? it.qb1 : it.qb0, kvp = it.vh >> 1, vhalf = it.vh & 1, h = kvp >> 1, map = kvp & 1;
    attn::BlockRef<bf16, float> r;
    r.Q = (const bf16*)(ws + WS_PB) + (size_t)qb * 256 * 2048 + h * 256 + map * 128;
    r.K = (const bf16*)(ws + WS_PB + PB_SEG) + h * 256 + map * 128;
    r.V = (const bf16*)(ws + WS_PB + 2 * PB_SEG) + h * 256 + vhalf * 128;
    r.O = (float*)(ws + (map ? WS_O2 : WS_O1)) + (size_t)qb * 256 * 2048 + h * 256 + vhalf * 128;
    r.P0 = qb * 256;
    return r;
}
__device__ __forceinline__ void da_attention(Frame& F, unsigned char* ws) {
    constexpr int total = 512; const int stride = F.G;
    int L = blockIdx.x; if (L >= total) return;
    char* lds = (char*)F.lds;
    AItem it = a_decode(L); int pass = 0;
    attn::BlockRef<bf16, float> cur = a_ref(it, 0, ws);
    attn::Seam<bf16> S;
    attn::causal_swa_prime<bf16, float, 2048, 2048, 2048>(cur, SEQ, lds, S, F.wave);
    for (;;) {
        const bool more_pass = pass == 0 && it.qb1 != it.qb0, more_item = L + stride < total, last = !more_pass && !more_item;
        AItem itn = it; int passn = pass + 1, Ln = L;
        if (!more_pass) { passn = 0; Ln = more_item ? L + stride : L; itn = a_decode(Ln); }
        const attn::BlockRef<bf16, float> nxt = last ? cur : a_ref(itn, passn, ws);
        attn::causal_swa_block<bf16, float, 2048, 2048, 2048>(cur, nxt, SEQ, SEQ, lds, S, F.wave);
        if (last) break;
        cur = nxt; it = itn; pass = passn; L = Ln;
    }
}
__device__ __forceinline__ void xa_attention(Frame& F, unsigned char* ws) {
    LAS unsigned char* L = F.lds + RING_OFF;
    const int lane = mk_lane(), w = F.wave, tid = w * 64 + lane, fr = lane & 15, fq = lane >> 4;
    const float* XQP = (const float*)(ws + WS_XQP); const bf16* XKV = (const bf16*)(ws + WS_XKV); bf16* XO = (bf16*)(ws + WS_XO);
    constexpr float C2 = 0.08838834764831845f * 1.4426950408889634f;
    for (int item = blockIdx.x; item < 128; item += F.G) {
        const int h = item >> 5, qb = item & 31;
#pragma unroll
        for (int i = 0; i < 8; ++i) { const int idx = tid + 512 * i, key = idx >> 4, c = idx & 15;
            const v4u kv = *(const GAS v4u*)(XKV + (size_t)key * 1024 + h * 128 + 8 * c);
            *(LAS v4u*)(L + key * 256 + ((c ^ (key & 15)) << 4)) = kv; }
#pragma unroll 4
        for (int i = 0; i < 16; ++i) { const int idx = tid + 512 * i, e = idx & 127, kq = idx >> 7;
            const bf16* vp = XKV + (size_t)(4 * kq) * 1024 + 512 + h * 128 + e;
            v2u o; o.x = (unsigned)vp[0] | ((unsigned)vp[1024] << 16); o.y = (unsigned)vp[2048] | ((unsigned)vp[3072] << 16);
            *(LAS v2u*)(L + 65536 + e * 512 + ((kq ^ ((e & 15) << 1)) << 3)) = o; }
        __syncthreads();
#pragma unroll 1
        for (int qt = 0; qt < 2; ++qt) {
            const size_t qrow = (size_t)qb * 256 + 32 * w + 16 * qt;
            bf16x8 qf[4];
#pragma unroll
            for (int ks = 0; ks < 4; ++ks) { const float* qp = XQP + (qrow + fr) * XAW + h * 128 + 32 * ks + 8 * fq;
                f32x4 a = *(const GAS f32x4*)qp, b = *(const GAS f32x4*)(qp + 4);
#pragma unroll
                for (int p = 1; p < 4; ++p) { a = a + *(const GAS f32x4*)(qp + (size_t)p * SEQ * XAW); b = b + *(const GAS f32x4*)(qp + (size_t)p * SEQ * XAW + 4); }
                const v4u w4 = (v4u){pg8::cvt_pk_bf16(a[0], a[1]), pg8::cvt_pk_bf16(a[2], a[3]), pg8::cvt_pk_bf16(b[0], b[1]), pg8::cvt_pk_bf16(b[2], b[3])};
                qf[ks] = __builtin_bit_cast(bf16x8, w4); }
            f32x4 sacc[16];
#pragma unroll
            for (int kt = 0; kt < 16; ++kt) sacc[kt] = (f32x4){0.f, 0.f, 0.f, 0.f};
#pragma unroll
            for (int ks = 0; ks < 4; ++ks)
#pragma unroll
                for (int kt = 0; kt < 16; ++kt) { const bf16x8 kf = *(const LAS bf16x8*)(L + (16 * kt + fr) * 256 + (((4 * ks + fq) ^ fr) << 4));
                    sacc[kt] = __builtin_amdgcn_mfma_f32_16x16x32_bf16(kf, qf[ks], sacc[kt], 0, 0, 0); }
            float mx = sacc[0][0];
#pragma unroll
            for (int kt = 0; kt < 16; ++kt)
#pragma unroll
                for (int r = 0; r < 4; ++r) mx = fmaxf(mx, sacc[kt][r]);
            mx = fmaxf(mx, __shfl_xor(mx, 16)); mx = fmaxf(mx, __shfl_xor(mx, 32));
            const float mc = mx * C2; float l = 0.f; s16x4 pa[16];
#pragma unroll
            for (int kt = 0; kt < 16; ++kt) { f32x4 p;
#pragma unroll
                for (int r = 0; r < 4; ++r) { p[r] = __builtin_amdgcn_exp2f(sacc[kt][r] * C2 - mc); l += p[r]; }
                const unsigned w0 = pg8::cvt_pk_bf16_pinned(p[0], p[1]), w1 = pg8::cvt_pk_bf16_pinned(p[2], p[3]);
                pa[kt] = (s16x4){(short)(w0 & 0xffffu), (short)(w0 >> 16), (short)(w1 & 0xffffu), (short)(w1 >> 16)}; }
            l += __shfl_xor(l, 16); l += __shfl_xor(l, 32);
            f32x4 oacc[8];
#pragma unroll
            for (int et = 0; et < 8; ++et) oacc[et] = (f32x4){0.f, 0.f, 0.f, 0.f};
#pragma unroll
            for (int kp = 0; kp < 8; ++kp) {
                const bf16x8 af = (bf16x8){pa[2 * kp][0], pa[2 * kp][1], pa[2 * kp][2], pa[2 * kp][3], pa[2 * kp + 1][0], pa[2 * kp + 1][1], pa[2 * kp + 1][2], pa[2 * kp + 1][3]};
#pragma unroll
                for (int et = 0; et < 8; ++et) { const s16x4 v0 = *(const LAS s16x4*)(L + 65536 + (16 * et + fr) * 512 + (((8 * kp + fq) ^ (fr << 1)) << 3)), v1 = *(const LAS s16x4*)(L + 65536 + (16 * et + fr) * 512 + (((8 * kp + 4 + fq) ^ (fr << 1)) << 3));
                    oacc[et] = __builtin_amdgcn_mfma_f32_16x16x32_bf16(af, (bf16x8){v0[0], v0[1], v0[2], v0[3], v1[0], v1[1], v1[2], v1[3]}, oacc[et], 0, 0, 0); } }
            const float rl = 1.0f / l;
#pragma unroll
            for (int r = 0; r < 4; ++r) { const float rr = __shfl(rl, 4 * fq + r);
#pragma unroll
                for (int et = 0; et < 8; ++et) { const float v = oacc[et][r] * rr, vn = __shfl_xor(v, 1);
                    if ((fr & 1) == 0) *(GAS unsigned*)(XO + (qrow + 4 * fq + r) * XAW + h * 128 + 16 * et + fr) = pk2(v, vn); } }
        }
        __syncthreads();
    }
}

__global__ void __launch_bounds__(NWAVES * 64, 2) mk_fwd(Args args) {
    extern __shared__ __attribute__((aligned(16))) unsigned char lds[];
    Frame F;
    F.lds = (LAS unsigned char*)lds;
    F.MISC = (volatile LAS unsigned*)(F.lds + MISC_OFF);
    F.wave = __builtin_amdgcn_readfirstlane((int)threadIdx.x >> 6);
    F.G = gridDim.x; { const int bx = blockIdx.x; F.vcu = (F.G % 8 == 0) ? (bx % 8) * (F.G / 8) + bx / 8 : bx; }
    unsigned char* ws = args.ws;
    F.ctl = (gu32*)(ws + WS_CTL);
    for (int u = threadIdx.x; u < (LDS_BYTES - LDSCTL_OFF) / 4; u += NWAVES * 64) ((LAS unsigned*)(F.lds + LDSCTL_OFF))[u] = 0u;
    __syncthreads();
    XcdBarrier bar; bar.bar = (unsigned*)(F.ctl + CW_BAR); bar.x = 0; bar.st = nullptr;
    if (N_LAUNCHES == 1) bar = xcd_barrier_post((unsigned*)(F.ctl + CW_BAR), F.MISC + 8, threadIdx.x == 0);
#define GRID_BAR() do { if (N_LAUNCHES == 1) xcd_barrier(bar, F.wave == 0 && mk_lane() == 0); } while (0)
    const int lo = args.ph_lo, hi = args.ph_hi;
#define IN(k) (lo <= (k) && (k) < hi)
#define SEAM(k) do { if (IN(k) && IN((k) + 1)) GRID_BAR(); } while (0)
    const int bid = (int)blockIdx.x;
#define XB ((bf16*)(ws + WS_XB))
#define Y ((float*)(ws + WS_Y))
#define XF ((float*)(ws + WS_XF))
#define HB ((bf16*)(ws + WS_H))

    if (IN(0)) { p0_prologue(F, ws); } SEAM(0);
    if (IN(1)) { pg8::Gemm g{XB, (const bf16*)(ws + WS_W1A), SEQ, 2 * DFF, DM, DM, nullptr, nullptr}; pg8::StaticOrder S; S.init(SEQ, 2 * DFF, F.G, bid);
        pg8::EpiSwiGLU E{HB, DFF}; pg8::gemm_phase<pg8::EpiSwiGLU, pg8::StaticOrder, true, true>(F.lds + RING_OFF, g, S, E, F.wave);
        { pg8::Gemm g2{(const bf16*)(ws + WS_MEMB), (const bf16*)(ws + WS_WXKV), MEM, 2 * XAW, DM, DM, nullptr, nullptr}; pg8::StaticOrder S2; S2.init(MEM, 2 * XAW, F.G, (bid + F.G - 192) % F.G);
          pg8::EpiBf16 E2{(bf16*)(ws + WS_XKV), 2 * XAW}; pg8::gemm_phase<pg8::EpiBf16, pg8::StaticOrder, true, true>(F.lds + RING_OFF, g2, S2, E2, F.wave); }
        p0_convert_down(F, arg_in(I_F1D), (bf16*)(ws + WS_W1D), F.G > 200 ? 196 : 0); } SEAM(1);
    if (IN(2)) { pg8::Gemm g{HB, (const bf16*)(ws + WS_W1D), SEQ, DM, DFF, DFF, nullptr, nullptr}; pg8::StaticOrder S; S.init(SEQ, DM, F.G, bid);
        pg8::EpiResF32 E{arg_in(I_X), Y, DM, DN_ALPHA, 0.5f}; pg8::gemm_phase<pg8::EpiResF32, pg8::StaticOrder, true, true>(F.lds + RING_OFF, g, S, E, F.wave); } SEAM(2);
    if (IN(3)) { ln_phase(F, Y, arg_in(I_LN1G), arg_in(I_LN1B), nullptr, XB, (float*)(ws + WS_ST)); } SEAM(3);
    if (IN(4)) { pg8::Gemm g{XB, (const bf16*)(ws + WS_WMI), SEQ, NMIX, DM, DM, nullptr, nullptr}; pg8::StaticOrder S; S.init(SEQ, NMIX, F.G, bid);
        pg8::EpiMixIn E{(bf16*)(ws + WS_PB), PB_SEG / 2, (float*)(ws + WS_HF), (bf16*)(ws + WS_GA), (bf16*)(ws + WS_GB), (const float*)(ws + WS_COS), (const float*)(ws + WS_SIN)};
        pg8::gemm_phase<pg8::EpiMixIn, pg8::StaticOrder, true, true>(F.lds + RING_OFF, g, S, E, F.wave); } SEAM(4);
    if (IN(5)) { da_attention(F, ws); hgrn_passA(F, ws); } SEAM(5);
    if (IN(6)) { hgrn_passB(F, ws); da_combine(F, ws); } SEAM(6);
    if (IN(7)) { hgrn_passC(F, ws); } SEAM(7);
    if (IN(8)) { pg8::Gemm g{(const bf16*)(ws + WS_OA), (const bf16*)(ws + WS_WDA), SEQ, DM, 2048, 2048, (const bf16*)(ws + WS_OB), (const bf16*)(ws + WS_WHG)};
        pg8::DualOrder S; S.init(SEQ, DM, F.G, bid); pg8::EpiMerge E{(const bf16*)(ws + WS_GA), (const bf16*)(ws + WS_GB), XB, DM};
        pg8::gemm_phase<pg8::EpiMerge, pg8::DualOrder, true, true>(F.lds + RING_OFF, g, S, E, F.wave); } SEAM(8);
    if (IN(9)) { pg8::Gemm g{XB, (const bf16*)(ws + WS_WMO), SEQ, DM, DM, DM, nullptr, nullptr}; pg8::StaticOrder S; S.init(SEQ, DM, F.G, bid);
        pg8::EpiResLN E{Y, (const float*)(ws + WS_ST), arg_in(I_LN1G), arg_in(I_LN1B), XF, DM, DN_ALPHA, 1.0f}; pg8::gemm_phase<pg8::EpiResLN, pg8::StaticOrder, true, true>(F.lds + RING_OFF, g, S, E, F.wave); } SEAM(9);
    if (IN(10)) { ln_phase(F, XF, arg_in(I_LN2G), arg_in(I_LN2B), nullptr, XB, (float*)(ws + WS_ST) + 2 * SEQ); } SEAM(10);
    if (IN(11)) { pg8::Gemm g{XB, (const bf16*)(ws + WS_WXQ), SEQ, XAW, DM / 4, DM, nullptr, nullptr}; pg8::SplitKOrder S; S.init(SEQ, XAW, DM / 4, 4, F.G, bid);
        pg8::EpiF32Part E{(float*)(ws + WS_XQP), XAW, DM / 4, (size_t)SEQ * XAW}; pg8::gemm_phase<pg8::EpiF32Part, pg8::SplitKOrder, true, true>(F.lds + RING_OFF, g, S, E, F.wave); } SEAM(11);
    if (IN(12)) { xa_attention(F, ws); } SEAM(12);
    if (IN(13)) { pg8::Gemm g{(const bf16*)(ws + WS_XO), (const bf16*)(ws + WS_WXO), SEQ, DM, XAW, XAW, nullptr, nullptr}; pg8::StaticOrder S; S.init(SEQ, DM, F.G, bid);
        pg8::EpiResLN E{XF, (const float*)(ws + WS_ST) + 2 * SEQ, arg_in(I_LN2G), arg_in(I_LN2B), Y, DM, DN_ALPHA, 1.0f}; pg8::gemm_phase<pg8::EpiResLN, pg8::StaticOrder, true, true>(F.lds + RING_OFF, g, S, E, F.wave); } SEAM(13);
    if (IN(14)) { ln_phase(F, Y, arg_in(I_LN3G), arg_in(I_LN3B), nullptr, XB, (float*)(ws + WS_ST) + 4 * SEQ); } SEAM(14);
    if (IN(15)) { pg8::Gemm g{XB, (const bf16*)(ws + WS_W2A), SEQ, 2 * DFF, DM, DM, nullptr, nullptr}; pg8::StaticOrder S; S.init(SEQ, 2 * DFF, F.G, bid);
        pg8::EpiSwiGLU E{HB, DFF}; pg8::gemm_phase<pg8::EpiSwiGLU, pg8::StaticOrder, true, true>(F.lds + RING_OFF, g, S, E, F.wave);
        p0_convert_down(F, arg_in(I_F2D), (bf16*)(ws + WS_W2D), F.G > 200 ? 192 : 0); } SEAM(15);
    if (IN(16)) { pg8::Gemm g{HB, (const bf16*)(ws + WS_W2D), SEQ, DM, DFF, DFF, nullptr, nullptr}; pg8::StaticOrder S; S.init(SEQ, DM, F.G, bid);
        pg8::EpiResLN E{Y, (const float*)(ws + WS_ST) + 4 * SEQ, arg_in(I_LN3G), arg_in(I_LN3B), XF, DM, DN_ALPHA, 0.5f}; pg8::gemm_phase<pg8::EpiResLN, pg8::StaticOrder, true, true>(F.lds + RING_OFF, g, S, E, F.wave); } SEAM(16);
    if (IN(17)) { ln_phase(F, XF, arg_in(I_LN4G), arg_in(I_LN4B), arg_out(), nullptr); }
#undef XB
#undef Y
#undef XF
#undef HB
#undef IN
#undef SEAM
#undef GRID_BAR
}

extern "C" void kernel_launch(void* const* d_in, const int* in_sizes, int n_in, void* d_out, int out_size, void* d_ws, size_t ws_size, hipStream_t stream) {
    static int grid = 0;
    if (grid == 0) {
        if (n_in != 31 || in_sizes[0] != SEQ * DM || out_size != SEQ * DM || ws_size < WS_END) { fprintf(stderr, "kernel_launch: built for 31 inputs, x/out of %d floats, >= %zu bytes of workspace; got n_in %d, in0 %d, out %d, ws %zu; nothing launched\n", SEQ * DM, (size_t)WS_END, n_in, n_in > 0 ? in_sizes[0] : -1, out_size, ws_size); grid = -1; return; }
        int dev = 0, cus = 0, per_cu = 0;
        if (hipGetDevice(&dev) != hipSuccess || hipDeviceGetAttribute(&cus, hipDeviceAttributeMultiprocessorCount, dev) != hipSuccess) { fprintf(stderr, "kernel_launch: device query failed\n"); grid = -1; return; }
        if (hipFuncSetAttribute((const void*)mk_fwd, hipFuncAttributeMaxDynamicSharedMemorySize, LDS_BYTES) != hipSuccess) { fprintf(stderr, "kernel_launch: hipFuncSetAttribute failed\n"); grid = -1; return; }
        if (hipOccupancyMaxActiveBlocksPerMultiprocessor(&per_cu, (const void*)mk_fwd, NWAVES * 64, LDS_BYTES) != hipSuccess || per_cu < 1)
            fprintf(stderr, "kernel_launch: note: occupancy query reports %d workgroups per CU\n", per_cu);
        (void)hipGetLastError();
        grid = cus;
    }
    if (grid < 0) return;
    if (hipMemsetAsync((char*)d_ws + WS_CTL, 0, CTL_ZERO_BYTES, stream) != hipSuccess) { fprintf(stderr, "kernel_launch: hipMemsetAsync failed\n"); return; }
    Args a{};
    for (int i = 0; i < 31; ++i) a.in[i] = (const float*)d_in[i];
    a.out = (float*)d_out; a.ws = (unsigned char*)d_ws;
    const int n_l = N_LAUNCHES;
    for (int li = 0; li < n_l; ++li) {
        a.ph_lo = (N_LAUNCHES == 1) ? 0 : li; a.ph_hi = (N_LAUNCHES == 1) ? NPHASES : li + 1;
        hipLaunchKernelGGL(mk_fwd, dim3(grid), dim3(NWAVES * 64), LDS_BYTES, stream, a);
        const hipError_t le = hipPeekAtLastError();
        if (le != hipSuccess) { fprintf(stderr, "kernel_launch: launch %d failed: %s\n", li, hipGetErrorName(le)); break; }
    }
}
```

```cpp
#include <hip/hip_runtime.h>
#include <cstdio>
#include <cstdint>
__device__ __forceinline__ int mk_lane() { int l; asm volatile("v_mbcnt_lo_u32_b32 %0, -1, 0\n\tv_mbcnt_hi_u32_b32 %0, -1, %0" : "=v"(l)); return l; }
namespace pg8 {
#define PG8_LAS __attribute__((address_space(3)))
typedef unsigned short bf16_t;
typedef short bf16x8 __attribute__((ext_vector_type(8)));
typedef float f32x4 __attribute__((ext_vector_type(4)));
typedef unsigned u32x4 __attribute__((ext_vector_type(4)));
constexpr int BM = 256, BK = 64, HALF = 128, HTB = HALF * BK * 2  , STAGE_BYTES = 8 * HTB, NXCD = 8, WGM = 8;

__host__ __device__ __forceinline__ int lds_byte(int r, int c) { const int st = (r >> 4) * 2 + (c >> 5), rr = r & 15, cc = c & 31, ob = rr * 64 + cc * 2; return st * 1024 + (ob ^ (((ob >> 9) & 1) << 5)); }
__host__ __device__ __forceinline__ void stage_rc(int b, int& R, int& C) { const int st = b / 1024, sb = b % 1024, swz = sb ^ (((sb >> 9) & 1) << 5); R = (st >> 1) * 16 + swz / 64; C = (st & 1) * 32 + (swz % 64) / 2; }
__host__ __device__ __forceinline__ int perm32(int rho) { const int n = rho >> 4, i = rho & 15; return 8 * (i >> 2) + 4 * n + (i & 3); }

struct Unit { int pm, pn, seg, ko; };
struct Gemm { const bf16_t* A; const bf16_t* Bt; int M, N, K, ld; const bf16_t* A2; const bf16_t* Bt2; };

struct StaticOrder {
    int nM, nN, nwg, G, c;
    __host__ __device__ void init(int M, int N, int G_, int c_) { nM = M / BM; nN = N / BM; nwg = nM * nN; G = G_; c = c_; }
    __host__ __device__ bool next(int i, Unit& u) const {
        const long L = (long)i * G + c; if (L >= nwg) return false;
        int wgid = (int)L; { const int q = nwg / NXCD, r = nwg % NXCD, xcd = wgid % NXCD, off = wgid / NXCD; wgid = (xcd < r ? xcd * (q + 1) : r * (q + 1) + (xcd - r) * q) + off; }
        const int nig = WGM * nN, gid = wgid / nig, fm = gid * WGM, gsz = (nM - fm) < WGM ? (nM - fm) : WGM;
        u.pm = fm + ((wgid % nig) % gsz); u.pn = (wgid % nig) / gsz; u.seg = 0; u.ko = 0; return true;
    }
    __device__ __forceinline__ void a_ready(const Unit&) const {}
    __device__ __forceinline__ void done(const Unit&) const {}
};
struct DualOrder : StaticOrder { __device__ __forceinline__ bool next(int i, Unit& u) const { if (!StaticOrder::next(i >> 1, u)) return false; u.seg = i & 1; return true; } };
struct SplitKOrder { int M, N, ntiles, nks, K, G, c;
    __device__ __forceinline__ void init(int M_, int N_, int K_, int nks_, int G_, int c_) { M = M_; N = N_; ntiles = (M_ / BM) * (N_ / BM); nks = nks_; K = K_; G = G_; c = c_; }
    __device__ __forceinline__ bool next(int i, Unit& u) const { const long L = (long)i * G + c; if (L >= (long)ntiles * nks) return false;
        StaticOrder b; b.init(M, N, ntiles, (int)(L % ntiles)); b.next(0, u); u.seg = 0; u.ko = (int)(L / ntiles) * K; return true; }
    __device__ __forceinline__ void a_ready(const Unit&) const {}
    __device__ __forceinline__ void done(const Unit&) const {}
};

typedef __bf16 bf16x2_cv __attribute__((ext_vector_type(2)));
typedef float f32x2_cv __attribute__((ext_vector_type(2)));
__device__ __forceinline__ unsigned cvt_pk_bf16_pinned(float lo, float hi) { unsigned r; asm volatile("s_nop 1\n\tv_cvt_pk_bf16_f32 %0, %1, %2" : "=v"(r) : "v"(lo), "v"(hi)); return r; }
__device__ __forceinline__ unsigned cvt_pk_bf16(float lo, float hi) { const bf16x2_cv v = __builtin_convertvector((f32x2_cv){lo, hi}, bf16x2_cv); return __builtin_bit_cast(unsigned, v); }
__device__ __forceinline__ u32x4 pack8(const f32x4 a, const f32x4 b) { u32x4 w; w.x = cvt_pk_bf16(a[0], a[1]); w.y = cvt_pk_bf16(a[2], a[3]); w.z = cvt_pk_bf16(b[0], b[1]); w.w = cvt_pk_bf16(b[2], b[3]); return w; }
__device__ __forceinline__ float sigm(float x) { return __builtin_amdgcn_rcpf(1.0f + __builtin_amdgcn_exp2f(-1.4426950408889634f * x)); }
__device__ __forceinline__ f32x4 sigm4(const f32x4 x) { return (f32x4){sigm(x[0]), sigm(x[1]), sigm(x[2]), sigm(x[3])}; }
__device__ __forceinline__ f32x4 bf_lo4(const u32x4 w) { return (f32x4){__uint_as_float(w.x << 16), __uint_as_float(w.x & 0xffff0000u), __uint_as_float(w.y << 16), __uint_as_float(w.y & 0xffff0000u)}; }
__device__ __forceinline__ f32x4 bf_hi4(const u32x4 w) { return (f32x4){__uint_as_float(w.z << 16), __uint_as_float(w.z & 0xffff0000u), __uint_as_float(w.w << 16), __uint_as_float(w.w & 0xffff0000u)}; }

struct EpiBf16 {
    static constexpr bool PERM = true, AFTER_DRAIN = false, CHAIN = false;
    bf16_t* O; int ldc;
    __device__ __forceinline__ void operator()(const f32x4 (&acc)[2][2][4][2], const Unit& u, int wr, int wc, int fr, int fq) const {
        const int row0 = u.pm * BM + wr * 64 + fr, col0 = u.pn * BM + wc * 32 + 8 * fq;
#pragma unroll
        for (int ai = 0; ai < 2; ++ai)
#pragma unroll
            for (int m = 0; m < 4; ++m) { bf16_t* rowp = O + (size_t)(row0 + ai * HALF + m * 16) * ldc + col0;
#pragma unroll
                for (int bj = 0; bj < 2; ++bj) *(u32x4*)(rowp + bj * HALF) = pack8(acc[ai][bj][m][0], acc[ai][bj][m][1]); }
    }
};
struct EpiSwiGLU {
    static constexpr bool PERM = true, AFTER_DRAIN = false, CHAIN = false;
    bf16_t* H; int ldh;
    __device__ __forceinline__ void operator()(const f32x4 (&acc)[2][2][4][2], const Unit& u, int wr, int wc, int fr, int fq) const {
        const int row0 = u.pm * BM + wr * 64 + fr, col0 = u.pn * HALF + wc * 32 + 8 * fq;
#pragma unroll
        for (int ai = 0; ai < 2; ++ai)
#pragma unroll
            for (int m = 0; m < 4; ++m) { bf16_t* rowp = H + (size_t)(row0 + ai * HALF + m * 16) * ldh + col0;
                const f32x4 g0 = acc[ai][0][m][0], g1 = acc[ai][0][m][1];
                const f32x4 v0 = g0 * sigm4(g0) * acc[ai][1][m][0], v1 = g1 * sigm4(g1) * acc[ai][1][m][1];
                *(u32x4*)rowp = pack8(v0, v1); }
    }
};
struct EpiResF32 {
    static constexpr bool PERM = false, AFTER_DRAIN = false, CHAIN = false;
    const float* R; float* Y; int ldc; float alpha, beta;
    __device__ __forceinline__ void operator()(const f32x4 (&acc)[2][2][4][2], const Unit& u, int wr, int wc, int fr, int fq) const {
        const int row0 = u.pm * BM + wr * 64 + fr, col0 = u.pn * BM + wc * 32 + 4 * fq;
#pragma unroll
        for (int ai = 0; ai < 2; ++ai)
#pragma unroll
            for (int m = 0; m < 4; ++m) { const size_t off = (size_t)(row0 + ai * HALF + m * 16) * ldc + col0;
#pragma unroll
                for (int bj = 0; bj < 2; ++bj)
#pragma unroll
                    for (int n = 0; n < 2; ++n) { const f32x4 r = *(const f32x4*)(R + off + bj * HALF + n * 16); *(f32x4*)(Y + off + bj * HALF + n * 16) = r * alpha + acc[ai][bj][m][n] * beta; }
                asm volatile("" ::: "memory"); }
    }
};
struct EpiMixIn {
    static constexpr bool PERM = true, AFTER_DRAIN = false, CHAIN = false;
    bf16_t* PB; size_t segstride;
    float* HF;
    bf16_t* GA; bf16_t* GB;
    const float* COS; const float* SIN;
    __device__ __forceinline__ void operator()(const f32x4 (&acc)[2][2][4][2], const Unit& u, int wr, int wc, int fr, int fq) const {
        const int seg = u.pn >> 3, row0 = u.pm * BM + wr * 64 + fr;
        if (seg < 2) {
            bf16_t* base = PB + (size_t)seg * segstride + (u.pn & 7) * 256 + (wc >> 1) * 128 + 32 * (wc & 1) + 8 * fq;
            const int d0 = 32 * (wc & 1) + 8 * fq;
#pragma unroll
            for (int ai = 0; ai < 2; ++ai) { f32x4 cs[4][4];
#pragma unroll
                for (int m = 0; m < 4; ++m) { const size_t ro = (size_t)(row0 + ai * HALF + m * 16) * 64 + d0;
                    cs[m][0] = *(const f32x4*)(COS + ro); cs[m][1] = *(const f32x4*)(COS + ro + 4); cs[m][2] = *(const f32x4*)(SIN + ro); cs[m][3] = *(const f32x4*)(SIN + ro + 4); }
#pragma unroll
                for (int m = 0; m < 4; ++m) { const int row = row0 + ai * HALF + m * 16;
                    const f32x4 c0 = cs[m][0], c1 = cs[m][1], s0 = cs[m][2], s1 = cs[m][3];
                    const f32x4 x1a = acc[ai][0][m][0], x1b = acc[ai][0][m][1], x2a = acc[ai][1][m][0], x2b = acc[ai][1][m][1];
                    bf16_t* dst = base + (size_t)row * 2048;
                    *(u32x4*)dst = pack8(x1a * c0 - x2a * s0, x1b * c1 - x2b * s1);
                    *(u32x4*)(dst + 64) = pack8(x2a * c0 + x1a * s0, x2b * c1 + x1b * s1); }
                asm volatile("" ::: "memory"); }
        } else if (seg == 4) {
            float* base = HF + (u.pn & 7) * 256 + wc * 32 + 8 * fq;
#pragma unroll
            for (int ai = 0; ai < 2; ++ai)
#pragma unroll
                for (int m = 0; m < 4; ++m) { float* dst = base + (size_t)(row0 + ai * HALF + m * 16) * 2048;
#pragma unroll
                    for (int bj = 0; bj < 2; ++bj) { *(f32x4*)(dst + bj * HALF) = acc[ai][bj][m][0]; *(f32x4*)(dst + bj * HALF + 4) = acc[ai][bj][m][1]; } }
        } else if (seg >= 7) {
            bf16_t* base = (seg >= 9 ? GB + (u.pn - 72) * 256 : GA + (u.pn - 56) * 256) + wc * 32 + 8 * fq;
#pragma unroll
            for (int ai = 0; ai < 2; ++ai)
#pragma unroll
                for (int m = 0; m < 4; ++m) { bf16_t* dst = base + (size_t)(row0 + ai * HALF + m * 16) * 4096;
#pragma unroll
                    for (int bj = 0; bj < 2; ++bj) *(u32x4*)(dst + bj * HALF) = pack8(sigm4(acc[ai][bj][m][0]), sigm4(acc[ai][bj][m][1])); }
        } else {
            const int slot = seg <= 3 ? seg : seg - 1;
            bf16_t* base = PB + (size_t)slot * segstride + (u.pn & 7) * 256 + wc * 32 + 8 * fq;
#pragma unroll
            for (int ai = 0; ai < 2; ++ai)
#pragma unroll
                for (int m = 0; m < 4; ++m) { bf16_t* dst = base + (size_t)(row0 + ai * HALF + m * 16) * 2048;
#pragma unroll
                    for (int bj = 0; bj < 2; ++bj) *(u32x4*)(dst + bj * HALF) = pack8(acc[ai][bj][m][0], acc[ai][bj][m][1]); }
        }
    }
};

struct EpiMerge {
    static constexpr bool PERM = true, AFTER_DRAIN = false, CHAIN = true;
    const bf16_t* GA; const bf16_t* GB; bf16_t* O; int ldc;
    __device__ __forceinline__ void mid(f32x4 (&acc)[2][2][4][2], const Unit& u, int wr, int wc, int fr, int fq) const {
        const int row0 = u.pm * BM + wr * 64 + fr, col0 = u.pn * BM + wc * 32 + 8 * fq;
#pragma unroll
        for (int ai = 0; ai < 2; ++ai)
#pragma unroll
            for (int m = 0; m < 4; ++m) { const size_t off = (size_t)(row0 + ai * HALF + m * 16) * ldc + col0;
#pragma unroll
                for (int bj = 0; bj < 2; ++bj) { const u32x4 ga = *(const u32x4*)(GA + off + bj * HALF), gb = *(const u32x4*)(GB + off + bj * HALF);
                    const f32x4 b0 = bf_lo4(gb), b1 = bf_hi4(gb);
                    const f32x4 r0 = bf_lo4(ga) * (f32x4){__builtin_amdgcn_rcpf(fmaxf(b0[0], 1e-30f)), __builtin_amdgcn_rcpf(fmaxf(b0[1], 1e-30f)), __builtin_amdgcn_rcpf(fmaxf(b0[2], 1e-30f)), __builtin_amdgcn_rcpf(fmaxf(b0[3], 1e-30f))};
                    const f32x4 r1 = bf_hi4(ga) * (f32x4){__builtin_amdgcn_rcpf(fmaxf(b1[0], 1e-30f)), __builtin_amdgcn_rcpf(fmaxf(b1[1], 1e-30f)), __builtin_amdgcn_rcpf(fmaxf(b1[2], 1e-30f)), __builtin_amdgcn_rcpf(fmaxf(b1[3], 1e-30f))};
                    acc[ai][bj][m][0] = acc[ai][bj][m][0] * r0; acc[ai][bj][m][1] = acc[ai][bj][m][1] * r1; } }
    }
    __device__ __forceinline__ void operator()(const f32x4 (&acc)[2][2][4][2], const Unit& u, int wr, int wc, int fr, int fq) const {
        const int row0 = u.pm * BM + wr * 64 + fr, col0 = u.pn * BM + wc * 32 + 8 * fq;
#pragma unroll
        for (int ai = 0; ai < 2; ++ai)
#pragma unroll
            for (int m = 0; m < 4; ++m) { const size_t off = (size_t)(row0 + ai * HALF + m * 16) * ldc + col0;
#pragma unroll
                for (int bj = 0; bj < 2; ++bj) { const u32x4 gb = *(const u32x4*)(GB + off + bj * HALF);
                    *(u32x4*)(O + off + bj * HALF) = pack8(bf_lo4(gb) * acc[ai][bj][m][0], bf_hi4(gb) * acc[ai][bj][m][1]); } }
    }
};
struct EpiF32Part {
    static constexpr bool PERM = false, AFTER_DRAIN = false, CHAIN = false;
    float* P; int ldc; int kslice; size_t slice_stride;
    __device__ __forceinline__ void operator()(const f32x4 (&acc)[2][2][4][2], const Unit& u, int wr, int wc, int fr, int fq) const {
        const int row0 = u.pm * BM + wr * 64 + fr, col0 = u.pn * BM + wc * 32 + 4 * fq; float* base = P + (size_t)(u.ko / kslice) * slice_stride;
#pragma unroll
        for (int ai = 0; ai < 2; ++ai)
#pragma unroll
            for (int m = 0; m < 4; ++m) { float* rowp = base + (size_t)(row0 + ai * HALF + m * 16) * ldc + col0;
#pragma unroll
                for (int bj = 0; bj < 2; ++bj)
#pragma unroll
                    for (int n = 0; n < 2; ++n) *(f32x4*)(rowp + bj * HALF + n * 16) = acc[ai][bj][m][n]; }
    }
};
struct EpiResLN {
    static constexpr bool PERM = false, AFTER_DRAIN = false, CHAIN = false;
    const float* Yp; const float* ST; const float* G; const float* B; float* Y; int ldc; float alpha, beta;
    __device__ __forceinline__ void operator()(const f32x4 (&acc)[2][2][4][2], const Unit& u, int wr, int wc, int fr, int fq) const {
        const int row0 = u.pm * BM + wr * 64 + fr, col0 = u.pn * BM + wc * 32 + 4 * fq;
        f32x4 g4[2][2], b4[2][2];
#pragma unroll
        for (int bj = 0; bj < 2; ++bj)
#pragma unroll
            for (int n = 0; n < 2; ++n) { g4[bj][n] = *(const f32x4*)(G + col0 + bj * HALF + n * 16); b4[bj][n] = *(const f32x4*)(B + col0 + bj * HALF + n * 16); }
#pragma unroll
        for (int ai = 0; ai < 2; ++ai)
#pragma unroll
            for (int m = 0; m < 4; ++m) { const int row = row0 + ai * HALF + m * 16; const size_t off = (size_t)row * ldc + col0;
                const float mean = ST[2 * row], rstd = ST[2 * row + 1];
#pragma unroll
                for (int bj = 0; bj < 2; ++bj)
#pragma unroll
                    for (int n = 0; n < 2; ++n) { const f32x4 yp = *(const f32x4*)(Yp + off + bj * HALF + n * 16);
                        const f32x4 x = (yp - mean) * rstd * g4[bj][n] + b4[bj][n];
                        *(f32x4*)(Y + off + bj * HALF + n * 16) = x * alpha + acc[ai][bj][m][n] * beta; }
                asm volatile("" ::: "memory"); }
    }
};
template <class Epi, class Sched, bool ALIGN_EPI = false, bool SP2 = false>
__device__ __forceinline__ void gemm_phase(PG8_LAS unsigned char* lds, const Gemm g, const Sched& S, const Epi& E, const int wid) {
    const int lane = mk_lane(), tid = wid * 64 + lane, wr = wid >> 2, wc = wid & 3, fr = lane & 15, fq = lane >> 4;
    const int K = g.K, LD = g.ld, nt = K / BK;
    unsigned voffA[2], voffB[2];
#pragma unroll
    for (int i = 0; i < 2; ++i) { int R, C; stage_rc(tid * 16 + i * 8192, R, C); const int Rb = Epi::PERM ? ((R & ~31) + perm32(R & 31)) : R;
        voffA[i] = (unsigned)(R * LD + C) * 2u; voffB[i] = (unsigned)(Rb * LD + C) * 2u; }
    const size_t kstep = (size_t)(BK * 2);
    const size_t hstep = (size_t)HALF * LD * 2;
    const size_t tstep = 2 * hstep;
    const unsigned ldsw = (unsigned)wid * 1024u;
    const int aoff = lds_byte(wr * 64 + fr, fq * 8), boff = lds_byte(wc * 32 + fr, fq * 8);
#define PG8_SA(b, h) (((b) * 2 + (h)) * HTB)
#define PG8_SB(b, h) ((4 + (b) * 2 + (h)) * HTB)
#define PG8_STAGE(bufoff, gbase, voff) do { _Pragma("unroll") for (int _i = 0; _i < 2; ++_i) \
        __builtin_amdgcn_global_load_lds((const unsigned*)((const char*)(gbase) + (voff)[_i]), (PG8_LAS unsigned*)(lds + (bufoff) + ldsw + _i * 8192), 16, 0, 0); } while (0)
#define PG8_LDA(dst, b, h) do { _Pragma("unroll") for (int m = 0; m < 4; ++m) _Pragma("unroll") for (int k = 0; k < 2; ++k) dst[m][k] = *(const PG8_LAS bf16x8*)(lds + PG8_SA(b, h) + aoff + m * 2048 + k * 1024); } while (0)
#define PG8_LDB(dst, b, h) do { _Pragma("unroll") for (int n = 0; n < 2; ++n) _Pragma("unroll") for (int k = 0; k < 2; ++k) dst[n][k] = *(const PG8_LAS bf16x8*)(lds + PG8_SB(b, h) + boff + n * 2048 + k * 1024); } while (0)
#define PG8_MMA(ai, bj, At, Bt) do { __builtin_amdgcn_s_setprio(1); _Pragma("unroll") for (int m = 0; m < 4; ++m) _Pragma("unroll") for (int n = 0; n < 2; ++n) _Pragma("unroll") for (int k = 0; k < 2; ++k) \
        acc[ai][bj][m][n] = __builtin_amdgcn_mfma_f32_16x16x32_bf16(Bt[n][k], At[m][k], acc[ai][bj][m][n], 0, 0, 0); __builtin_amdgcn_s_setprio(0); } while (0)
#define PG8_WAIT_V(n) asm volatile("s_waitcnt vmcnt(" #n ")" ::: "memory")
#define PG8_WAIT_L(n) asm volatile("s_waitcnt lgkmcnt(" #n ")" ::: "memory")
#define PG8_BAR __builtin_amdgcn_s_barrier()
#define PG8_SCHED __builtin_amdgcn_sched_barrier(0)
    Unit cur, nxt; int ui = 0;
    if (!S.next(0, cur)) return;
    f32x4 acc[2][2][4][2];
#pragma unroll
    for (int a = 0; a < 2; ++a)
#pragma unroll
        for (int b = 0; b < 2; ++b)
#pragma unroll
            for (int m = 0; m < 4; ++m)
#pragma unroll
                for (int n = 0; n < 2; ++n) acc[a][b][m][n] = (f32x4){0.f, 0.f, 0.f, 0.f};
    bf16x8 At[4][2], B0[2][2], B1[2][2];
#define PG8_UA(u) ((const char*)((u).seg ? g.A2 : g.A) + (size_t)(u).pm * tstep + (size_t)(u).ko * 2)
#define PG8_UB(u) ((const char*)((u).seg ? g.Bt2 : g.Bt) + (size_t)(u).pn * tstep + (size_t)(u).ko * 2)
    const char* cA = PG8_UA(cur); const char* cB = PG8_UB(cur);
    S.a_ready(cur);
    if constexpr (SP2) {
        PG8_STAGE(PG8_SB(0, 0), cB, voffB); PG8_STAGE(PG8_SB(0, 1), cB + hstep, voffB); PG8_STAGE(PG8_SA(0, 0), cA, voffA); PG8_STAGE(PG8_SA(0, 1), cA + hstep, voffA);
        if (wr == 1) PG8_BAR;
        PG8_WAIT_V(2); PG8_BAR;
        PG8_STAGE(PG8_SB(1, 0), cB + kstep, voffB); PG8_STAGE(PG8_SA(1, 0), cA + kstep, voffA); PG8_STAGE(PG8_SB(1, 1), cB + hstep + kstep, voffB);
        PG8_WAIT_V(6); PG8_BAR;
    } else {
        PG8_STAGE(PG8_SB(0, 0), cB, voffB); PG8_STAGE(PG8_SA(0, 0), cA, voffA); PG8_STAGE(PG8_SB(0, 1), cB + hstep, voffB); PG8_STAGE(PG8_SA(0, 1), cA + hstep, voffA);
        if (wr == 1) PG8_BAR;
        PG8_WAIT_V(4); PG8_BAR;
        PG8_STAGE(PG8_SB(1, 0), cB + kstep, voffB); PG8_STAGE(PG8_SA(1, 0), cA + kstep, voffA); PG8_STAGE(PG8_SB(1, 1), cB + hstep + kstep, voffB);
        PG8_WAIT_V(6); PG8_BAR;
    }
    for (;;) {
        const bool has_next = S.next(ui + 1, nxt);
        const char* nA = has_next ? PG8_UA(nxt) : cA; const char* nB = has_next ? PG8_UB(nxt) : cB;
        for (int t = 0; t < nt; t += 2) {
            const bool last = (t == nt - 2);
            const char* a1 = cA + (size_t)(t + 1) * kstep;
            const char* a2 = last ? nA : cA + (size_t)(t + 2) * kstep; const char* b2 = last ? nB : cB + (size_t)(t + 2) * kstep;
            const char* a3 = a2 + kstep; const char* b3 = b2 + kstep;
            if (last && has_next) S.a_ready(nxt);
            if constexpr (SP2) {
            PG8_LDB(B0, 0, 0); PG8_LDB(B1, 0, 1); PG8_SCHED; PG8_LDA(At, 0, 0); PG8_STAGE(PG8_SA(1, 1), a1 + hstep, voffA);
            PG8_WAIT_V(8); PG8_WAIT_L(0); PG8_BAR; PG8_MMA(0, 0, At, B0); PG8_MMA(0, 1, At, B1); PG8_BAR; PG8_SCHED;
            PG8_LDA(At, 0, 1); PG8_STAGE(PG8_SB(0, 0), b2, voffB); PG8_STAGE(PG8_SB(0, 1), b2 + hstep, voffB); PG8_STAGE(PG8_SA(0, 0), a2, voffA);
            PG8_WAIT_V(8); PG8_WAIT_L(0); PG8_BAR; PG8_MMA(1, 0, At, B0); PG8_MMA(1, 1, At, B1); PG8_BAR; PG8_SCHED;
            PG8_LDB(B0, 1, 0); PG8_LDB(B1, 1, 1); PG8_SCHED; PG8_LDA(At, 1, 0); PG8_STAGE(PG8_SA(0, 1), a2 + hstep, voffA);
            PG8_WAIT_V(8); PG8_WAIT_L(0); PG8_BAR; PG8_MMA(0, 0, At, B0); PG8_MMA(0, 1, At, B1); PG8_BAR; PG8_SCHED;
            PG8_LDA(At, 1, 1); PG8_STAGE(PG8_SB(1, 0), b3, voffB); PG8_STAGE(PG8_SB(1, 1), b3 + hstep, voffB); PG8_STAGE(PG8_SA(1, 0), a3, voffA);
            PG8_WAIT_V(8); PG8_WAIT_L(0); PG8_BAR; PG8_MMA(1, 0, At, B0); PG8_MMA(1, 1, At, B1); PG8_BAR; PG8_SCHED;
            } else {
            PG8_LDB(B0, 0, 0); PG8_SCHED; PG8_LDA(At, 0, 0); PG8_STAGE(PG8_SA(1, 1), a1 + hstep, voffA);
            PG8_WAIT_L(8); PG8_BAR; PG8_WAIT_L(0); PG8_MMA(0, 0, At, B0); PG8_BAR; PG8_SCHED;
            PG8_LDB(B1, 0, 1); PG8_STAGE(PG8_SB(0, 0), b2, voffB);
            PG8_BAR; PG8_WAIT_L(0); PG8_MMA(0, 1, At, B1); PG8_BAR;
            PG8_LDA(At, 0, 1); PG8_STAGE(PG8_SA(0, 0), a2, voffA);
            PG8_BAR; PG8_WAIT_L(0); PG8_MMA(1, 0, At, B0); PG8_BAR; PG8_SCHED;
            PG8_STAGE(PG8_SB(0, 1), b2 + hstep, voffB);
            PG8_WAIT_V(6); PG8_BAR; PG8_MMA(1, 1, At, B1); PG8_BAR;
            PG8_LDB(B0, 1, 0); PG8_SCHED; PG8_LDA(At, 1, 0); PG8_STAGE(PG8_SA(0, 1), a2 + hstep, voffA);
            PG8_WAIT_L(8); PG8_BAR; PG8_WAIT_L(0); PG8_MMA(0, 0, At, B0); PG8_BAR; PG8_SCHED;
            PG8_LDB(B1, 1, 1); PG8_STAGE(PG8_SB(1, 0), b3, voffB);
            PG8_BAR; PG8_WAIT_L(0); PG8_MMA(0, 1, At, B1); PG8_BAR;
            PG8_LDA(At, 1, 1); PG8_STAGE(PG8_SA(1, 0), a3, voffA);
            PG8_BAR; PG8_WAIT_L(0); PG8_MMA(1, 0, At, B0); PG8_BAR; PG8_SCHED;
            PG8_STAGE(PG8_SB(1, 1), b3 + hstep, voffB);
            PG8_WAIT_V(6); PG8_BAR; PG8_MMA(1, 1, At, B1); PG8_BAR;
            }
        }
        if constexpr (ALIGN_EPI) { if (wr == 0) PG8_BAR; }
        bool keep_acc = false;
        if constexpr (Epi::CHAIN) { if (cur.seg == 0) { E.mid(acc, cur, wr, wc, fr, fq); keep_acc = true; } else E(acc, cur, wr, wc, fr, fq); }
        else if constexpr (!Epi::AFTER_DRAIN) { E(acc, cur, wr, wc, fr, fq); S.done(cur); }
        if (!has_next) break;
        if (!keep_acc) {
#pragma unroll
        for (int a = 0; a < 2; ++a)
#pragma unroll
            for (int b = 0; b < 2; ++b)
#pragma unroll
                for (int m = 0; m < 4; ++m)
#pragma unroll
                    for (int n = 0; n < 2; ++n) acc[a][b][m][n] = (f32x4){0.f, 0.f, 0.f, 0.f};
        }
        cur = nxt; cA = nA; cB = nB; ++ui;
        if constexpr (ALIGN_EPI) { if (wr == 1) PG8_BAR; }
    }
    PG8_WAIT_V(0);
    if constexpr (!ALIGN_EPI) { if (wr == 0) PG8_BAR; }
    PG8_BAR;
    if constexpr (Epi::AFTER_DRAIN) { E.fused(acc, cur, wr, wc, fr, fq, lds, wid, lane); S.done(cur); }
#undef PG8_UA
#undef PG8_UB
#undef PG8_SA
#undef PG8_SB
#undef PG8_STAGE
#undef PG8_LDA
#undef PG8_LDB
#undef PG8_MMA
#undef PG8_WAIT_V
#undef PG8_WAIT_L
#undef PG8_BAR
#undef PG8_SCHED
}
}
namespace attn {
constexpr int D = 128;
constexpr float THR = 8.f;
constexpr bool WSKIP = false;
constexpr float SCALE = 0.08838834764831845f;
constexpr int NW = 8, QBLK = 32, KVBLK = 64, QB = NW * QBLK;
constexpr int SHM_V = KVBLK * D * 2, SHM_K = KVBLK * D * 2;
constexpr int LDS_BYTES = 2 * SHM_V + 2 * SHM_K + NW * 64 * 4;

typedef unsigned short bf16;
typedef short bf16x8 __attribute__((ext_vector_type(8)));
typedef short s16x4 __attribute__((ext_vector_type(4)));
typedef float f32x16 __attribute__((ext_vector_type(16)));
typedef float f32x4 __attribute__((ext_vector_type(4)));
typedef unsigned u32x4 __attribute__((ext_vector_type(4)));
template <class A, class Bt> struct same_t { static constexpr bool v = false; };
template <class A> struct same_t<A, A> { static constexpr bool v = true; };

#define KSWZ(row, colB) ((row) * 256 + ((colB) ^ (((row) & 7) << 4)))
#define SBAR() __builtin_amdgcn_sched_barrier(0)
__device__ __forceinline__ int v_st(int k, int c) { const int kk = (k & ~0xC) | ((k & 4) << 1) | ((k & 8) >> 1); return ((kk >> 3) * 4 + (c >> 5)) * 512 + ((kk & 7) * 32 + (c & 31)) * 2; }
__device__ __forceinline__ int v_rd_base(int lane) { return ((lane & 3) << 3) | (((lane >> 2) & 3) << 6) | (((lane >> 4) & 1) << 5) | (((lane >> 5) & 1) << 8); }
constexpr int v_rd_off(int d0, int ks, int half) { return d0 * 512 + ks * 4096 + half * 2048; }
__device__ __forceinline__ int crow(int r, int hi) { return (r & 3) + 8 * (r >> 2) + 4 * hi; }
__device__ __forceinline__ unsigned cvtpk(float lo, float hi) {
    unsigned r; asm volatile("v_cvt_pk_bf16_f32 %0, %1, %2" : "=v"(r) : "v"(lo), "v"(hi)); return r;
}
__device__ __forceinline__ bf16x8 pack8(f32x4 a, f32x4 b) {
    u32x4 w = {cvtpk(a[0], a[1]), cvtpk(a[2], a[3]), cvtpk(b[0], b[1]), cvtpk(b[2], b[3])};
    return *reinterpret_cast<bf16x8*>(&w);
}
template <class T> __device__ __forceinline__ bf16x8 load8(const T* p) {
    if constexpr (same_t<T, float>::v) { return pack8(*(const f32x4*)p, *(const f32x4*)(p + 4)); }
    else { return *reinterpret_cast<const bf16x8*>(p); }
}
__device__ __forceinline__ void mask_tile(f32x16& p0, f32x16& p1, int dq, unsigned W) {
    const float NEG = -__builtin_inff();
#pragma unroll
    for (int r = 0; r < 16; ++r) {
        const int c = (r & 3) + 8 * (r >> 2);
        if ((unsigned)(dq - c) >= W) p0[r] = NEG;
        if ((unsigned)(dq - c - 32) >= W) p1[r] = NEG;
    }
}
__device__ __forceinline__ void partialSM(f32x16& p0, f32x16& p1, float& m_reg, float& mn, float& alpha) {
    float pmax = p0[0]; for (int r = 1; r < 16; ++r) pmax = fmaxf(pmax, p0[r]); for (int r = 0; r < 16; ++r) pmax = fmaxf(pmax, p1[r]);
    { auto rr = __builtin_amdgcn_permlane32_swap(__float_as_uint(pmax), __float_as_uint(pmax), false, false);
      pmax = fmaxf(__uint_as_float(rr[0]), __uint_as_float(rr[1])); }
    constexpr float C2 = 1.4426950408889634f * SCALE;
    if (__builtin_expect(__all((pmax - m_reg) * SCALE <= THR), 1)) { mn = m_reg; alpha = 1.f; }
    else { mn = fmaxf(m_reg, pmax); alpha = __builtin_amdgcn_exp2f((m_reg - mn) * C2); m_reg = mn; }
    const float mnL = -mn * C2;
    for (int r = 0; r < 16; ++r) p0[r] = fmaf(p0[r], C2, mnL); for (int r = 0; r < 16; ++r) p1[r] = fmaf(p1[r], C2, mnL);
    for (int r = 0; r < 16; ++r) p0[r] = __builtin_amdgcn_exp2f(p0[r]);
}
__device__ __forceinline__ void finishSM(f32x16& p0, f32x16& p1, float alpha, float& l_reg, bf16x8& pa0, bf16x8& pa1, bf16x8& pa2, bf16x8& pa3) {
    for (int r = 0; r < 16; ++r) p1[r] = __builtin_amdgcn_exp2f(p1[r]);
    float ps = 0; for (int r = 0; r < 16; ++r) ps += p0[r]; for (int r = 0; r < 16; ++r) ps += p1[r];
    { auto rr = __builtin_amdgcn_permlane32_swap(__float_as_uint(ps), __float_as_uint(ps), false, false);
      ps = __uint_as_float(rr[0]) + __uint_as_float(rr[1]); }
    l_reg = l_reg * alpha + ps;
#define PK4(P, B_, OUT) do { unsigned a0 = cvtpk(P[B_+0], P[B_+1]), a1 = cvtpk(P[B_+2], P[B_+3]);                          \
        unsigned b0 = cvtpk(P[B_+4], P[B_+5]), b1 = cvtpk(P[B_+6], P[B_+7]);                                             \
        auto r0 = __builtin_amdgcn_permlane32_swap(a0, b0, false, false); auto r1 = __builtin_amdgcn_permlane32_swap(a1, b1, false, false); \
        u32x4 w = {r0[0], r1[0], r0[1], r1[1]}; OUT = *reinterpret_cast<bf16x8*>(&w); } while (0)
    PK4(p0, 0, pa0); PK4(p0, 8, pa1); PK4(p1, 0, pa2); PK4(p1, 8, pa3);
#undef PK4
}
template <int KB, bool SK>
__device__ __forceinline__ void qkt(f32x16& p0, f32x16& p1, const char* K_lds, int r32, int hi, const bf16x8* qr, bool act) {
    if (SK && !act) { const float NEG = -__builtin_inff();
#pragma unroll
        for (int r = 0; r < 16; ++r) { p0[r] = NEG; p1[r] = NEG; } return; }
    p0 = f32x16{}; p1 = f32x16{};
    const char* kb[4];
#pragma unroll
    for (int dd = 0; dd < 4; ++dd) kb[dd] = K_lds + KB * SHM_K + KSWZ(r32, (dd * 16 + hi * 8) * 2);
#pragma unroll
    for (int d0 = 0; d0 < 8; ++d0) { const char* a = kb[d0 & 3] + (d0 >> 2) * 128;
        bf16x8 b0 = *reinterpret_cast<const bf16x8*>(a);
        bf16x8 b1 = *reinterpret_cast<const bf16x8*>(a + 32 * 256);
        p0 = __builtin_amdgcn_mfma_f32_32x32x16_bf16(b0, qr[d0], p0, 0, 0, 0);
        p1 = __builtin_amdgcn_mfma_f32_32x32x16_bf16(b1, qr[d0], p1, 0, 0, 0); }
}
template <int VB, bool SK>
__device__ __forceinline__ void pv_tile(f32x16* o, int vb0, bf16x8 pa0, bf16x8 pa1, bf16x8 pa2, bf16x8 pa3, bool act) {
    if (SK && !act) return;
#define TRRD(dst, off) asm volatile("ds_read_b64_tr_b16 %0, %1 offset:%2" : "=&v"(dst) : "v"(vb0), "i"(off) : "memory")
#define PV_D0(d0) do { s16x4 l0, l1, l2, l3, h0, h1, h2, h3; constexpr int b_ = VB * SHM_V + v_rd_off(d0, 0, 0);     \
        TRRD(l0, b_); TRRD(h0, b_ + 2048); TRRD(l1, b_ + 4096); TRRD(h1, b_ + 6144); TRRD(l2, b_ + 8192); TRRD(h2, b_ + 10240); TRRD(l3, b_ + 12288); TRRD(h3, b_ + 14336); \
        asm volatile("s_waitcnt lgkmcnt(0)" ::: "memory"); SBAR();                 \
        o[d0] = __builtin_amdgcn_mfma_f32_32x32x16_bf16(pa0, (bf16x8){l0[0], l0[1], l0[2], l0[3], h0[0], h0[1], h0[2], h0[3]}, o[d0], 0, 0, 0);   \
        o[d0] = __builtin_amdgcn_mfma_f32_32x32x16_bf16(pa1, (bf16x8){l1[0], l1[1], l1[2], l1[3], h1[0], h1[1], h1[2], h1[3]}, o[d0], 0, 0, 0);   \
        o[d0] = __builtin_amdgcn_mfma_f32_32x32x16_bf16(pa2, (bf16x8){l2[0], l2[1], l2[2], l2[3], h2[0], h2[1], h2[2], h2[3]}, o[d0], 0, 0, 0);   \
        o[d0] = __builtin_amdgcn_mfma_f32_32x32x16_bf16(pa3, (bf16x8){l3[0], l3[1], l3[2], l3[3], h3[0], h3[1], h3[2], h3[3]}, o[d0], 0, 0, 0); } while (0)
    PV_D0(0); PV_D0(1); PV_D0(2); PV_D0(3);
#undef PV_D0
#undef TRRD
}

template <class TIn, class TOut> struct BlockRef { const TIn* Q; const TIn* K; const TIn* V; TOut* O; int P0; };
template <class TIn> struct Seam {
    bf16x8 qr[8];
    bf16x8 st_v0, st_v1, st_k0, st_k1; f32x4 sf0, sf1, sf2, sf3;
    f32x4 tq[16];
};
__device__ __forceinline__ int swa_jlo(int P0, int W) { const int lowk = P0 - W + 1; return lowk > 0 ? lowk / KVBLK : 0; }
#define ROW(p, k0, rr) ((p) + (size_t)((k0) + (rr)) * KS + sc)
#define VMW() asm volatile("s_waitcnt vmcnt(0)" ::: "memory")
#define VMWN(n) asm volatile("s_waitcnt vmcnt(%0)" :: "i"(n) : "memory")
#define SLOAD_H(Kp, Vp, k0) do { S.st_v0 = load8<TIn>(ROW(Vp, k0, sr)); S.st_v1 = load8<TIn>(ROW(Vp, k0, 32 + sr));              \
                         S.st_k0 = load8<TIn>(ROW(Kp, k0, sr)); S.st_k1 = load8<TIn>(ROW(Kp, k0, 32 + sr)); } while (0)
#define SWRITE_HK(bf) do { *(bf16x8*)(K_lds + (bf) * SHM_K + kws) = S.st_k0; *(bf16x8*)(K_lds + (bf) * SHM_K + kws + 32 * 256) = S.st_k1; } while (0)
#define SWRITE_HV(bf) do { *(bf16x8*)(V_lds + (bf) * SHM_V + vst0) = S.st_v0; *(bf16x8*)(V_lds + (bf) * SHM_V + vst1) = S.st_v1; } while (0)
#define SWRITE_H(bf) do { SWRITE_HV(bf); SWRITE_HK(bf); } while (0)
#define SLOAD_F(p, k0) do { S.sf0 = *(const f32x4*)ROW(p, k0, sr); S.sf1 = *(const f32x4*)(ROW(p, k0, sr) + 4);                \
                            S.sf2 = *(const f32x4*)ROW(p, k0, 32 + sr); S.sf3 = *(const f32x4*)(ROW(p, k0, 32 + sr) + 4); } while (0)
#define SWRITE_KF(bf) do { *(bf16x8*)(K_lds + (bf) * SHM_K + kws) = pack8(S.sf0, S.sf1); *(bf16x8*)(K_lds + (bf) * SHM_K + kws + 32 * 256) = pack8(S.sf2, S.sf3); } while (0)
#define SWRITE_VF(bf) do { *(bf16x8*)(V_lds + (bf) * SHM_V + vst0) = pack8(S.sf0, S.sf1); *(bf16x8*)(V_lds + (bf) * SHM_V + vst1) = pack8(S.sf2, S.sf3); } while (0)
template <class TIn, class TOut, int QS, int KS, int OS>
__device__ __forceinline__ void causal_swa_prime(const BlockRef<TIn, TOut>& cur, int W, char* lds, Seam<TIn>& S, const int wid) {
    constexpr bool F32 = same_t<TIn, float>::v;
    const int lane = mk_lane(), tid = wid * 64 + lane, r32 = lane & 31, hi = lane >> 5;
    const int sr = tid >> 4, sc = (tid & 15) * 8, kws = KSWZ(sr, sc * 2); char* K_lds = lds + 2 * SHM_V;
    const int kb0 = swa_jlo(cur.P0, W) * KVBLK;
    for (int d0 = 0; d0 < 8; ++d0) S.qr[d0] = load8<TIn>(cur.Q + (size_t)(wid * QBLK + r32) * QS + d0 * 16 + hi * 8);
    if constexpr (F32) { SLOAD_F((const float*)cur.K, kb0); VMW(); SWRITE_KF(0); SBAR(); SLOAD_F((const float*)cur.V, kb0); }
    else { SLOAD_H(cur.K, cur.V, kb0); VMW(); SWRITE_HK(0); }
    __syncthreads();
}
template <class TIn, class TOut, int QS, int KS, int OS>
__device__ __forceinline__ void causal_swa_block(const BlockRef<TIn, TOut>& cur, const BlockRef<TIn, TOut>& nxt, int skv, int W, char* lds, Seam<TIn>& S, const int wid) {
    constexpr bool F32 = same_t<TIn, float>::v;
    const int lane = mk_lane(), tid = wid * 64 + lane, r32 = lane & 31, hi = lane >> 5;
    const int j_lo = swa_jlo(cur.P0, W);
    int j_hi = (cur.P0 + QB - 1) / KVBLK + 1; if (j_hi > skv / KVBLK) j_hi = skv / KVBLK;
    const int NT = j_hi - j_lo;
    const int kbn = swa_jlo(nxt.P0, W) * KVBLK;
    const int qlo = cur.P0 + wid * QBLK, qm = qlo + r32 - 4 * hi;
    char* V_lds = lds; char* K_lds = lds + 2 * SHM_V;
    float* ws = (float*)(lds + 2 * SHM_V + 2 * SHM_K) + wid * 64; float* li_l = ws, * al_l = ws + 32;
    float m_reg = -1e30f, l_reg = 0; f32x16 o[4] = {};
    const int sr = tid >> 4, sc = (tid & 15) * 8, vst0 = v_st(sr, sc), vst1 = v_st(32 + sr, sc), kws = KSWZ(sr, sc * 2);
    const int vb0 = (int)(uintptr_t)V_lds + v_rd_base(lane);
    const TIn* Kh = cur.K; const TIn* Vh = cur.V;
#define RESC(a) do { if (__any((a) < 1.f)) { if (hi == 0) al_l[r32] = (a); asm volatile("s_waitcnt lgkmcnt(0)" ::: "memory");              \
                     for (int d_ = 0; d_ < 4; ++d_) for (int r = 0; r < 16; ++r) o[d_][r] *= al_l[crow(r, hi)]; } } while (0)
#define KBASE(t) ((j_lo + (t)) * KVBLK)
#define ACT(t) (KBASE(t) <= qlo + QBLK - 1 && KBASE(t) + KVBLK - 1 >= qlo - W + 1)
#define MASKT(P0_, P1_, t) do { const int kb_ = KBASE(t); if ((!SK || ACT(t)) && (kb_ + KVBLK - 1 > qlo || kb_ <= qlo + QBLK - 1 - W)) mask_tile(P0_, P1_, qm - kb_, (unsigned)W); } while (0)
    constexpr int NQL = F32 ? 16 : 8;
    constexpr bool SK = WSKIP && !F32;
#define SEAM_K0() do { VMWN(NQL); if constexpr (F32) { SWRITE_KF(0); SBAR(); SLOAD_F((const float*)nxt.V, kbn); } else { SWRITE_HK(0); } SBAR(); } while (0)
    f32x16 pA0, pA1, pB0, pB1; float mnA, mnB, alA, alB; bf16x8 pa0, pa1, pa2, pa3;
    if constexpr (F32) { VMW(); SWRITE_VF(0); SBAR(); } else { SWRITE_HV(0); SBAR(); }
    if (NT > 1) { if constexpr (F32) SLOAD_F((const float*)Kh, KBASE(1)); else SLOAD_H(Kh, Vh, KBASE(1)); }
    SBAR(); qkt<0, SK>(pA0, pA1, K_lds, r32, hi, S.qr, ACT(0));
    if constexpr (F32) { if (NT > 1) { VMW(); SWRITE_KF(1); SBAR(); SLOAD_F((const float*)Vh, KBASE(1)); } }
    MASKT(pA0, pA1, 0); partialSM(pA0, pA1, m_reg, mnA, alA);
    if (NT > 1) { VMW(); if constexpr (F32) { SWRITE_VF(1); SBAR(); if (NT > 2) SLOAD_F((const float*)Kh, KBASE(2)); } else SWRITE_H(1); }
    __syncthreads();
#define HALF_STEP(PX0, PX1, mnX, alX, PY0, PY1, alY, t, KB, VB, SB) do {                                                      \
        SBAR(); qkt<KB, SK>(PX0, PX1, K_lds, r32, hi, S.qr, ACT(t));                                             \
        finishSM(PY0, PY1, alY, l_reg, pa0, pa1, pa2, pa3); SBAR();                                                           \
        if ((t) + 1 < NT) { if constexpr (F32) { VMW(); SWRITE_KF(SB); SBAR(); SLOAD_F((const float*)Vh, KBASE((t) + 1)); }  \
                            else { SLOAD_H(Kh, Vh, KBASE((t) + 1)); } SBAR(); }                                               \
        pv_tile<VB, SK>(o, vb0, pa0, pa1, pa2, pa3, ACT((t) - 1)); MASKT(PX0, PX1, (t)); partialSM(PX0, PX1, m_reg, mnX, alX);                                        \
        __syncthreads();                                                                                                      \
        if ((t) + 1 < NT) { VMW(); if constexpr (F32) { SWRITE_VF(SB); SBAR(); if ((t) + 2 < NT) SLOAD_F((const float*)Kh, KBASE((t) + 2)); } \
                            else { SWRITE_H(SB); } }                                                                          \
        RESC(alX); __syncthreads(); } while (0)
    for (int t = 1; t + 1 < NT; t += 2) {
        HALF_STEP(pB0, pB1, mnB, alB, pA0, pA1, alA, t, 1, 0, 0);
        HALF_STEP(pA0, pA1, mnA, alA, pB0, pB1, alB, t + 1, 0, 1, 1);
    }
    const bool even = (NT & 1) == 0;
    if (even) { SBAR(); qkt<1, SK>(pB0, pB1, K_lds, r32, hi, S.qr, ACT(NT - 1)); SBAR(); }
#define QROW(e) (nxt.Q + (size_t)(wid * QBLK + r32) * QS + ((e) >> 1) * 16 + hi * 8 + ((e) & 1) * 4)
    if constexpr (F32) { SLOAD_F((const float*)nxt.K, kbn); SBAR();
#pragma unroll
        for (int e = 0; e < 8; ++e) S.tq[e] = *(const f32x4*)QROW(e); }
    else { SLOAD_H(nxt.K, nxt.V, kbn); SBAR();
#pragma unroll
        for (int d0 = 0; d0 < 8; ++d0) S.qr[d0] = load8<TIn>(nxt.Q + (size_t)(wid * QBLK + r32) * QS + d0 * 16 + hi * 8); }
    SBAR();
    finishSM(pA0, pA1, alA, l_reg, pa0, pa1, pa2, pa3); SBAR();
    if constexpr (F32) {
#pragma unroll
        for (int e = 8; e < 16; ++e) S.tq[e] = *(const f32x4*)QROW(e); SBAR(); }
#undef QROW
    pv_tile<0, SK>(o, vb0, pa0, pa1, pa2, pa3, ACT(even ? NT - 2 : NT - 1));
    if (even) { MASKT(pB0, pB1, NT - 1); partialSM(pB0, pB1, m_reg, mnB, alB); __syncthreads(); RESC(alB);
        finishSM(pB0, pB1, alB, l_reg, pa0, pa1, pa2, pa3); SBAR(); pv_tile<1, SK>(o, vb0, pa0, pa1, pa2, pa3, ACT(NT - 1)); }
    SBAR(); SEAM_K0();
    if (hi == 0) li_l[r32] = l_reg; asm volatile("s_waitcnt lgkmcnt(0)" ::: "memory");
    float rli[16];
#pragma unroll
    for (int r = 0; r < 16; ++r) rli[r] = __builtin_amdgcn_rcpf(li_l[crow(r, hi)]);
    TOut* Ow = cur.O + (size_t)(wid * QBLK) * OS;
#pragma unroll
    for (int r = 0; r < 16; ++r) { const int orow = crow(r, hi);
#pragma unroll
        for (int d0 = 0; d0 < 4; ++d0) { const float v = o[d0][r] * rli[r];
            if constexpr (same_t<TOut, float>::v) { Ow[(size_t)orow * OS + d0 * 32 + r32] = v; }
            else { const float vn = __shfl_xor(v, 1);
                   if ((r32 & 1) == 0) *(unsigned*)(Ow + (size_t)orow * OS + d0 * 32 + r32) = cvtpk(v, vn); } } }
    if constexpr (F32) {
#pragma unroll
        for (int d0 = 0; d0 < 8; ++d0) S.qr[d0] = pack8(S.tq[2 * d0], S.tq[2 * d0 + 1]); }
    __syncthreads();
#undef RESC
#undef KBASE
#undef ACT
#undef MASKT
#undef SEAM_K0
#undef HALF_STEP
}
#undef ROW
#undef VMW
#undef VMWN
#undef SLOAD_H
#undef SWRITE_HK
#undef SWRITE_HV
#undef SWRITE_H
#undef SLOAD_F
#undef SWRITE_KF
#undef SWRITE_VF
}
constexpr int NWAVES = 8;
#ifndef MK_N_LAUNCHES
#define MK_N_LAUNCHES 1
#endif
constexpr int NPHASES = 18;
constexpr int N_LAUNCHES = MK_N_LAUNCHES;
static_assert(N_LAUNCHES == 1 || N_LAUNCHES == NPHASES, "MK_N_LAUNCHES: 1 or NPHASES");

constexpr int SEQ = 8192, DM = 4096, DFF = 11008, NMIX = 22528, MEM = 256;
constexpr int DAW = 2048, HGW = 2048, XAW = 512;
constexpr float LN_EPS = 1e-5f;
constexpr int DOWN_TAIL_ITEMS = 22016;
constexpr float DN_ALPHA = 1.189207115002721f;
constexpr float LAMBDA_INIT = 0.2f;
constexpr size_t MiB = 1u << 20;
constexpr size_t WS_CTL = 0, CTL_ZERO_BYTES = 1 * MiB;
constexpr size_t WS_LB = 1 * MiB;
constexpr size_t WS_LAM = WS_LB + 8192;
constexpr size_t WS_ST = WS_LB + 65536;
constexpr size_t WS_COS = 2 * MiB, WS_SIN = 4 * MiB;
constexpr size_t WS_DEC = 6 * MiB;
constexpr size_t WS_XKV = 7 * MiB;
constexpr size_t WS_MEMB = 8 * MiB;
constexpr size_t WS_XO = 18 * MiB;
constexpr size_t WS_WXQ = 26 * MiB, WS_WXKV = 30 * MiB, WS_WXO = 38 * MiB, WS_WDA = 42 * MiB, WS_WHG = 58 * MiB, WS_WMO = 74 * MiB, WS_WMI = 106 * MiB, WS_W2A = 282 * MiB, WS_W2D = 454 * MiB;
constexpr size_t WS_R1 = 540 * MiB;
constexpr size_t WS_W1A = WS_R1, WS_W1D = WS_R1 + 172 * MiB;
constexpr size_t WS_PB = WS_R1, PB_SEG = 32 * MiB;
constexpr size_t WS_HF = WS_R1 + 192 * MiB;
constexpr size_t WS_XB = 798 * MiB;
constexpr size_t WS_Y = 862 * MiB;
constexpr size_t WS_XF = 990 * MiB;
constexpr size_t WS_H = 1118 * MiB;
constexpr size_t WS_SLT = WS_H;
constexpr size_t WS_GA = 1290 * MiB, WS_GB = 1354 * MiB;
constexpr size_t WS_O1 = 1418 * MiB, WS_O2 = 1482 * MiB;
constexpr size_t WS_XQP = WS_O2;
constexpr size_t WS_OA = 1546 * MiB, WS_OB = 1578 * MiB;
constexpr size_t WS_END = 1610 * MiB;
static_assert(WS_W1D + (size_t)DM * DFF * 2 <= WS_XB && WS_HF + (size_t)SEQ * 2048 * 4 <= WS_XB && WS_H + (size_t)SEQ * DFF * 2 <= WS_GA && WS_W2D + (size_t)DM * DFF * 2 <= WS_R1 && WS_WMI + (size_t)NMIX * DM * 2 <= WS_W2A && WS_W2A + (size_t)2 * DFF * DM * 2 <= WS_W2D, "d_ws map");
constexpr int CW_TMO = 0, CW_CODE = 1;
constexpr int CW_BAR = 4096;
constexpr int RING_OFF = 0, RING_BYTES = 131072;
constexpr int LDSCTL_OFF = RING_BYTES, MISC_OFF = LDSCTL_OFF + 320;
constexpr int LDS_BYTES = 147456;
constexpr int HG_KT = 0, HG_VT = 18432, HG_QD = 36864, HG_KD = 54272, HG_ST = 71680, HG_TOT = 106496, HG_ER = 108544, HG_SS = 109056;

#define GAS __attribute__((address_space(1)))
#define LAS __attribute__((address_space(3)))
typedef unsigned short bf16;
typedef unsigned v4u __attribute__((ext_vector_type(4)));
typedef unsigned v2u __attribute__((ext_vector_type(2)));
typedef float f32x4 __attribute__((ext_vector_type(4)));
typedef float f32x2 __attribute__((ext_vector_type(2)));
typedef short bf16x8 __attribute__((ext_vector_type(8)));
typedef short s16x4 __attribute__((ext_vector_type(4)));
typedef GAS unsigned gu32;
#define RLX_AGENT __ATOMIC_RELAXED, __HIP_MEMORY_SCOPE_AGENT
#define LDS_WAIT() asm volatile("s_waitcnt lgkmcnt(0)" ::: "memory")
#define VM_WAIT() asm volatile("s_waitcnt vmcnt(0)" ::: "memory")
__device__ __forceinline__ unsigned f2bf(float f) { unsigned u = __builtin_bit_cast(unsigned, f); return (u + 0x7fffu + ((u >> 16) & 1u)) >> 16; }
__device__ __forceinline__ unsigned pk2(float lo, float hi) { return f2bf(lo) | (f2bf(hi) << 16); }
__device__ __forceinline__ float bf2f(unsigned short b) { return __uint_as_float(((unsigned)b) << 16); }

#define XB_TMO      128
#define XB_XCNT(j)  (256  + 64 * (j))
#define XB_XSUB(j)  (1280 + 64 * (j))
#define XB_XGEN(j)  (2304 + 64 * (j))
#define XB_TOP      3328
#define XB_TOPGEN   3392
#define XCD_BAR_WORDS 3456
#define XB_SPIN_CAP (1u << 18)

__device__ __forceinline__ unsigned xb_ld(unsigned* p)              { return __hip_atomic_load(p, __ATOMIC_RELAXED, __HIP_MEMORY_SCOPE_AGENT); }
__device__ __forceinline__ unsigned xb_add(unsigned* p, unsigned v) { return __hip_atomic_fetch_add(p, v, __ATOMIC_RELAXED, __HIP_MEMORY_SCOPE_AGENT); }
__device__ __forceinline__ unsigned xb_xcc_id() { return (unsigned)__builtin_amdgcn_s_getreg((3 << 11) | 20) & 0xFu; }
#define XB_SPIN(cond, bar) do { unsigned _sp = 0; while (cond) { __builtin_amdgcn_s_sleep(1); \
    if ((++_sp & 255u) == 0u) { if (xb_ld(&(bar)[XB_TMO])) break; if (_sp > XB_SPIN_CAP) { atomicAdd(&(bar)[XB_TMO], 1u); break; } } } } while (0)

struct XcdBarrier {
    unsigned* bar; unsigned x;
    volatile LAS unsigned* st;
};

__device__ __forceinline__ XcdBarrier xcd_barrier_post(unsigned* bar, volatile LAS unsigned* st, const bool t0  ) {
    XcdBarrier b; b.bar = bar; b.x = xb_xcc_id(); b.st = st;
    if (t0) (void)xb_add(&bar[XB_XCNT(b.x)], 1u);
    return b;
}
__device__ __forceinline__ void xcd_barrier_complete(unsigned* bar, unsigned x, unsigned& nloc, unsigned& nx) {
    const unsigned G = gridDim.x * gridDim.y * gridDim.z;
    unsigned sum, cnt, mine, sp = 0u;
    for (;;) {
        sum = 0u; cnt = 0u; mine = 0u;
#pragma unroll
        for (unsigned j = 0; j < 16; ++j) { const unsigned c = xb_ld(&bar[XB_XCNT(j)]); sum += c; cnt += (c > 0u) ? 1u : 0u; mine = (j == x) ? c : mine; }
        if (sum == G) break;
        __builtin_amdgcn_s_sleep(1);
        if ((++sp & 255u) == 0u) { if (xb_ld(&bar[XB_TMO])) break; if (sp > XB_SPIN_CAP) { atomicAdd(&bar[XB_TMO], 1u); break; } }
    }
    nloc = mine > 0u ? mine : 1u; nx = cnt > 0u ? cnt : 1u;
}

__device__ __forceinline__ void xcd_barrier(const XcdBarrier& b, const bool t0) {
    asm volatile("s_waitcnt vmcnt(0)" ::: "memory");
    __syncthreads();
    if (t0) {
        unsigned* bar = b.bar;
        __builtin_amdgcn_s_waitcnt(0);
        unsigned nloc = b.st[0], nx = b.st[1];
        if (nloc == 0u) { xcd_barrier_complete(bar, b.x, nloc, nx); b.st[0] = nloc; b.st[1] = nx; }
        const unsigned old = xb_add(&bar[XB_XSUB(b.x)], 1u);
        const unsigned gen = old / nloc;
        if (old + 1u == (gen + 1u) * nloc) {
            __builtin_amdgcn_fence(__ATOMIC_RELEASE, "agent");
            asm volatile("s_waitcnt vmcnt(0)" ::: "memory");
            const unsigned og = xb_add(&bar[XB_TOP], 1u);
            const unsigned tg = og / nx;
            if (og + 1u == (tg + 1u) * nx) xb_add(&bar[XB_TOPGEN], 1u);
            else XB_SPIN(xb_ld(&bar[XB_TOPGEN]) == tg, bar);
            __builtin_amdgcn_fence(__ATOMIC_ACQUIRE, "agent");
            xb_add(&bar[XB_XGEN(b.x)], 1u);
            asm volatile("s_waitcnt vmcnt(0)" ::: "memory");
        } else {
            XB_SPIN(xb_ld(&bar[XB_XGEN(b.x)]) == gen, bar);
            __builtin_amdgcn_fence(__ATOMIC_ACQUIRE, "agent");
            asm volatile("s_waitcnt vmcnt(0)" ::: "memory");
        }
    }
    __syncthreads();
}

struct Args { const float* in[31]; float* out; unsigned char* ws; int ph_lo, ph_hi; };
enum InIdx { I_X = 0, I_MEM, I_F1G, I_F1U, I_F1D, I_LN1G, I_LN1B, I_MIXIN, I_LQ1, I_LK1, I_LQ2, I_LK2, I_SUBLN, I_DAUP, I_LBLOG, I_HGNORM, I_HGUP, I_MIXOUT, I_LN2G, I_LN2B,
             I_XAQ, I_XAK, I_XAV, I_XAO, I_LN3G, I_LN3B, I_F2G, I_F2U, I_F2D, I_LN4G, I_LN4B };
typedef const char __attribute__((address_space(4))) karg_c;
__device__ __forceinline__ const float* arg_in(int i) { karg_c* kp = (karg_c*)__builtin_amdgcn_kernarg_segment_ptr(); asm volatile("" : "+s"(kp)); return *(const float* const __attribute__((address_space(4)))*)(kp + 8 * i); }
__device__ __forceinline__ float* arg_out() { karg_c* kp = (karg_c*)__builtin_amdgcn_kernarg_segment_ptr(); asm volatile("" : "+s"(kp)); return *(float* const __attribute__((address_space(4)))*)(kp + 8 * 31); }
struct Frame {
    LAS unsigned char* lds;
    volatile LAS unsigned* MISC;
    gu32* ctl;
    int wave;
    int vcu, G;
};
__device__ __forceinline__ float wave_sum(float v) {
#pragma unroll
    for (int o = 1; o < 64; o <<= 1) v += __shfl_xor(v, o);
    return v;
}

__device__ __forceinline__ void p0_transpose_item(const float* W, int K, int N, bf16* WT, int k0, int n0, int drow0, LAS float* scr, int lane) {
    { f32x4 wv[8];
      const float* wp = W + (size_t)(k0 + (lane >> 3)) * N + n0 + 4 * (lane & 7);
#pragma unroll
      for (int i = 0; i < 8; ++i) wv[i] = *(const GAS f32x4*)(wp + (size_t)(8 * i) * N);
#pragma unroll
      for (int i = 0; i < 8; ++i) { LAS float* d = scr + (8 * i + (lane >> 3)) * 33 + 4 * (lane & 7); d[0] = wv[i].x; d[1] = wv[i].y; d[2] = wv[i].z; d[3] = wv[i].w; } }
    LDS_WAIT(); asm volatile("" ::: "memory");
    const int c = lane & 7;
#pragma unroll
    for (int j = 0; j < 4; ++j) { const int n = (lane >> 3) + 8 * j; const LAS float* s = scr + (8 * c) * 33 + n;
        v4u o; o.x = pk2(s[0 * 33], s[1 * 33]); o.y = pk2(s[2 * 33], s[3 * 33]); o.z = pk2(s[4 * 33], s[5 * 33]); o.w = pk2(s[6 * 33], s[7 * 33]);
        *(GAS v4u*)(WT + (size_t)(drow0 + n) * K + k0 + 8 * c) = o; }
    LDS_WAIT(); asm volatile("" ::: "memory");
}
__device__ __forceinline__ int map_gu(int n0, int up) { return (n0 >> 7) * 256 + up * 128 + (n0 & 127); }
__device__ __forceinline__ int map_mix(int n0) { if (n0 >= 4096) return n0; const int cc = n0 & 255; return (n0 & ~255) + ((cc >> 6) & 1) * 128 + (cc >> 7) * 64 + (cc & 63); }
__device__ __forceinline__ void sincos_d(double ang, float& sn_o, float& cs_o) {
    const double kd = __builtin_rint(ang * 0.63661977236758134308);
    double y = __builtin_fma(-kd, 1.57079632679489655800e+00, ang); y = __builtin_fma(-kd, 6.12323399573676603587e-17, y);
    const int q = ((int)kd) & 3; const double y2 = y * y;
    const double sp = y * (1.0 + y2 * (-1.0 / 6.0 + y2 * (1.0 / 120.0 + y2 * (-1.0 / 5040.0 + y2 * (1.0 / 362880.0 + y2 * (-1.0 / 39916800.0 + y2 * (1.0 / 6227020800.0 + y2 * (-1.0 / 1307674368000.0))))))));
    const double cp = 1.0 + y2 * (-0.5 + y2 * (1.0 / 24.0 + y2 * (-1.0 / 720.0 + y2 * (1.0 / 40320.0 + y2 * (-1.0 / 3628800.0 + y2 * (1.0 / 479001600.0 + y2 * (-1.0 / 87178291200.0 + y2 * (1.0 / 20922789888000.0))))))));
    const double sn = (q == 0) ? sp : (q == 1) ? cp : (q == 2) ? -sp : -cp;
    const double cs = (q == 0) ? cp : (q == 1) ? -sp : (q == 2) ? -cp : sp;
    sn_o = (float)sn; cs_o = (float)cs;
}
__device__ __forceinline__ void p0_prologue(Frame& F, unsigned char* ws) {
    LAS float* scr = (LAS float*)(F.lds + RING_OFF + F.wave * 16384); const int lane = mk_lane();
    const int gw = F.vcu * NWAVES + F.wave, NGW = F.G * NWAVES;
    bf16* ws16 = (bf16*)ws;
    constexpr int I_FF = (DM / 64) * (DFF / 32), I_DN = (DFF / 64) * (DM / 32), I_MI = (DM / 64) * (NMIX / 32), I_UP = (2048 / 64) * (DM / 32), I_MO = (DM / 64) * (DM / 32), I_XP = (DM / 64) * (XAW / 32), I_XO = (XAW / 64) * (DM / 32);
    constexpr int I_DR = I_DN - DOWN_TAIL_ITEMS;
    constexpr int NITEMS = 4 * I_FF + 2 * I_DR + I_MI + 2 * I_UP + I_MO + 3 * I_XP + I_XO;
    for (int it = gw; it < NITEMS; it += NGW) {
        int r = it; const float* W; int K, N, kind; bf16* WT;
        int off = 0;
        if (r < I_FF) { W = arg_in(I_F1G); K = DM; N = DFF; WT = (bf16*)(ws + WS_W1A); kind = 1; }
        else if ((r -= I_FF) < I_FF) { W = arg_in(I_F1U); K = DM; N = DFF; WT = (bf16*)(ws + WS_W1A); kind = 2; }
        else if ((r -= I_FF) < I_DR) { r += DOWN_TAIL_ITEMS; W = arg_in(I_F1D); K = DFF; N = DM; WT = (bf16*)(ws + WS_W1D); kind = 0; }
        else if ((r -= I_DR) < I_MI) { W = arg_in(I_MIXIN); K = DM; N = NMIX; WT = (bf16*)(ws + WS_WMI); kind = 3; }
        else if ((r -= I_MI) < I_UP) { W = arg_in(I_DAUP); K = 2048; N = DM; WT = (bf16*)(ws + WS_WDA); kind = 0; }
        else if ((r -= I_UP) < I_UP) { W = arg_in(I_HGUP); K = 2048; N = DM; WT = (bf16*)(ws + WS_WHG); kind = 0; }
        else if ((r -= I_UP) < I_MO) { W = arg_in(I_MIXOUT); K = DM; N = DM; WT = (bf16*)(ws + WS_WMO); kind = 0; }
        else if ((r -= I_MO) < I_XP) { W = arg_in(I_XAQ); K = DM; N = XAW; WT = (bf16*)(ws + WS_WXQ); kind = 0; }
        else if ((r -= I_XP) < I_XP) { W = arg_in(I_XAK); K = DM; N = XAW; WT = (bf16*)(ws + WS_WXKV); kind = 0; }
        else if ((r -= I_XP) < I_XP) { W = arg_in(I_XAV); K = DM; N = XAW; WT = (bf16*)(ws + WS_WXKV); kind = 0; off = XAW; }
        else if ((r -= I_XP) < I_XO) { W = arg_in(I_XAO); K = XAW; N = DM; WT = (bf16*)(ws + WS_WXO); kind = 0; }
        else if ((r -= I_XO) < I_FF) { W = arg_in(I_F2G); K = DM; N = DFF; WT = (bf16*)(ws + WS_W2A); kind = 1; }
        else if ((r -= I_FF) < I_FF) { W = arg_in(I_F2U); K = DM; N = DFF; WT = (bf16*)(ws + WS_W2A); kind = 2; }
        else { r -= I_FF; r += DOWN_TAIL_ITEMS; W = arg_in(I_F2D); K = DFF; N = DM; WT = (bf16*)(ws + WS_W2D); kind = 0; }
        const int nblk = N / 32, kb = r / nblk, nb = r - kb * nblk, n0 = 32 * nb;
        const int drow0 = kind == 0 ? n0 + off : kind == 3 ? map_mix(n0) : map_gu(n0, kind - 1);
        p0_transpose_item(W, K, N, WT, 64 * kb, n0, drow0, scr, lane);
    }
    (void)ws16;
    { const size_t gt = (size_t)gw * 64 + lane, NT = (size_t)NGW * 64;
      const GAS f32x4* x4 = (const GAS f32x4*)arg_in(I_X); GAS v4u* xb = (GAS v4u*)(ws + WS_XB);
      for (size_t i = gt; i < (size_t)SEQ * DM / 8; i += NT) { const f32x4 p = x4[2 * i], q = x4[2 * i + 1]; v4u o; o.x = pk2(p.x, p.y); o.y = pk2(p.z, p.w); o.z = pk2(q.x, q.y); o.w = pk2(q.z, q.w); xb[i] = o; }
      const GAS f32x4* m4 = (const GAS f32x4*)arg_in(I_MEM); GAS v4u* mb = (GAS v4u*)(ws + WS_MEMB);
      for (size_t i = gt; i < (size_t)MEM * DM / 8; i += NT) { const f32x4 p = m4[2 * i], q = m4[2 * i + 1]; v4u o; o.x = pk2(p.x, p.y); o.y = pk2(p.z, p.w); o.z = pk2(q.x, q.y); o.w = pk2(q.z, q.w); mb[i] = o; }
      float* COS = (float*)(ws + WS_COS); float* SIN = (float*)(ws + WS_SIN);
      for (size_t i = gt; i < (size_t)SEQ * 64; i += NT) { const int pos = (int)(i >> 6), fi = (int)(i & 63);
          double inv = 1.0, base = 0.86596432336006535;
#pragma unroll
          for (int bit = 0; bit < 6; ++bit) { if ((fi >> bit) & 1) inv *= base; base *= base; }
          const float invf = (float)inv; const float angf = (float)pos * invf;
          float sn, cs; sincos_d((double)angf, sn, cs); COS[i] = cs; SIN[i] = sn; }
      const float* lbl = arg_in(I_LBLOG); float* LB = (float*)(ws + WS_LB);
      for (size_t i = gt; i < 2048; i += NT) { const float l0 = lbl[i], l1 = lbl[2048 + i]; LB[i] = 1.0f / (1.0f + expf(l1 - l0)); }
    }
    if (blockIdx.x == 0 && F.wave == 0) {
        const int l = lane; const float* q1 = arg_in(I_LQ1); const float* k1 = arg_in(I_LK1); const float* q2 = arg_in(I_LQ2); const float* k2 = arg_in(I_LK2);
        const float s1 = wave_sum(q1[l] * k1[l] + q1[l + 64] * k1[l + 64]), s2 = wave_sum(q2[l] * k2[l] + q2[l + 64] * k2[l + 64]);
        if (l == 0) *(float*)(ws + WS_LAM) = expf(s1) - expf(s2) + LAMBDA_INIT;
    }
}

__device__ __forceinline__ void p0_convert_down(Frame& F, const float* W, bf16* WT, int t0) {
    const int nb = F.G - t0, b = (int)blockIdx.x - t0; if (b < 0) return;
    LAS float* scr = (LAS float*)(F.lds + RING_OFF + F.wave * 16384); const int lane = mk_lane();
    constexpr int nblk = DM / 32;
    for (int r = b * NWAVES + F.wave; r < DOWN_TAIL_ITEMS; r += nb * NWAVES) { const int kb = r / nblk, n0 = 32 * (r - kb * nblk);
        p0_transpose_item(W, DFF, DM, WT, 64 * kb, n0, n0, scr, lane); }
}
__device__ __forceinline__ void ln_phase(Frame& F, const float* Y, const float* g, const float* b, float* Xf, bf16* Xb, float* ST = nullptr) {
    const int gw = F.vcu * NWAVES + F.wave, NGW = F.G * NWAVES, lane = mk_lane();
    for (int m = gw; m < SEQ; m += NGW) {
        const GAS f32x4* yr = (const GAS f32x4*)(Y + (size_t)m * DM) + lane;
        f32x4 v[16]; float s = 0.f;
#pragma unroll
        for (int j = 0; j < 16; ++j) { v[j] = yr[64 * j]; s += (v[j].x + v[j].y) + (v[j].z + v[j].w); }
        const float mean = wave_sum(s) * (1.f / DM); float s2 = 0.f;
#pragma unroll
        for (int j = 0; j < 16; ++j) { v[j] = v[j] - mean; s2 += (v[j].x * v[j].x + v[j].y * v[j].y) + (v[j].z * v[j].z + v[j].w * v[j].w); }
        const float rstd = 1.f / sqrtf(wave_sum(s2) * (1.f / DM) + LN_EPS);
        if (ST && lane == 0) { ST[2 * m] = mean; ST[2 * m + 1] = rstd; }
        const GAS f32x4* g4 = (const GAS f32x4*)g + lane; const GAS f32x4* b4 = (const GAS f32x4*)b + lane;
#pragma unroll
        for (int j = 0; j < 16; ++j) { const f32x4 o = v[j] * rstd * g4[64 * j] + b4[64 * j];
            if (Xf) ((GAS f32x4*)(Xf + (size_t)m * DM) + lane)[64 * j] = o;
            if (Xb) { v2u w; w.x = pk2(o.x, o.y); w.y = pk2(o.z, o.w); ((GAS v2u*)(Xb + (size_t)m * DM) + lane)[64 * j] = w; } }
    }
}
__device__ __forceinline__ void da_combine(Frame& F, unsigned char* ws) {
    const int gw = F.vcu * NWAVES + F.wave, NGW = F.G * NWAVES, lane = mk_lane();
    const float lam = *(const float*)(ws + WS_LAM);
    const f32x4 g4 = ((const GAS f32x4*)arg_in(I_SUBLN))[lane];
    const float* O1 = (const float*)(ws + WS_O1); const float* O2 = (const float*)(ws + WS_O2); bf16* OA = (bf16*)(ws + WS_OA);
    for (int r = gw; r < SEQ * 8; r += NGW) {
        const size_t off = (size_t)r * 256 + 4 * lane;
        const f32x4 o1 = *(const GAS f32x4*)(O1 + off), o2 = *(const GAS f32x4*)(O2 + off);
        const f32x4 o = o1 - o2 * lam;
        const float ss = wave_sum((o.x * o.x + o.y * o.y) + (o.z * o.z + o.w * o.w));
        const float rs = (1.0f - LAMBDA_INIT) / sqrtf(ss * (1.f / 256.f) + LN_EPS);
        const f32x4 y = o * rs * g4;
        v2u w; w.x = pk2(y.x, y.y); w.y = pk2(y.z, y.w); *(GAS v2u*)(OA + off) = w;
    }
}
#define HG_GATES(ROWBASE)                                                                                           \
    float g[16], kk[16];                                                                                            \
    _Pragma("unroll") for (int i = 0; i < 16; ++i) { const float p = HF[(ROWBASE) + (size_t)i * 2048 + n];        \
        const float sg_ = __builtin_amdgcn_rcpf(1.0f + __expf(-p)); const float f = lb + (1.0f - lb) * sg_; kk[i] = 1.0f - f; g[i] = __logf(f); } \
    _Pragma("unroll") for (int i = 1; i < 16; ++i) g[i] += g[i - 1];
__device__ __forceinline__ void hgrn_passA(Frame& F, unsigned char* ws) {
    LAS unsigned char* L = F.lds + RING_OFF;
    const int lane = mk_lane(), w = F.wave, tid = w * 64 + lane, n = tid & 127, sg = tid >> 7, fr = lane & 15, fq = lane >> 4;
    const float* HF = (const float*)(ws + WS_HF); const bf16* HI = (const bf16*)(ws + WS_PB + 4 * PB_SEG); const float* LB = (const float*)(ws + WS_LB);
    float* SLT = (float*)(ws + WS_SLT); float* DEC = (float*)(ws + WS_DEC);
    LAS float* TOT = (LAS float*)(L + HG_TOT);
    for (int item = blockIdx.x; item < 2048; item += F.G) {
        const int h = item >> 7, c = item & 127;
        const float lb = LB[h * 128 + n];
        const size_t rowbase = (size_t)(c * 64 + sg * 16) * 2048 + h * 128;
        HG_GATES(rowbase)
        TOT[sg * 128 + n] = g[15];
        { unsigned vv[8];
#pragma unroll
          for (int i = 0; i < 8; ++i) vv[i] = (unsigned)HI[rowbase + (size_t)(2 * i) * 2048 + n] | ((unsigned)HI[rowbase + (size_t)(2 * i + 1) * 2048 + n] << 16);
          *(LAS v4u*)(L + HG_VT + n * 144 + sg * 32) = (v4u){vv[0], vv[1], vv[2], vv[3]}; *(LAS v4u*)(L + HG_VT + n * 144 + sg * 32 + 16) = (v4u){vv[4], vv[5], vv[6], vv[7]}; }
        __syncthreads();
        { const float t0 = TOT[n], t1 = TOT[128 + n], t2 = TOT[256 + n], t3 = TOT[384 + n];
          const float off = (sg > 0 ? t0 : 0.f) + (sg > 1 ? t1 : 0.f) + (sg > 2 ? t2 : 0.f), bl = (t0 + t1) + (t2 + t3);
          unsigned kw[8];
#pragma unroll
          for (int i = 0; i < 8; ++i) kw[i] = pg8::cvt_pk_bf16(kk[2 * i] * __expf(bl - (off + g[2 * i])), kk[2 * i + 1] * __expf(bl - (off + g[2 * i + 1])));
          *(LAS v4u*)(L + HG_KT + n * 144 + sg * 32) = (v4u){kw[0], kw[1], kw[2], kw[3]}; *(LAS v4u*)(L + HG_KT + n * 144 + sg * 32 + 16) = (v4u){kw[4], kw[5], kw[6], kw[7]};
          if (sg == 0) DEC[(size_t)(h * 128 + c) * 128 + n] = __expf(bl); }
        __syncthreads();
        f32x4 acc[8];
#pragma unroll
        for (int et = 0; et < 8; ++et) acc[et] = (f32x4){0.f, 0.f, 0.f, 0.f};
#pragma unroll
        for (int ks = 0; ks < 2; ++ks) { const bf16x8 af = *(const LAS bf16x8*)(L + HG_KT + (16 * w + fr) * 144 + (32 * ks + 8 * fq) * 2);
#pragma unroll
            for (int et = 0; et < 8; ++et) { const bf16x8 bfr = *(const LAS bf16x8*)(L + HG_VT + (16 * et + fr) * 144 + (32 * ks + 8 * fq) * 2);
                acc[et] = __builtin_amdgcn_mfma_f32_16x16x32_bf16(af, bfr, acc[et], 0, 0, 0); } }
        bf16* dst = (bf16*)SLT + (size_t)(h * 128 + c) * 16384 + 16 * w + 4 * fq;
#pragma unroll
        for (int et = 0; et < 8; ++et) *(GAS v2u*)(dst + (size_t)(16 * et + fr) * 128) = (v2u){pg8::cvt_pk_bf16(acc[et][0], acc[et][1]), pg8::cvt_pk_bf16(acc[et][2], acc[et][3])};
        __syncthreads();
    }
}
__device__ __forceinline__ void hgrn_passB(Frame& F, unsigned char* ws) {
    const float* SLT = (const float*)(ws + WS_SLT); float* SP = (float*)(ws + WS_XF); const float* DEC = (const float*)(ws + WS_DEC);
    for (int idx = blockIdx.x * (NWAVES * 64) + F.wave * 64 + mk_lane(); idx < 16 * 128 * 64; idx += F.G * NWAVES * 64) {
        const int h = idx >> 13, e = (idx >> 6) & 127, np = idx & 63;
        const GAS unsigned* p = (const GAS unsigned*)((const bf16*)SLT + (size_t)h * 128 * 16384 + (size_t)e * 128 + 2 * np);
        GAS unsigned* q = (GAS unsigned*)((bf16*)SP + (size_t)h * 128 * 16384 + (size_t)e * 128 + 2 * np);
        const GAS f32x2* d = (const GAS f32x2*)(DEC + (size_t)h * 128 * 128 + 2 * np);
        f32x2 st = (f32x2){0.f, 0.f};
        for (int c0 = 0; c0 < 128; c0 += 16) {
            unsigned lv[16]; f32x2 dv[16];
#pragma unroll
            for (int k = 0; k < 16; ++k) { lv[k] = p[(size_t)(c0 + k) * 8192]; dv[k] = d[(size_t)(c0 + k) * 64]; }
#pragma unroll
            for (int k = 0; k < 16; ++k) { q[(size_t)(c0 + k) * 8192] = pg8::cvt_pk_bf16(st.x, st.y);
                st = dv[k] * st + (f32x2){__uint_as_float(lv[k] << 16), __uint_as_float(lv[k] & 0xffff0000u)}; }
        }
    }
}
__device__ __forceinline__ void hgrn_passC(Frame& F, unsigned char* ws) {
    LAS unsigned char* L = F.lds + RING_OFF;
    const int lane = mk_lane(), w = F.wave, tid = w * 64 + lane, n = tid & 127, sg = tid >> 7, fr = lane & 15, fq = lane >> 4;
    const float* HF = (const float*)(ws + WS_HF); const bf16* HQ = (const bf16*)(ws + WS_PB + 3 * PB_SEG); const bf16* HI = (const bf16*)(ws + WS_PB + 4 * PB_SEG); const bf16* HGt = (const bf16*)(ws + WS_PB + 5 * PB_SEG);
    const float* LB = (const float*)(ws + WS_LB); const float* SLT = (const float*)(ws + WS_XF); const float* NG = arg_in(I_HGNORM); bf16* OB = (bf16*)(ws + WS_OB);
    LAS float* TOT = (LAS float*)(L + HG_TOT); LAS float* ER = (LAS float*)(L + HG_ER); LAS float* SS = (LAS float*)(L + HG_SS);
    const int ti = w & 3, eh = w >> 2;
    float ng[4];
#pragma unroll
    for (int q4 = 0; q4 < 4; ++q4) ng[q4] = NG[16 * (4 * eh + q4) + fr];
    for (int item = blockIdx.x; item < 2048; item += F.G) {
        const int h = item >> 7, c = item & 127;
        const float lb = LB[h * 128 + n];
        const size_t rowbase = (size_t)(c * 64 + sg * 16) * 2048 + h * 128;
        v2u sp[8];
        { const bf16* src = (const bf16*)SLT + (size_t)(h * 128 + c) * 16384; const int n4 = (tid & 31) * 4;
#pragma unroll
          for (int k = 0; k < 8; ++k) sp[k] = *(const GAS v2u*)(src + (size_t)((tid >> 5) + 16 * k) * 128 + n4); }
        unsigned short gtv[16];
#pragma unroll
        for (int i = 0; i < 4; ++i)
#pragma unroll
            for (int q4 = 0; q4 < 4; ++q4) gtv[4 * i + q4] = HGt[(size_t)(c * 64 + 16 * ti + 4 * fq + i) * 2048 + h * 128 + 16 * (4 * eh + q4) + fr];
        HG_GATES(rowbase)
        TOT[sg * 128 + n] = g[15];
        unsigned short qv[16];
#pragma unroll
        for (int i = 0; i < 16; ++i) qv[i] = HQ[rowbase + (size_t)i * 2048 + n];
        { unsigned vv[8];
#pragma unroll
          for (int i = 0; i < 8; ++i) vv[i] = (unsigned)HI[rowbase + (size_t)(2 * i) * 2048 + n] | ((unsigned)HI[rowbase + (size_t)(2 * i + 1) * 2048 + n] << 16);
          *(LAS v4u*)(L + HG_VT + n * 144 + sg * 32) = (v4u){vv[0], vv[1], vv[2], vv[3]}; *(LAS v4u*)(L + HG_VT + n * 144 + sg * 32 + 16) = (v4u){vv[4], vv[5], vv[6], vv[7]}; }
        __syncthreads();
        { const float t0 = TOT[n], t1 = TOT[128 + n], t2 = TOT[256 + n];
          const float off = (sg > 0 ? t0 : 0.f) + (sg > 1 ? t1 : 0.f) + (sg > 2 ? t2 : 0.f), r = t0 + t1;
#pragma unroll
          for (int i = 0; i < 16; ++i) { const float b = off + g[i];
              *(LAS unsigned short*)(L + HG_QD + (16 * sg + i) * 272 + n * 2) = (unsigned short)pg8::cvt_pk_bf16(bf2f(qv[i]) * __expf(b - r), 0.f);
              *(LAS unsigned short*)(L + HG_KD + (16 * sg + i) * 272 + n * 2) = (unsigned short)pg8::cvt_pk_bf16(kk[i] * __expf(r - b), 0.f); }
          if (sg == 0) ER[n] = __expf(r); }
        __syncthreads();
        { const int n4 = (tid & 31) * 4; const f32x4 er4 = *(const LAS f32x4*)(ER + n4);
#pragma unroll
          for (int k = 0; k < 8; ++k) { const int e = (tid >> 5) + 16 * k;
              const f32x4 s = (f32x4){__uint_as_float(sp[k].x << 16), __uint_as_float(sp[k].x & 0xffff0000u), __uint_as_float(sp[k].y << 16), __uint_as_float(sp[k].y & 0xffff0000u)} * er4;
              v2u o; o.x = pg8::cvt_pk_bf16(s.x, s.y); o.y = pg8::cvt_pk_bf16(s.z, s.w); *(LAS v2u*)(L + HG_ST + e * 272 + n4 * 2) = o; } }
        __syncthreads();
        bf16x8 qf[4];
#pragma unroll
        for (int ks = 0; ks < 4; ++ks) qf[ks] = *(const LAS bf16x8*)(L + HG_QD + (16 * ti + fr) * 272 + (32 * ks + 8 * fq) * 2);
        s16x4 pa[4];
#pragma unroll
        for (int j = 0; j < 4; ++j) { pa[j] = (s16x4){0, 0, 0, 0};
            if (j <= ti) { f32x4 at = (f32x4){0.f, 0.f, 0.f, 0.f};
#pragma unroll
                for (int ks = 0; ks < 4; ++ks) { const bf16x8 kf = *(const LAS bf16x8*)(L + HG_KD + (16 * j + fr) * 272 + (32 * ks + 8 * fq) * 2);
                    at = __builtin_amdgcn_mfma_f32_16x16x32_bf16(kf, qf[ks], at, 0, 0, 0); }
                if (j == ti) {
#pragma unroll
                    for (int i = 0; i < 4; ++i) at[i] = (4 * fq + i <= fr) ? at[i] : 0.f; }
                const unsigned w0 = pg8::cvt_pk_bf16(at[0], at[1]), w1 = pg8::cvt_pk_bf16(at[2], at[3]);
                pa[j] = (s16x4){(short)(w0 & 0xffffu), (short)(w0 >> 16), (short)(w1 & 0xffffu), (short)(w1 >> 16)}; } }
        f32x4 acc[4];
#pragma unroll
        for (int q4 = 0; q4 < 4; ++q4) { const int et = 4 * eh + q4; acc[q4] = (f32x4){0.f, 0.f, 0.f, 0.f};
#pragma unroll
            for (int ks = 0; ks < 4; ++ks) { const bf16x8 sf = *(const LAS bf16x8*)(L + HG_ST + (16 * et + fr) * 272 + (32 * ks + 8 * fq) * 2);
                acc[q4] = __builtin_amdgcn_mfma_f32_16x16x32_bf16(qf[ks], sf, acc[q4], 0, 0, 0); }
#pragma unroll
            for (int jp = 0; jp < 2; ++jp) if (2 * jp <= ti) {
                const s16x4 v0 = *(const LAS s16x4*)(L + HG_VT + (16 * et + fr) * 144 + (32 * jp + 4 * fq) * 2), v1 = *(const LAS s16x4*)(L + HG_VT + (16 * et + fr) * 144 + (32 * jp + 16 + 4 * fq) * 2);
                const bf16x8 af = (bf16x8){pa[2 * jp][0], pa[2 * jp][1], pa[2 * jp][2], pa[2 * jp][3], pa[2 * jp + 1][0], pa[2 * jp + 1][1], pa[2 * jp + 1][2], pa[2 * jp + 1][3]};
                const bf16x8 bfv = (bf16x8){v0[0], v0[1], v0[2], v0[3], v1[0], v1[1], v1[2], v1[3]};
                acc[q4] = __builtin_amdgcn_mfma_f32_16x16x32_bf16(af, bfv, acc[q4], 0, 0, 0); } }
        float ssq[4];
#pragma unroll
        for (int i = 0; i < 4; ++i) { float s = (acc[0][i] * acc[0][i] + acc[1][i] * acc[1][i]) + (acc[2][i] * acc[2][i] + acc[3][i] * acc[3][i]);
            s += __shfl_xor(s, 1); s += __shfl_xor(s, 2); s += __shfl_xor(s, 4); s += __shfl_xor(s, 8); ssq[i] = s; }
        if (fr == 0) { *(LAS f32x4*)(SS + w * 16 + 4 * fq) = (f32x4){ssq[0], ssq[1], ssq[2], ssq[3]}; }
        __syncthreads();
        { const f32x4 other = *(const LAS f32x4*)(SS + (w ^ 4) * 16 + 4 * fq);
#pragma unroll
          for (int i = 0; i < 4; ++i) { const float rs = __builtin_amdgcn_rsqf((ssq[i] + other[i]) * (1.f / 128.f) + LN_EPS);
              const size_t orow = (size_t)(c * 64 + 16 * ti + 4 * fq + i) * 2048 + h * 128;
#pragma unroll
              for (int q4 = 0; q4 < 4; ++q4) { const int e = 16 * (4 * eh + q4) + fr; const float gt = bf2f(gtv[4 * i + q4]);
                  const float v = acc[q4][i] * rs * ng[q4] * (gt * __builtin_amdgcn_rcpf(1.0f + __expf(-gt))), vn = __shfl_xor(v, 1);
                  if ((fr & 1) == 0) *(GAS unsigned*)(OB + orow + e) = pg8::cvt_pk_bf16(v, vn); } } }
        __syncthreads();
    }
}
struct AItem { int vh, qb0, qb1; };
__device__ __forceinline__ AItem a_decode(int L) { const int xcd = L & 7, k = L >> 3; AItem it; it.vh = (((k >> 5) * 8 + xcd) * 2 + ((k & 31) >> 4)) & 31; const int x = k & 15; it.qb0 = x; it.qb1 = 31 - x; return it; }
__device__ __forceinline__ attn::BlockRef<bf16, float> a_ref(const AItem& it, int pass, unsigned char* ws) {
    const int qb = pass ? it.qb1 : it.qb0, kvp = it.vh >> 1, vhalf = it.vh & 1, h = kvp >> 1, map = kvp & 1;
    attn::BlockRef<bf16, float> r;
    r.Q = (const bf16*)(ws + WS_PB) + (size_t)qb * 256 * 2048 + h * 256 + map * 128;
    r.K = (const bf16*)(ws + WS_PB + PB_SEG) + h * 256 + map * 128;
    r.V = (const bf16*)(ws + WS_PB + 2 * PB_SEG) + h * 256 + vhalf * 128;
    r.O = (float*)(ws + (map ? WS_O2 : WS_O1)) + (size_t)qb * 256 * 2048 + h * 256 + vhalf * 128;
    r.P0 = qb * 256;
    return r;
}
__device__ __forceinline__ void da_attention(Frame& F, unsigned char* ws) {
    constexpr int total = 512; const int stride = F.G;
    int L = blockIdx.x; if (L >= total) return;
    char* lds = (char*)F.lds;
    AItem it = a_decode(L); int pass = 0;
    attn::BlockRef<bf16, float> cur = a_ref(it, 0, ws);
    attn::Seam<bf16> S;
    attn::causal_swa_prime<bf16, float, 2048, 2048, 2048>(cur, SEQ, lds, S, F.wave);
    for (;;) {
        const bool more_pass = pass == 0 && it.qb1 != it.qb0, more_item = L + stride < total, last = !more_pass && !more_item;
        AItem itn = it; int passn = pass + 1, Ln = L;
        if (!more_pass) { passn = 0; Ln = more_item ? L + stride : L; itn = a_decode(Ln); }
        const attn::BlockRef<bf16, float> nxt = last ? cur : a_ref(itn, passn, ws);
        attn::causal_swa_block<bf16, float, 2048, 2048, 2048>(cur, nxt, SEQ, SEQ, lds, S, F.wave);
        if (last) break;
        cur = nxt; it = itn; pass = passn; L = Ln;
    }
}
__device__ __forceinline__ void xa_attention(Frame& F, unsigned char* ws) {
    LAS unsigned char* L = F.lds + RING_OFF;
    const int lane = mk_lane(), w = F.wave, tid = w * 64 + lane, fr = lane & 15, fq = lane >> 4;
    const float* XQP = (const float*)(ws + WS_XQP); const bf16* XKV = (const bf16*)(ws + WS_XKV); bf16* XO = (bf16*)(ws + WS_XO);
    constexpr float C2 = 0.08838834764831845f * 1.4426950408889634f;
    for (int item = blockIdx.x; item < 128; item += F.G) {
        const int h = item >> 5, qb = item & 31;
#pragma unroll
        for (int i = 0; i < 8; ++i) { const int idx = tid + 512 * i, key = idx >> 4, c = idx & 15;
            const v4u kv = *(const GAS v4u*)(XKV + (size_t)key * 1024 + h * 128 + 8 * c);
            *(LAS v4u*)(L + key * 256 + ((c ^ (key & 15)) << 4)) = kv; }
#pragma unroll 4
        for (int i = 0; i < 16; ++i) { const int idx = tid + 512 * i, e = idx & 127, kq = idx >> 7;
            const bf16* vp = XKV + (size_t)(4 * kq) * 1024 + 512 + h * 128 + e;
            v2u o; o.x = (unsigned)vp[0] | ((unsigned)vp[1024] << 16); o.y = (unsigned)vp[2048] | ((unsigned)vp[3072] << 16);
            *(LAS v2u*)(L + 65536 + e * 512 + ((kq ^ ((e & 15) << 1)) << 3)) = o; }
        __syncthreads();
#pragma unroll 1
        for (int qt = 0; qt < 2; ++qt) {
            const size_t qrow = (size_t)qb * 256 + 32 * w + 16 * qt;
            bf16x8 qf[4];
#pragma unroll
            for (int ks = 0; ks < 4; ++ks) { const float* qp = XQP + (qrow + fr) * XAW + h * 128 + 32 * ks + 8 * fq;
                f32x4 a = *(const GAS f32x4*)qp, b = *(const GAS f32x4*)(qp + 4);
#pragma unroll
                for (int p = 1; p < 4; ++p) { a = a + *(const GAS f32x4*)(qp + (size_t)p * SEQ * XAW); b = b + *(const GAS f32x4*)(qp + (size_t)p * SEQ * XAW + 4); }
                const v4u w4 = (v4u){pg8::cvt_pk_bf16(a[0], a[1]), pg8::cvt_pk_bf16(a[2], a[3]), pg8::cvt_pk_bf16(b[0], b[1]), pg8::cvt_pk_bf16(b[2], b[3])};
                qf[ks] = __builtin_bit_cast(bf16x8, w4); }
            f32x4 sacc[16];
#pragma unroll
            for (int kt = 0; kt < 16; ++kt) sacc[kt] = (f32x4){0.f, 0.f, 0.f, 0.f};
#pragma unroll
            for (int ks = 0; ks < 4; ++ks)
#pragma unroll
                for (int kt = 0; kt < 16; ++kt) { const bf16x8 kf = *(const LAS bf16x8*)(L + (16 * kt + fr) * 256 + (((4 * ks + fq) ^ fr) << 4));
                    sacc[kt] = __builtin_amdgcn_mfma_f32_16x16x32_bf16(kf, qf[ks], sacc[kt], 0, 0, 0); }
            float mx = sacc[0][0];
#pragma unroll
            for (int kt = 0; kt < 16; ++kt)
#pragma unroll
                for (int r = 0; r < 4; ++r) mx = fmaxf(mx, sacc[kt][r]);
            mx = fmaxf(mx, __shfl_xor(mx, 16)); mx = fmaxf(mx, __shfl_xor(mx, 32));
            const float mc = mx * C2; float l = 0.f; s16x4 pa[16];
#pragma unroll
            for (int kt = 0; kt < 16; ++kt) { f32x4 p;
#pragma unroll
                for (int r = 0; r < 4; ++r) { p[r] = __builtin_amdgcn_exp2f(sacc[kt][r] * C2 - mc); l += p[r]; }
                const unsigned w0 = pg8::cvt_pk_bf16_pinned(p[0], p[1]), w1 = pg8::cvt_pk_bf16_pinned(p[2], p[3]);
                pa[kt] = (s16x4){(short)(w0 & 0xffffu), (short)(w0 >> 16), (short)(w1 & 0xffffu), (short)(w1 >> 16)}; }
            l += __shfl_xor(l, 16); l += __shfl_xor(l, 32);
            f32x4 oacc[8];
#pragma unroll
            for (int et = 0; et < 8; ++et) oacc[et] = (f32x4){0.f, 0.f, 0.f, 0.f};
#pragma unroll
            for (int kp = 0; kp < 8; ++kp) {
                const bf16x8 af = (bf16x8){pa[2 * kp][0], pa[2 * kp][1], pa[2 * kp][2], pa[2 * kp][3], pa[2 * kp + 1][0], pa[2 * kp + 1][1], pa[2 * kp + 1][2], pa[2 * kp + 1][3]};
#pragma unroll
                for (int et = 0; et < 8; ++et) { const s16x4 v0 = *(const LAS s16x4*)(L + 65536 + (16 * et + fr) * 512 + (((8 * kp + fq) ^ (fr << 1)) << 3)), v1 = *(const LAS s16x4*)(L + 65536 + (16 * et + fr) * 512 + (((8 * kp + 4 + fq) ^ (fr << 1)) << 3));
                    oacc[et] = __builtin_amdgcn_mfma_f32_16x16x32_bf16(af, (bf16x8){v0[0], v0[1], v0[2], v0[3], v1[0], v1[1], v1[2], v1[3]}, oacc[et], 0, 0, 0); } }
            const float rl = 1.0f / l;
#pragma unroll
            for (int r = 0; r < 4; ++r) { const float rr = __shfl(rl, 4 * fq + r);
#pragma unroll
                for (int et = 0; et < 8; ++et) { const float v = oacc[et][r] * rr, vn = __shfl_xor(v, 1);
                    if ((fr & 1) == 0) *(GAS unsigned*)(XO + (qrow + 4 * fq + r) * XAW + h * 128 + 16 * et + fr) = pk2(v, vn); } }
        }
        __syncthreads();
    }
}

__global__ void __launch_bounds__(NWAVES * 64, 2) mk_fwd(Args args) {
    extern __shared__ __attribute__((aligned(16))) unsigned char lds[];
    Frame F;
    F.lds = (LAS unsigned char*)lds;
    F.MISC = (volatile LAS unsigned*)(F.lds + MISC_OFF);
    F.wave = __builtin_amdgcn_readfirstlane((int)threadIdx.x >> 6);
    F.G = gridDim.x; { const int bx = blockIdx.x; F.vcu = (F.G % 8 == 0) ? (bx % 8) * (F.G / 8) + bx / 8 : bx; }
    unsigned char* ws = args.ws;
    F.ctl = (gu32*)(ws + WS_CTL);
    for (int u = threadIdx.x; u < (LDS_BYTES - LDSCTL_OFF) / 4; u += NWAVES * 64) ((LAS unsigned*)(F.lds + LDSCTL_OFF))[u] = 0u;
    __syncthreads();
    XcdBarrier bar; bar.bar = (unsigned*)(F.ctl + CW_BAR); bar.x = 0; bar.st = nullptr;
    if (N_LAUNCHES == 1) bar = xcd_barrier_post((unsigned*)(F.ctl + CW_BAR), F.MISC + 8, threadIdx.x == 0);
#define GRID_BAR() do { if (N_LAUNCHES == 1) xcd_barrier(bar, F.wave == 0 && mk_lane() == 0); } while (0)
    const int lo = args.ph_lo, hi = args.ph_hi;
#define IN(k) (lo <= (k) && (k) < hi)
#define SEAM(k) do { if (IN(k) && IN((k) + 1)) GRID_BAR(); } while (0)
    const int bid = (int)blockIdx.x;
#define XB ((bf16*)(ws + WS_XB))
#define Y ((float*)(ws + WS_Y))
#define XF ((float*)(ws + WS_XF))
#define HB ((bf16*)(ws + WS_H))

    if (IN(0)) { p0_prologue(F, ws); } SEAM(0);
    if (IN(1)) { pg8::Gemm g{XB, (const bf16*)(ws + WS_W1A), SEQ, 2 * DFF, DM, DM, nullptr, nullptr}; pg8::StaticOrder S; S.init(SEQ, 2 * DFF, F.G, bid);
        pg8::EpiSwiGLU E{HB, DFF}; pg8::gemm_phase<pg8::EpiSwiGLU, pg8::StaticOrder, true, true>(F.lds + RING_OFF, g, S, E, F.wave);
        { pg8::Gemm g2{(const bf16*)(ws + WS_MEMB), (const bf16*)(ws + WS_WXKV), MEM, 2 * XAW, DM, DM, nullptr, nullptr}; pg8::StaticOrder S2; S2.init(MEM, 2 * XAW, F.G, (bid + F.G - 192) % F.G);
          pg8::EpiBf16 E2{(bf16*)(ws + WS_XKV), 2 * XAW}; pg8::gemm_phase<pg8::EpiBf16, pg8::StaticOrder, true, true>(F.lds + RING_OFF, g2, S2, E2, F.wave); }
        p0_convert_down(F, arg_in(I_F1D), (bf16*)(ws + WS_W1D), F.G > 200 ? 196 : 0); } SEAM(1);
    if (IN(2)) { pg8::Gemm g{HB, (const bf16*)(ws + WS_W1D), SEQ, DM, DFF, DFF, nullptr, nullptr}; pg8::StaticOrder S; S.init(SEQ, DM, F.G, bid);
        pg8::EpiResF32 E{arg_in(I_X), Y, DM, DN_ALPHA, 0.5f}; pg8::gemm_phase<pg8::EpiResF32, pg8::StaticOrder, true, true>(F.lds + RING_OFF, g, S, E, F.wave); } SEAM(2);
    if (IN(3)) { ln_phase(F, Y, arg_in(I_LN1G), arg_in(I_LN1B), nullptr, XB, (float*)(ws + WS_ST)); } SEAM(3);
    if (IN(4)) { pg8::Gemm g{XB, (const bf16*)(ws + WS_WMI), SEQ, NMIX, DM, DM, nullptr, nullptr}; pg8::StaticOrder S; S.init(SEQ, NMIX, F.G, bid);
        pg8::EpiMixIn E{(bf16*)(ws + WS_PB), PB_SEG / 2, (float*)(ws + WS_HF), (bf16*)(ws + WS_GA), (bf16*)(ws + WS_GB), (const float*)(ws + WS_COS), (const float*)(ws + WS_SIN)};
        pg8::gemm_phase<pg8::EpiMixIn, pg8::StaticOrder, true, true>(F.lds + RING_OFF, g, S, E, F.wave); } SEAM(4);
    if (IN(5)) { da_attention(F, ws); hgrn_passA(F, ws); } SEAM(5);
    if (IN(6)) { hgrn_passB(F, ws); da_combine(F, ws); } SEAM(6);
    if (IN(7)) { hgrn_passC(F, ws); } SEAM(7);
    if (IN(8)) { pg8::Gemm g{(const bf16*)(ws + WS_OA), (const bf16*)(ws + WS_WDA), SEQ, DM, 2048, 2048, (const bf16*)(ws + WS_OB), (const bf16*)(ws + WS_WHG)};
        pg8::DualOrder S; S.init(SEQ, DM, F.G, bid); pg8::EpiMerge E{(const bf16*)(ws + WS_GA), (const bf16*)(ws + WS_GB), XB, DM};
        pg8::gemm_phase<pg8::EpiMerge, pg8::DualOrder, true, true>(F.lds + RING_OFF, g, S, E, F.wave); } SEAM(8);
    if (IN(9)) { pg8::Gemm g{XB, (const bf16*)(ws + WS_WMO), SEQ, DM, DM, DM, nullptr, nullptr}; pg8::StaticOrder S; S.init(SEQ, DM, F.G, bid);
        pg8::EpiResLN E{Y, (const float*)(ws + WS_ST), arg_in(I_LN1G), arg_in(I_LN1B), XF, DM, DN_ALPHA, 1.0f}; pg8::gemm_phase<pg8::EpiResLN, pg8::StaticOrder, true, true>(F.lds + RING_OFF, g, S, E, F.wave); } SEAM(9);
    if (IN(10)) { ln_phase(F, XF, arg_in(I_LN2G), arg_in(I_LN2B), nullptr, XB, (float*)(ws + WS_ST) + 2 * SEQ); } SEAM(10);
    if (IN(11)) { pg8::Gemm g{XB, (const bf16*)(ws + WS_WXQ), SEQ, XAW, DM / 4, DM, nullptr, nullptr}; pg8::SplitKOrder S; S.init(SEQ, XAW, DM / 4, 4, F.G, bid);
        pg8::EpiF32Part E{(float*)(ws + WS_XQP), XAW, DM / 4, (size_t)SEQ * XAW}; pg8::gemm_phase<pg8::EpiF32Part, pg8::SplitKOrder, true, true>(F.lds + RING_OFF, g, S, E, F.wave); } SEAM(11);
    if (IN(12)) { xa_attention(F, ws); } SEAM(12);
    if (IN(13)) { pg8::Gemm g{(const bf16*)(ws + WS_XO), (const bf16*)(ws + WS_WXO), SEQ, DM, XAW, XAW, nullptr, nullptr}; pg8::StaticOrder S; S.init(SEQ, DM, F.G, bid);
        pg8::EpiResLN E{XF, (const float*)(ws + WS_ST) + 2 * SEQ, arg_in(I_LN2G), arg_in(I_LN2B), Y, DM, DN_ALPHA, 1.0f}; pg8::gemm_phase<pg8::EpiResLN, pg8::StaticOrder, true, true>(F.lds + RING_OFF, g, S, E, F.wave); } SEAM(13);
    if (IN(14)) { ln_phase(F, Y, arg_in(I_LN3G), arg_in(I_LN3B), nullptr, XB, (float*)(ws + WS_ST) + 4 * SEQ); } SEAM(14);
    if (IN(15)) { pg8::Gemm g{XB, (const bf16*)(ws + WS_W2A), SEQ, 2 * DFF, DM, DM, nullptr, nullptr}; pg8::StaticOrder S; S.init(SEQ, 2 * DFF, F.G, bid);
        pg8::EpiSwiGLU E{HB, DFF}; pg8::gemm_phase<pg8::EpiSwiGLU, pg8::StaticOrder, true, true>(F.lds + RING_OFF, g, S, E, F.wave);
        p0_convert_down(F, arg_in(I_F2D), (bf16*)(ws + WS_W2D), F.G > 200 ? 192 : 0); } SEAM(15);
    if (IN(16)) { pg8::Gemm g{HB, (const bf16*)(ws + WS_W2D), SEQ, DM, DFF, DFF, nullptr, nullptr}; pg8::StaticOrder S; S.init(SEQ, DM, F.G, bid);
        pg8::EpiResLN E{Y, (const float*)(ws + WS_ST) + 4 * SEQ, arg_in(I_LN3G), arg_in(I_LN3B), XF, DM, DN_ALPHA, 0.5f}; pg8::gemm_phase<pg8::EpiResLN, pg8::StaticOrder, true, true>(F.lds + RING_OFF, g, S, E, F.wave); } SEAM(16);
    if (IN(17)) { ln_phase(F, XF, arg_in(I_LN4G), arg_in(I_LN4B), arg_out(), nullptr); }
#undef XB
#undef Y
#undef XF
#undef HB
#undef IN
#undef SEAM
#undef GRID_BAR
}

extern "C" void kernel_launch(void* const* d_in, const int* in_sizes, int n_in, void* d_out, int out_size, void* d_ws, size_t ws_size, hipStream_t stream) {
    static int grid = 0;
    if (grid == 0) {
        if (n_in != 31 || in_sizes[0] != SEQ * DM || out_size != SEQ * DM || ws_size < WS_END) { fprintf(stderr, "kernel_launch: built for 31 inputs, x/out of %d floats, >= %zu bytes of workspace; got n_in %d, in0 %d, out %d, ws %zu; nothing launched\n", SEQ * DM, (size_t)WS_END, n_in, n_in > 0 ? in_sizes[0] : -1, out_size, ws_size); grid = -1; return; }
        int dev = 0, cus = 0, per_cu = 0;
        if (hipGetDevice(&dev) != hipSuccess || hipDeviceGetAttribute(&cus, hipDeviceAttributeMultiprocessorCount, dev) != hipSuccess) { fprintf(stderr, "kernel_launch: device query failed\n"); grid = -1; return; }
        if (hipFuncSetAttribute((const void*)mk_fwd, hipFuncAttributeMaxDynamicSharedMemorySize, LDS_BYTES) != hipSuccess) { fprintf(stderr, "kernel_launch: hipFuncSetAttribute failed\n"); grid = -1; return; }
        if (hipOccupancyMaxActiveBlocksPerMultiprocessor(&per_cu, (const void*)mk_fwd, NWAVES * 64, LDS_BYTES) != hipSuccess || per_cu < 1)
            fprintf(stderr, "kernel_launch: note: occupancy query reports %d workgroups per CU\n", per_cu);
        (void)hipGetLastError();
        grid = cus;
    }
    if (grid < 0) return;
    if (hipMemsetAsync((char*)d_ws + WS_CTL, 0, CTL_ZERO_BYTES, stream) != hipSuccess) { fprintf(stderr, "kernel_launch: hipMemsetAsync failed\n"); return; }
    Args a{};
    for (int i = 0; i < 31; ++i) a.in[i] = (const float*)d_in[i];
    a.out = (float*)d_out; a.ws = (unsigned char*)d_ws;
    const int n_l = N_LAUNCHES;
    for (int li = 0; li < n_l; ++li) {
        a.ph_lo = (N_LAUNCHES == 1) ? 0 : li; a.ph_hi = (N_LAUNCHES == 1) ? NPHASES : li + 1;
        hipLaunchKernelGGL(mk_fwd, dim3(grid), dim3(NWAVES * 64), LDS_BYTES, stream, a);
        const hipError_t le = hipPeekAtLastError();
        if (le != hipSuccess) { fprintf(stderr, "kernel_launch: launch %d failed: %s\n", li, hipGetErrorName(le)); break; }
    }
}
```
